# Optimizing an MI355X kernel written in HIP

```python
import jax, jax.numpy as jnp
from jax import lax
import numpy as np

D_MODEL = 1024
BATCH = 16
SEQ = 2048
DEPTH = 2

HEAD_DIM = 64
SB_HEADS = 8
SB_WIDTH = SB_HEADS * HEAD_DIM
CONV_CH = 512
CONV_WIDTH = 31
NSA_HEADS = 8
NSA_KV_HEADS = 2
NSA_GROUP = NSA_HEADS // NSA_KV_HEADS
NSA_WIDTH = NSA_HEADS * HEAD_DIM
KV_WIDTH = NSA_KV_HEADS * HEAD_DIM
CMP_BLOCK = 32
CMP_STRIDE = 16
SEL_BLOCK = 64
SEL_TOPK = 8
WINDOW = 512
GMLP_WIDTH = 512
GMLP_GROUPS = 4
GMLP_CHUNK = 128
D_FF = -(-8 * D_MODEL // (3 * 256)) * 256
Q_BLOCK = 128
SEL_Q_BLOCK = 64
ALPHA = (2 * DEPTH) ** 0.25
OUT_INIT = (8 * DEPTH) ** -0.25
LN_EPS = 1e-5
NEG = -1e30
FORCE_BONUS = 1e3

EVEN_SPLITS = (SB_WIDTH, SB_WIDTH, SB_WIDTH, CONV_CH, CONV_CH)
ODD_SPLITS = (NSA_WIDTH,) + (KV_WIDTH,) * 6 + (3 * NSA_HEADS, GMLP_WIDTH, GMLP_WIDTH)
EVEN_IN = sum(EVEN_SPLITS)
ODD_IN = sum(ODD_SPLITS)
MIX_OUT = SB_WIDTH + CONV_CH

kernel_name = "hybrid_stickbreak_conformer_nsa_gmlp_deepnorm"


def layer_norm(x, g, b):
    xf = x.astype(jnp.float32)
    mu = jnp.mean(xf, axis=-1, keepdims=True)
    var = jnp.mean(jnp.square(xf - mu), axis=-1, keepdims=True)
    y = (xf - mu) * lax.rsqrt(var + LN_EPS) * g.astype(jnp.float32) + b.astype(jnp.float32)
    return y.astype(x.dtype)


def split_cols(h, sizes):
    offs = [int(o) for o in np.cumsum(sizes)[:-1]]
    return jnp.split(h, offs, axis=-1)


def masked_softmax(s, mask):
    s = jnp.where(mask, s, NEG)
    p = jax.nn.softmax(s, axis=-1)
    return jnp.where(mask, p, 0.0)


def stick_breaking_attention(q, k, v):
    B, S, H, D = q.shape
    scale = D ** -0.5
    outs = []
    for i in range(S // Q_BLOCK):
        q0 = i * Q_BLOCK
        q1 = q0 + Q_BLOCK
        z = jnp.einsum('bqhd,bkhd->bhqk', q[:, q0:q1], k[:, :q1]).astype(jnp.float32) * scale
        tpos = q0 + jnp.arange(Q_BLOCK)
        kpos = jnp.arange(q1)
        past = kpos[None, :] < tpos[:, None]
        log_beta = jax.nn.log_sigmoid(z)
        log_rem = jnp.where(past, log_beta - z, 0.0)
        between = lax.cumsum(log_rem, axis=3, reverse=True) - log_rem
        w = jnp.where(past, jnp.exp(log_beta + between), 0.0)
        outs.append(jnp.einsum('bhqk,bkhd->bqhd', w.astype(v.dtype), v[:, :q1]))
    return jnp.concatenate(outs, axis=1)


def conformer_conv(a, gate, w_dw, b_dw, ln_g, ln_b):
    C = a.shape[-1]
    h = a * jax.nn.sigmoid(gate)
    hp = jnp.pad(h, ((0, 0), (CONV_WIDTH - 1, 0), (0, 0)))
    y = lax.conv_general_dilated(hp, w_dw[:, None, :].astype(h.dtype), window_strides=(1,),
                                 padding='VALID', dimension_numbers=('NWC', 'WIO', 'NWC'),
                                 feature_group_count=C) + b_dw
    y = layer_norm(y, ln_g, ln_b)
    return jax.nn.silu(y)


def compress_blocks(blocks, pos, w1, w2):
    B, n, L, G, D = blocks.shape
    h = blocks + pos[:, None, :]
    h = jnp.transpose(h, (0, 1, 3, 2, 4)).reshape(B, n, G, L * D)
    return jax.nn.gelu(h @ w1) @ w2


def nsa_compressed(q5, k, v, pos_k, w1k, w2k, pos_v, w1v, w2v):
    B, S, G, R, D = q5.shape
    scale = D ** -0.5
    n_cmp = (S - CMP_BLOCK) // CMP_STRIDE + 1
    idx = jnp.arange(n_cmp)[:, None] * CMP_STRIDE + jnp.arange(CMP_BLOCK)[None, :]
    kc = compress_blocks(k[:, idx], pos_k, w1k, w2k)
    vc = compress_blocks(v[:, idx], pos_v, w1v, w2v)
    s = jnp.einsum('bsgrd,bngd->bgrsn', q5, kc).astype(jnp.float32) * scale
    tpos = jnp.arange(S)
    cstart = jnp.arange(n_cmp) * CMP_STRIDE
    mask = (cstart + CMP_BLOCK - 1)[None, :] <= tpos[:, None]
    p = masked_softmax(s, mask)
    o = jnp.einsum('bgrsn,bngd->bsgrd', p.astype(vc.dtype), vc)
    n_slc = S // SEL_BLOCK
    sstart = jnp.arange(n_slc) * SEL_BLOCK
    overlap = ((cstart[:, None] < sstart[None, :] + SEL_BLOCK) &
               (cstart[:, None] + CMP_BLOCK > sstart[None, :])).astype(jnp.float32)
    imp = jnp.einsum('bgrsn,nj->bsgj', p, overlap)
    return o, imp


def select_blocks(imp):
    B, S, G, n_slc = imp.shape
    blk_t = jnp.arange(S) // SEL_BLOCK
    j = jnp.arange(n_slc)
    valid = j[None, :] <= blk_t[:, None]
    forced = (j[None, :] == 0) | (j[None, :] == blk_t[:, None]) | (j[None, :] == blk_t[:, None] - 1)
    bonus = jnp.where(forced, FORCE_BONUS, 0.0)
    score = jnp.where(valid[None, :, None, :], imp + bonus[None, :, None, :], NEG)
    k_eff = min(SEL_TOPK, n_slc)
    _, sel = lax.top_k(score, k_eff)
    return sel


def nsa_selected(q5, k, v, sel):
    B, S, G, R, D = q5.shape
    scale = D ** -0.5
    n_slc = S // SEL_BLOCK
    kk = sel.shape[-1]
    kb = jnp.transpose(k.reshape(B, n_slc, SEL_BLOCK, G, D), (0, 3, 1, 2, 4))
    vb = jnp.transpose(v.reshape(B, n_slc, SEL_BLOCK, G, D), (0, 3, 1, 2, 4))
    nc = S // SEL_Q_BLOCK
    qc = jnp.moveaxis(q5.reshape(B, nc, SEL_Q_BLOCK, G, R, D), 1, 0)
    ic = jnp.moveaxis(sel.reshape(B, nc, SEL_Q_BLOCK, G, kk), 1, 0)
    starts = jnp.arange(nc, dtype=jnp.int32) * SEL_Q_BLOCK
    bi = jnp.arange(B)[:, None, None, None]
    gi = jnp.arange(G)[None, None, :, None]

    def one(args):
        qi, idx, st = args
        kg = kb[bi, gi, idx]
        vg = vb[bi, gi, idx]
        tpos = st + jnp.arange(SEL_Q_BLOCK)
        kpos = idx[..., None] * SEL_BLOCK + jnp.arange(SEL_BLOCK)
        mask = (kpos <= tpos[None, :, None, None, None]).reshape(B, SEL_Q_BLOCK, G, kk * SEL_BLOCK)
        s = jnp.einsum('bqgrd,bqgkld->bqgrkl', qi, kg).astype(jnp.float32) * scale
        s = s.reshape(B, SEL_Q_BLOCK, G, R, kk * SEL_BLOCK)
        p = masked_softmax(s, mask[:, :, :, None, :])
        return jnp.einsum('bqgrm,bqgmd->bqgrd', p.astype(vg.dtype),
                          vg.reshape(B, SEL_Q_BLOCK, G, kk * SEL_BLOCK, D))

    o = lax.map(one, (qc, ic, starts))
    return jnp.moveaxis(o, 0, 1).reshape(B, S, G, R, D)


def nsa_window(q5, k, v):
    B, S, G, R, D = q5.shape
    scale = D ** -0.5
    nq = S // Q_BLOCK
    span = Q_BLOCK + WINDOW
    kp = jnp.pad(k, ((0, 0), (WINDOW, 0), (0, 0), (0, 0)))
    vp = jnp.pad(v, ((0, 0), (WINDOW, 0), (0, 0), (0, 0)))
    qb = jnp.moveaxis(q5.reshape(B, nq, Q_BLOCK, G, R, D), 1, 0)
    starts = jnp.arange(nq, dtype=jnp.int32) * Q_BLOCK

    def one(args):
        qi, st = args
        kb = lax.dynamic_slice_in_dim(kp, st, span, axis=1)
        vb = lax.dynamic_slice_in_dim(vp, st, span, axis=1)
        tpos = st + jnp.arange(Q_BLOCK)
        kpos = st - WINDOW + jnp.arange(span)
        mask = ((kpos[None, :] >= 0) & (kpos[None, :] <= tpos[:, None]) &
                (tpos[:, None] - kpos[None, :] < WINDOW))
        s = jnp.einsum('bqgrd,bkgd->bgrqk', qi, kb).astype(jnp.float32) * scale
        p = masked_softmax(s, mask)
        return jnp.einsum('bgrqk,bkgd->bqgrd', p.astype(vb.dtype), vb)

    o = lax.map(one, (qb, starts))
    return jnp.moveaxis(o, 0, 1).reshape(B, S, G, R, D)


def chunked_gmlp(u, v, ln_g, ln_b, ws, bs):
    u = jax.nn.gelu(u)
    v = layer_norm(jax.nn.gelu(v), ln_g, ln_b)
    B, S, C = v.shape
    nch = S // GMLP_CHUNK
    cg = C // GMLP_GROUPS
    vr = v.reshape(B, nch, GMLP_CHUNK, GMLP_GROUPS, cg)
    tril = jnp.tril(jnp.ones((GMLP_CHUNK, GMLP_CHUNK), ws.dtype))
    mixed = jnp.einsum('gts,bcsgd->bctgd', ws * tril, vr) + jnp.transpose(bs)[None, None, :, :, None]
    return u * mixed.reshape(B, S, C)


def even_mixer(x, w_in, conv_w, conv_b, conv_ln_g, conv_ln_b, w_out):
    B, S, _ = x.shape
    q, k, v, a, g = split_cols(x @ w_in, EVEN_SPLITS)
    hs = (B, S, SB_HEADS, HEAD_DIM)
    o_sb = stick_breaking_attention(q.reshape(hs), k.reshape(hs), v.reshape(hs)).reshape(B, S, SB_WIDTH)
    o_cv = conformer_conv(a, g, conv_w, conv_b, conv_ln_g, conv_ln_b)
    return jnp.concatenate([o_sb, o_cv], axis=-1) @ w_out


def odd_mixer(x, w_in, cmpk_pos, cmpk_w1, cmpk_w2, cmpv_pos, cmpv_w1, cmpv_w2,
              gmlp_ln_g, gmlp_ln_b, gmlp_ws, gmlp_bs, w_out):
    B, S, _ = x.shape
    q, kc, vc, ks, vs, kw, vw, gt, u, v = split_cols(x @ w_in, ODD_SPLITS)
    q5 = q.reshape(B, S, NSA_KV_HEADS, NSA_GROUP, HEAD_DIM)
    kvs = (B, S, NSA_KV_HEADS, HEAD_DIM)
    o_cmp, imp = nsa_compressed(q5, kc.reshape(kvs), vc.reshape(kvs),
                                cmpk_pos, cmpk_w1, cmpk_w2, cmpv_pos, cmpv_w1, cmpv_w2)
    sel = select_blocks(imp)
    o_slc = nsa_selected(q5, ks.reshape(kvs), vs.reshape(kvs), sel)
    o_win = nsa_window(q5, kw.reshape(kvs), vw.reshape(kvs))
    gates = jax.nn.sigmoid(gt).reshape(B, S, NSA_KV_HEADS, NSA_GROUP, 3)
    o_nsa = (gates[..., 0:1] * o_cmp + gates[..., 1:2] * o_slc + gates[..., 2:3] * o_win).reshape(B, S, NSA_WIDTH)
    o_mlp = chunked_gmlp(u, v, gmlp_ln_g, gmlp_ln_b, gmlp_ws, gmlp_bs)
    return jnp.concatenate([o_nsa, o_mlp], axis=-1) @ w_out


def swiglu(x, w_gate, w_up, w_down):
    return (jax.nn.silu(x @ w_gate) * (x @ w_up)) @ w_down


def setup_inputs(seed: int = 0) -> dict:
    key = jax.random.key(seed)
    ks = jax.random.split(key, 32)
    ne = (DEPTH + 1) // 2
    no = DEPTH // 2

    def nrm(k, shape, scale):
        return jax.random.normal(k, shape, jnp.float32) * scale

    L = CMP_BLOCK
    return {
        "x": nrm(ks[0], (BATCH, SEQ, D_MODEL), 1.0),
        "ev_w_in": nrm(ks[1], (ne, D_MODEL, EVEN_IN), D_MODEL ** -0.5),
        "ev_conv_w": nrm(ks[2], (ne, CONV_WIDTH, CONV_CH), CONV_WIDTH ** -0.5),
        "ev_conv_b": nrm(ks[3], (ne, CONV_CH), 0.02),
        "ev_conv_ln_g": 1.0 + nrm(ks[4], (ne, CONV_CH), 0.02),
        "ev_conv_ln_b": nrm(ks[5], (ne, CONV_CH), 0.02),
        "ev_w_out": nrm(ks[6], (ne, MIX_OUT, D_MODEL), MIX_OUT ** -0.5 * OUT_INIT),
        "od_w_in": nrm(ks[7], (no, D_MODEL, ODD_IN), D_MODEL ** -0.5),
        "od_cmpk_pos": nrm(ks[8], (no, L, HEAD_DIM), 0.02),
        "od_cmpk_w1": nrm(ks[9], (no, L * HEAD_DIM, HEAD_DIM), (L * HEAD_DIM) ** -0.5),
        "od_cmpk_w2": nrm(ks[10], (no, HEAD_DIM, HEAD_DIM), HEAD_DIM ** -0.5),
        "od_cmpv_pos": nrm(ks[11], (no, L, HEAD_DIM), 0.02),
        "od_cmpv_w1": nrm(ks[12], (no, L * HEAD_DIM, HEAD_DIM), (L * HEAD_DIM) ** -0.5),
        "od_cmpv_w2": nrm(ks[13], (no, HEAD_DIM, HEAD_DIM), HEAD_DIM ** -0.5),
        "od_gmlp_ln_g": 1.0 + nrm(ks[14], (no, GMLP_WIDTH), 0.02),
        "od_gmlp_ln_b": nrm(ks[15], (no, GMLP_WIDTH), 0.02),
        "od_gmlp_ws": nrm(ks[16], (no, GMLP_GROUPS, GMLP_CHUNK, GMLP_CHUNK), GMLP_CHUNK ** -0.5),
        "od_gmlp_bs": 1.0 + nrm(ks[17], (no, GMLP_GROUPS, GMLP_CHUNK), 0.1),
        "od_w_out": nrm(ks[18], (no, MIX_OUT, D_MODEL), MIX_OUT ** -0.5 * OUT_INIT),
        "ffn_w_gate": nrm(ks[19], (DEPTH, D_MODEL, D_FF), D_MODEL ** -0.5),
        "ffn_w_up": nrm(ks[20], (DEPTH, D_MODEL, D_FF), D_MODEL ** -0.5),
        "ffn_w_down": nrm(ks[21], (DEPTH, D_FF, D_MODEL), D_FF ** -0.5 * OUT_INIT),
        "ln1_g": 1.0 + nrm(ks[22], (DEPTH, D_MODEL), 0.02),
        "ln1_b": nrm(ks[23], (DEPTH, D_MODEL), 0.02),
        "ln2_g": 1.0 + nrm(ks[24], (DEPTH, D_MODEL), 0.02),
        "ln2_b": nrm(ks[25], (DEPTH, D_MODEL), 0.02),
    }


def reference(x, ev_w_in, ev_conv_w, ev_conv_b, ev_conv_ln_g, ev_conv_ln_b, ev_w_out,
              od_w_in, od_cmpk_pos, od_cmpk_w1, od_cmpk_w2, od_cmpv_pos, od_cmpv_w1, od_cmpv_w2,
              od_gmlp_ln_g, od_gmlp_ln_b, od_gmlp_ws, od_gmlp_bs, od_w_out,
              ffn_w_gate, ffn_w_up, ffn_w_down, ln1_g, ln1_b, ln2_g, ln2_b):
    for layer in range(DEPTH):
        i = layer // 2
        if layer % 2 == 0:
            m = even_mixer(x, ev_w_in[i], ev_conv_w[i], ev_conv_b[i], ev_conv_ln_g[i],
                           ev_conv_ln_b[i], ev_w_out[i])
        else:
            m = odd_mixer(x, od_w_in[i], od_cmpk_pos[i], od_cmpk_w1[i], od_cmpk_w2[i],
                          od_cmpv_pos[i], od_cmpv_w1[i], od_cmpv_w2[i], od_gmlp_ln_g[i],
                          od_gmlp_ln_b[i], od_gmlp_ws[i], od_gmlp_bs[i], od_w_out[i])
        x = layer_norm(ALPHA * x + m, ln1_g[layer], ln1_b[layer])
        x = layer_norm(ALPHA * x + swiglu(x, ffn_w_gate[layer], ffn_w_up[layer], ffn_w_down[layer]),
                       ln2_g[layer], ln2_b[layer])
    return x
```

```cpp
#include <hip/hip_runtime.h>
#include <hip/hip_cooperative_groups.h>
#include <cstdio>
#include <cstdint>
namespace cg = cooperative_groups;
namespace pg8 {
#define PG8_LAS __attribute__((address_space(3)))
typedef unsigned short bf16_t;
typedef short bf16x8 __attribute__((ext_vector_type(8)));
typedef float f32x4 __attribute__((ext_vector_type(4)));
typedef unsigned u32x4 __attribute__((ext_vector_type(4)));
constexpr int BM = 256, BK = 64, HALF = 128, HTB = HALF * BK * 2  , STAGE_BYTES = 8 * HTB, NXCD = 8, WGM = 8;

__host__ __device__ __forceinline__ int lds_byte(int r, int c) { const int st = (r >> 4) * 2 + (c >> 5), rr = r & 15, cc = c & 31, ob = rr * 64 + cc * 2; return st * 1024 + (ob ^ (((ob >> 9) & 1) << 5)); }
__host__ __device__ __forceinline__ void stage_rc(int b, int& R, int& C) { const int st = b / 1024, sb = b % 1024, swz = sb ^ (((sb >> 9) & 1) << 5); R = (st >> 1) * 16 + swz / 64; C = (st & 1) * 32 + (swz % 64) / 2; }
__host__ __device__ __forceinline__ int perm32(int rho) { const int n = rho >> 4, i = rho & 15; return 8 * (i >> 2) + 4 * n + (i & 3); }

struct Unit { int pm, pn; };
struct Gemm { const bf16_t* A; const bf16_t* Bt; int M, N, K; };

struct StaticOrder {
    int nM, nN, nwg, G, c;
    __host__ __device__ void init(int M, int N, int G_, int c_) { nM = M / BM; nN = N / BM; nwg = nM * nN; G = G_; c = c_; }
    __host__ __device__ bool next(int i, Unit& u) const {
        const long L = (long)i * G + c; if (L >= nwg) return false;
        int wgid = (int)L; { const int q = nwg / NXCD, r = nwg % NXCD, xcd = wgid % NXCD, off = wgid / NXCD; wgid = (xcd < r ? xcd * (q + 1) : r * (q + 1) + (xcd - r) * q) + off; }
        const int nig = WGM * nN, gid = wgid / nig, fm = gid * WGM, gsz = (nM - fm) < WGM ? (nM - fm) : WGM;
        u.pm = fm + ((wgid % nig) % gsz); u.pn = (wgid % nig) / gsz; return true;
    }
    __device__ __forceinline__ void a_ready(const Unit&) const {}
    __device__ __forceinline__ void done(const Unit&) const {}
};

__device__ __forceinline__ unsigned cvt_pk_bf16(float lo, float hi) { unsigned r; asm volatile("v_cvt_pk_bf16_f32 %0, %1, %2" : "=v"(r) : "v"(lo), "v"(hi)); return r; }
typedef float f32x2 __attribute__((ext_vector_type(2)));
__device__ __forceinline__ f32x2 gelu_pk(f32x2 v) {
    const f32x2 av = __builtin_elementwise_abs(v), d = av * 0.2316418882f + 1.0f;
    f32x2 t; t.x = __builtin_amdgcn_rcpf(d.x); t.y = __builtin_amdgcn_rcpf(d.y);
    f32x2 q = t * 0.5307027145f + (-0.7265760135f); q = q * t + 0.7107068705f; q = q * t + (-0.142248368f); q = q * t + 0.127414796f; q = q * t;
    const f32x2 s = (v * v) * (-0.72134752044f);
    f32x2 e; e.x = __builtin_amdgcn_exp2f(s.x); e.y = __builtin_amdgcn_exp2f(s.y);
    const f32x2 m = v * (q * e), r = v - m;
    f32x2 o; o.x = v.x < 0.f ? m.x : r.x; o.y = v.y < 0.f ? m.y : r.y; return o;
}

template <int ACT  > struct EpiBf16 {
    static constexpr bool PERM = true, AFTER_DRAIN = false; static_assert(ACT == 0 || ACT == 1, "EpiBf16: ACT is 0 (none) or 1 (gelu_pk)");
    bf16_t* O; int ldc; const float* bias; int split_cols; size_t split_stride; float scale0;
    __device__ __forceinline__ void operator()(const f32x4 (&acc)[2][2][4][2], const Unit& u, int wr, int wc, int fr, int fq) const {
        const int row0 = u.pm * BM + wr * 64 + fr; int colt = u.pn * BM; bf16_t* base = O;
        float sc = 1.f; if (split_cols) { const int t = colt / split_cols; base += (size_t)t * split_stride; colt -= t * split_cols; if (t == 0) sc = scale0; }
        const int col0 = colt + wc * 32 + 8 * fq, bcol0 = u.pn * BM + wc * 32 + 8 * fq;
        f32x4 bv[2][2];
#pragma unroll
        for (int bj = 0; bj < 2; ++bj)
#pragma unroll
            for (int n = 0; n < 2; ++n) bv[bj][n] = bias ? *(const f32x4*)(bias + bcol0 + bj * HALF + 4 * n) : (f32x4){0.f, 0.f, 0.f, 0.f};
#pragma unroll
        for (int ai = 0; ai < 2; ++ai)
#pragma unroll
            for (int m = 0; m < 4; ++m) { bf16_t* rowp = base + (size_t)(row0 + ai * HALF + m * 16) * ldc + col0;
#pragma unroll
                for (int bj = 0; bj < 2; ++bj) { f32x4 v0 = acc[ai][bj][m][0] + bv[bj][0], v1 = acc[ai][bj][m][1] + bv[bj][1];
                    if (ACT == 1) { f32x2 a = gelu_pk((f32x2){v0[0], v0[1]}), b = gelu_pk((f32x2){v0[2], v0[3]}), c = gelu_pk((f32x2){v1[0], v1[1]}), d = gelu_pk((f32x2){v1[2], v1[3]});
                        v0 = (f32x4){a.x, a.y, b.x, b.y}; v1 = (f32x4){c.x, c.y, d.x, d.y}; }
                    v0 = v0 * sc; v1 = v1 * sc; u32x4 w; w.x = cvt_pk_bf16(v0[0], v0[1]); w.y = cvt_pk_bf16(v0[2], v0[3]); w.z = cvt_pk_bf16(v1[0], v1[1]); w.w = cvt_pk_bf16(v1[2], v1[3]);
                    *(u32x4*)(rowp + bj * HALF) = w; } }
    }
};

struct PanelStats {
    unsigned* xbuf;
    unsigned* cnt;
    unsigned* tmo;
    int ntn; float eps;
    unsigned code;
    __device__ __forceinline__ bool run(const f32x4 (&v)[2][2][4][2], const Unit& u, int wr, int wc, int fr, int fq, PG8_LAS unsigned char* lds, int wid, int lane) const {
        typedef float f32x2v __attribute__((ext_vector_type(2)));
        PG8_LAS f32x2v* P = (PG8_LAS f32x2v*)lds;
        PG8_LAS f32x2v* S = (PG8_LAS f32x2v*)(lds + 8192);
        PG8_LAS unsigned* flag = (PG8_LAS unsigned*)(lds + 8192 + 2048);
#pragma unroll
        for (int ai = 0; ai < 2; ++ai)
#pragma unroll
            for (int m = 0; m < 4; ++m) {
                float s = 0.f;
#pragma unroll
                for (int bj = 0; bj < 2; ++bj)
#pragma unroll
                    for (int n = 0; n < 2; ++n) { const f32x4 x = v[ai][bj][m][n]; s += (x[0] + x[1]) + (x[2] + x[3]); }
                s += __shfl_xor(s, 16); s += __shfl_xor(s, 32);
                const float mw = s * (1.0f / 64.0f); float q = 0.f;
#pragma unroll
                for (int bj = 0; bj < 2; ++bj)
#pragma unroll
                    for (int n = 0; n < 2; ++n) { const f32x4 d = v[ai][bj][m][n] - mw; q += (d[0] * d[0] + d[1] * d[1]) + (d[2] * d[2] + d[3] * d[3]); }
                q += __shfl_xor(q, 16); q += __shfl_xor(q, 32);
                if (fq == 0) P[(ai * HALF + wr * 64 + m * 16 + fr) * 4 + wc] = (f32x2v){mw, q};
            }
        asm volatile("s_waitcnt lgkmcnt(0)" ::: "memory"); __builtin_amdgcn_s_barrier(); asm volatile("" ::: "memory");
#if defined(BROKEN_EXCHANGE_NO_WAIT)
#warning BROKEN CONTROL BUILD: the row-statistics exchange does not wait; results are wrong by design
        if (blockIdx.x >= 64) { const long long t0_ = clock64(); while (clock64() - t0_ < 60000) __builtin_amdgcn_s_sleep(8); }
#endif
        const int row = wid * 32 + (lane & 31);
        if (lane < 32) {
            const f32x2v a = P[row * 4 + 0], b = P[row * 4 + 1], c = P[row * 4 + 2], d = P[row * 4 + 3];
            const float mt = (a.x + b.x + c.x + d.x) * 0.25f;
            const float da = a.x - mt, db = b.x - mt, dc = c.x - mt, dd = d.x - mt;
            const float m2 = (a.y + b.y) + (c.y + d.y) + 64.0f * ((da * da + db * db) + (dc * dc + dd * dd));
            unsigned long long* slot = (unsigned long long*)xbuf + ((size_t)(u.pm * BM + row) * 4 + u.pn);
            __hip_atomic_store(slot, ((unsigned long long)__float_as_uint(m2) << 32) | __float_as_uint(mt), __ATOMIC_RELAXED, __HIP_MEMORY_SCOPE_AGENT);
        }
        asm volatile("s_waitcnt vmcnt(0)" ::: "memory");
        if (lane == 0) __hip_atomic_fetch_add(cnt + 64 * u.pm, 1u, __ATOMIC_RELAXED, __HIP_MEMORY_SCOPE_AGENT);
        if (wid == 0) {
            bool dead = false; const unsigned long long t0 = __builtin_amdgcn_s_memrealtime(); const unsigned want = 8u * (unsigned)ntn;
            for (;;) {
#if defined(BROKEN_EXCHANGE_NO_WAIT)
                break;
#endif
                if ((unsigned)__builtin_amdgcn_readfirstlane(__hip_atomic_load(cnt + 64 * u.pm, __ATOMIC_RELAXED, __HIP_MEMORY_SCOPE_AGENT)) >= want) break;
                if (__builtin_amdgcn_s_memrealtime() - t0 > 2000000ull) {
                    if (lane == 0) { unsigned expect = 0u; __hip_atomic_compare_exchange_strong(tmo + 1, &expect, code | (unsigned)(u.pm & 0xff), __ATOMIC_RELAXED, __ATOMIC_RELAXED, __HIP_MEMORY_SCOPE_AGENT);
                                     __hip_atomic_store(tmo, 1u, __ATOMIC_RELAXED, __HIP_MEMORY_SCOPE_AGENT); }
                    dead = true; break; }
                __builtin_amdgcn_s_sleep(2);
            }
            __builtin_amdgcn_fence(__ATOMIC_ACQUIRE, "agent");
            if (lane == 0) flag[0] = dead ? 1u : 0u;
        }
        asm volatile("s_waitcnt vmcnt(0) lgkmcnt(0)" ::: "memory"); __builtin_amdgcn_s_barrier(); asm volatile("" ::: "memory");
        const bool bad = flag[0] != 0u;
        if (lane < 32) {
            const unsigned long long* slot = (const unsigned long long*)xbuf + (size_t)(u.pm * BM + row) * 4; float mt[4], m2[4]; float ms = 0.f;
#pragma unroll
            for (int t = 0; t < 4; ++t) { if (t < ntn) { const unsigned long long w = __hip_atomic_load(slot + t, __ATOMIC_RELAXED, __HIP_MEMORY_SCOPE_AGENT); mt[t] = __uint_as_float((unsigned)w); m2[t] = __uint_as_float((unsigned)(w >> 32)); } else { mt[t] = 0.f; m2[t] = 0.f; } ms += mt[t]; }
            const float mean = ms / (float)ntn; float q = 0.f;
#pragma unroll
            for (int t = 0; t < 4; ++t) if (t < ntn) { const float dm = mt[t] - mean; q += m2[t] + 256.0f * dm * dm; }
            S[row] = (f32x2v){mean, 1.0f / sqrtf(q / (256.0f * (float)ntn) + eps)};
        }
        asm volatile("s_waitcnt lgkmcnt(0)" ::: "memory"); __builtin_amdgcn_s_barrier(); asm volatile("" ::: "memory");
        return bad;
    }
};
struct EpiLnRes {
    static constexpr bool PERM = false, AFTER_DRAIN = true;
    const float* base; float* out; int ldc; const float* bias; PanelStats st; unsigned poison;
    __device__ __forceinline__ void fused(f32x4 (&acc)[2][2][4][2], const Unit& u, int wr, int wc, int fr, int fq, PG8_LAS unsigned char* lds, int wid, int lane) const {
        typedef float f32x2v __attribute__((ext_vector_type(2)));
        const PG8_LAS f32x2v* S = (const PG8_LAS f32x2v*)(lds + 8192);
        const int col0 = u.pn * BM + wc * 32 + 4 * fq;
#pragma unroll
        for (int bj = 0; bj < 2; ++bj)
#pragma unroll
            for (int n = 0; n < 2; ++n) { const f32x4 bv = bias ? *(const f32x4*)(bias + col0 + bj * HALF + n * 16) : (f32x4){0.f, 0.f, 0.f, 0.f};
#pragma unroll
                for (int ai = 0; ai < 2; ++ai)
#pragma unroll
                    for (int m = 0; m < 4; ++m) acc[ai][bj][m][n] += bv; }
        f32x4 pre[4][2][2];
#pragma unroll
        for (int m = 0; m < 4; ++m) { const size_t off = (size_t)(u.pm * BM + wr * 64 + m * 16 + fr) * ldc + col0;
#pragma unroll
            for (int bj = 0; bj < 2; ++bj)
#pragma unroll
                for (int n = 0; n < 2; ++n) pre[m][bj][n] = *(const f32x4*)(base + off + bj * HALF + n * 16); }
        const bool bad = st.run(acc, u, wr, wc, fr, fq, lds, wid, lane) || poison != 0u;
        const float qnan = __builtin_nanf("");
#pragma unroll
        for (int ai = 0; ai < 2; ++ai)
#pragma unroll
            for (int m = 0; m < 4; ++m) { const int r = ai * HALF + wr * 64 + m * 16 + fr; const f32x2v sr = S[r]; const size_t off = (size_t)(u.pm * BM + r) * ldc + col0;
#pragma unroll
                for (int bj = 0; bj < 2; ++bj)
#pragma unroll
                    for (int n = 0; n < 2; ++n) { const f32x4 bs = ai == 0 ? pre[m][bj][n] : *(const f32x4*)(base + off + bj * HALF + n * 16); f32x4 o = bs + (acc[ai][bj][m][n] - sr.x) * sr.y;
                        if (bad) o = (f32x4){qnan, qnan, qnan, qnan}; *(f32x4*)(out + off + bj * HALF + n * 16) = o; }
                if (m & 1) asm volatile("" ::: "memory"); }
    }
};
struct EpiLnResLn {
    static constexpr bool PERM = false, AFTER_DRAIN = true;
    const float* base; float* out; bf16_t* xn; int ldc; const float* bias; PanelStats st1, st2; unsigned poison;
    __device__ __forceinline__ void fused(f32x4 (&acc)[2][2][4][2], const Unit& u, int wr, int wc, int fr, int fq, PG8_LAS unsigned char* lds, int wid, int lane) const {
        typedef float f32x2v __attribute__((ext_vector_type(2))); typedef unsigned u32x2v __attribute__((ext_vector_type(2)));
        const PG8_LAS f32x2v* S = (const PG8_LAS f32x2v*)(lds + 8192);
        const int col0 = u.pn * BM + wc * 32 + 4 * fq;
#pragma unroll
        for (int bj = 0; bj < 2; ++bj)
#pragma unroll
            for (int n = 0; n < 2; ++n) { const f32x4 bv = bias ? *(const f32x4*)(bias + col0 + bj * HALF + n * 16) : (f32x4){0.f, 0.f, 0.f, 0.f};
#pragma unroll
                for (int ai = 0; ai < 2; ++ai)
#pragma unroll
                    for (int m = 0; m < 4; ++m) acc[ai][bj][m][n] += bv; }
        bool bad = st1.run(acc, u, wr, wc, fr, fq, lds, wid, lane) || poison != 0u;
        const float qnan = __builtin_nanf("");
#pragma unroll
        for (int ai = 0; ai < 2; ++ai)
#pragma unroll
            for (int m = 0; m < 4; ++m) { const int r = ai * HALF + wr * 64 + m * 16 + fr; const f32x2v sr = S[r]; const size_t off = (size_t)(u.pm * BM + r) * ldc + col0;
#pragma unroll
                for (int bj = 0; bj < 2; ++bj)
#pragma unroll
                    for (int n = 0; n < 2; ++n) { const f32x4 bs = *(const f32x4*)(base + off + bj * HALF + n * 16); acc[ai][bj][m][n] = bs + (acc[ai][bj][m][n] - sr.x) * sr.y; }
                asm volatile("" : "+v"(acc[ai][0][m][0]), "+v"(acc[ai][0][m][1]), "+v"(acc[ai][1][m][0]), "+v"(acc[ai][1][m][1]));
                if (m & 1) asm volatile("" ::: "memory"); }
        const bool bad1 = bad;
        bad = st2.run(acc, u, wr, wc, fr, fq, lds, wid, lane) || bad;
#pragma unroll
        for (int ai = 0; ai < 2; ++ai)
#pragma unroll
            for (int m = 0; m < 4; ++m) { const int r = ai * HALF + wr * 64 + m * 16 + fr; const f32x2v sr = S[r]; const size_t off = (size_t)(u.pm * BM + r) * ldc + col0;
#pragma unroll
                for (int bj = 0; bj < 2; ++bj)
#pragma unroll
                    for (int n = 0; n < 2; ++n) { const f32x4 x1 = acc[ai][bj][m][n]; *(f32x4*)(out + off + bj * HALF + n * 16) = bad1 ? (f32x4){qnan, qnan, qnan, qnan} : x1;
                        const f32x4 o = (x1 - sr.x) * sr.y; u32x2v w; w.x = cvt_pk_bf16(o[0], o[1]); w.y = cvt_pk_bf16(o[2], o[3]);
                        if (bad) { w.x = 0x7fc07fc0u; w.y = 0x7fc07fc0u; } *(u32x2v*)(xn + off + bj * HALF + n * 16) = w; }
                asm volatile("" ::: "memory"); }
    }
};

template <class Epi, class Sched, bool ALIGN_EPI = false, bool SP2 = false>
__device__ __forceinline__ void gemm_phase(PG8_LAS unsigned char* lds, const Gemm g, const Sched& S, const Epi& E) {
    int tid_ = threadIdx.x; asm volatile("" : "+v"(tid_)); const int tid = tid_, wid = __builtin_amdgcn_readfirstlane(tid >> 6), lane = tid & 63, wr = wid >> 2, wc = wid & 3, fr = lane & 15, fq = lane >> 4;
    const int K = g.K, nt = K / BK;
    unsigned voffA[2], voffB[2];
#pragma unroll
    for (int i = 0; i < 2; ++i) { int R, C; stage_rc(tid * 16 + i * 8192, R, C); const int Rb = Epi::PERM ? ((R & ~31) + perm32(R & 31)) : R;
        voffA[i] = (unsigned)(R * K + C) * 2u; voffB[i] = (unsigned)(Rb * K + C) * 2u; }
    const size_t kstep = (size_t)(BK * 2);
    const size_t hstep = (size_t)HALF * K * 2;
    const size_t tstep = 2 * hstep;
    const unsigned ldsw = (unsigned)wid * 1024u;
    const int aoff = lds_byte(wr * 64 + fr, fq * 8), boff = lds_byte(wc * 32 + fr, fq * 8);
#define PG8_SA(b, h) (((b) * 2 + (h)) * HTB)
#define PG8_SB(b, h) ((4 + (b) * 2 + (h)) * HTB)
#define PG8_STAGE(bufoff, gbase, voff) do { _Pragma("unroll") for (int _i = 0; _i < 2; ++_i) \
        __builtin_amdgcn_global_load_lds((const unsigned*)((const char*)(gbase) + (voff)[_i]), (PG8_LAS unsigned*)(lds + (bufoff) + ldsw + _i * 8192), 16, 0, 0); } while (0)
#define PG8_LDA(dst, b, h) do { _Pragma("unroll") for (int m = 0; m < 4; ++m) _Pragma("unroll") for (int k = 0; k < 2; ++k) dst[m][k] = *(const PG8_LAS bf16x8*)(lds + PG8_SA(b, h) + aoff + m * 2048 + k * 1024); } while (0)
#define PG8_LDB(dst, b, h) do { _Pragma("unroll") for (int n = 0; n < 2; ++n) _Pragma("unroll") for (int k = 0; k < 2; ++k) dst[n][k] = *(const PG8_LAS bf16x8*)(lds + PG8_SB(b, h) + boff + n * 2048 + k * 1024); } while (0)
#define PG8_MMA(ai, bj, At, Bt) do { __builtin_amdgcn_s_setprio(1); _Pragma("unroll") for (int m = 0; m < 4; ++m) _Pragma("unroll") for (int n = 0; n < 2; ++n) _Pragma("unroll") for (int k = 0; k < 2; ++k) \
        acc[ai][bj][m][n] = __builtin_amdgcn_mfma_f32_16x16x32_bf16(Bt[n][k], At[m][k], acc[ai][bj][m][n], 0, 0, 0); __builtin_amdgcn_s_setprio(0); } while (0)
#define PG8_WAIT_V(n) asm volatile("s_waitcnt vmcnt(" #n ")" ::: "memory")
#define PG8_WAIT_L(n) asm volatile("s_waitcnt lgkmcnt(" #n ")" ::: "memory")
#define PG8_BAR __builtin_amdgcn_s_barrier()
#define PG8_SCHED __builtin_amdgcn_sched_barrier(0)
    Unit cur, nxt; int ui = 0;
    if (!S.next(0, cur)) return;
    f32x4 acc[2][2][4][2];
#pragma unroll
    for (int a = 0; a < 2; ++a)
#pragma unroll
        for (int b = 0; b < 2; ++b)
#pragma unroll
            for (int m = 0; m < 4; ++m)
#pragma unroll
                for (int n = 0; n < 2; ++n) acc[a][b][m][n] = (f32x4){0.f, 0.f, 0.f, 0.f};
    bf16x8 At[4][2], B0[2][2], B1[2][2];
    const char* cA = (const char*)g.A + (size_t)cur.pm * tstep; const char* cB = (const char*)g.Bt + (size_t)cur.pn * tstep;
    S.a_ready(cur);
    if constexpr (SP2) {
        PG8_STAGE(PG8_SB(0, 0), cB, voffB); PG8_STAGE(PG8_SB(0, 1), cB + hstep, voffB); PG8_STAGE(PG8_SA(0, 0), cA, voffA); PG8_STAGE(PG8_SA(0, 1), cA + hstep, voffA);
        if (wr == 1) PG8_BAR;
        PG8_WAIT_V(2); PG8_BAR;
        PG8_STAGE(PG8_SB(1, 0), cB + kstep, voffB); PG8_STAGE(PG8_SA(1, 0), cA + kstep, voffA); PG8_STAGE(PG8_SB(1, 1), cB + hstep + kstep, voffB);
        PG8_WAIT_V(6); PG8_BAR;
    } else {
        PG8_STAGE(PG8_SB(0, 0), cB, voffB); PG8_STAGE(PG8_SA(0, 0), cA, voffA); PG8_STAGE(PG8_SB(0, 1), cB + hstep, voffB); PG8_STAGE(PG8_SA(0, 1), cA + hstep, voffA);
        if (wr == 1) PG8_BAR;
        PG8_WAIT_V(4); PG8_BAR;
        PG8_STAGE(PG8_SB(1, 0), cB + kstep, voffB); PG8_STAGE(PG8_SA(1, 0), cA + kstep, voffA); PG8_STAGE(PG8_SB(1, 1), cB + hstep + kstep, voffB);
        PG8_WAIT_V(6); PG8_BAR;
    }
    for (;;) {
        const bool has_next = S.next(ui + 1, nxt);
        const char* nA = has_next ? (const char*)g.A + (size_t)nxt.pm * tstep : cA; const char* nB = has_next ? (const char*)g.Bt + (size_t)nxt.pn * tstep : cB;
        for (int t = 0; t < nt; t += 2) {
            const bool last = (t == nt - 2);
            const char* a1 = cA + (size_t)(t + 1) * kstep;
            const char* a2 = last ? nA : cA + (size_t)(t + 2) * kstep; const char* b2 = last ? nB : cB + (size_t)(t + 2) * kstep;
            const char* a3 = a2 + kstep; const char* b3 = b2 + kstep;
            if (last && has_next) S.a_ready(nxt);
            if constexpr (SP2) {
            PG8_LDB(B0, 0, 0); PG8_LDB(B1, 0, 1); PG8_SCHED; PG8_LDA(At, 0, 0); PG8_STAGE(PG8_SA(1, 1), a1 + hstep, voffA);
            PG8_WAIT_V(8); PG8_WAIT_L(0); PG8_BAR; PG8_MMA(0, 0, At, B0); PG8_MMA(0, 1, At, B1); PG8_BAR; PG8_SCHED;
            PG8_LDA(At, 0, 1); PG8_STAGE(PG8_SB(0, 0), b2, voffB); PG8_STAGE(PG8_SB(0, 1), b2 + hstep, voffB); PG8_STAGE(PG8_SA(0, 0), a2, voffA);
            PG8_WAIT_V(8); PG8_WAIT_L(0); PG8_BAR; PG8_MMA(1, 0, At, B0); PG8_MMA(1, 1, At, B1); PG8_BAR; PG8_SCHED;
            PG8_LDB(B0, 1, 0); PG8_LDB(B1, 1, 1); PG8_SCHED; PG8_LDA(At, 1, 0); PG8_STAGE(PG8_SA(0, 1), a2 + hstep, voffA);
            PG8_WAIT_V(8); PG8_WAIT_L(0); PG8_BAR; PG8_MMA(0, 0, At, B0); PG8_MMA(0, 1, At, B1); PG8_BAR; PG8_SCHED;
            PG8_LDA(At, 1, 1); PG8_STAGE(PG8_SB(1, 0), b3, voffB); PG8_STAGE(PG8_SB(1, 1), b3 + hstep, voffB); PG8_STAGE(PG8_SA(1, 0), a3, voffA);
            PG8_WAIT_V(8); PG8_WAIT_L(0); PG8_BAR; PG8_MMA(1, 0, At, B0); PG8_MMA(1, 1, At, B1); PG8_BAR; PG8_SCHED;
            } else {
            PG8_LDB(B0, 0, 0); PG8_SCHED; PG8_LDA(At, 0, 0); PG8_STAGE(PG8_SA(1, 1), a1 + hstep, voffA);
            PG8_WAIT_L(8); PG8_BAR; PG8_WAIT_L(0); PG8_MMA(0, 0, At, B0); PG8_BAR; PG8_SCHED;
            PG8_LDB(B1, 0, 1); PG8_STAGE(PG8_SB(0, 0), b2, voffB);
            PG8_BAR; PG8_WAIT_L(0); PG8_MMA(0, 1, At, B1); PG8_BAR;
            PG8_LDA(At, 0, 1); PG8_STAGE(PG8_SA(0, 0), a2, voffA);
            PG8_BAR; PG8_WAIT_L(0); PG8_MMA(1, 0, At, B0); PG8_BAR; PG8_SCHED;
            PG8_STAGE(PG8_SB(0, 1), b2 + hstep, voffB);
            PG8_WAIT_V(6); PG8_BAR; PG8_MMA(1, 1, At, B1); PG8_BAR;
            PG8_LDB(B0, 1, 0); PG8_SCHED; PG8_LDA(At, 1, 0); PG8_STAGE(PG8_SA(0, 1), a2 + hstep, voffA);
            PG8_WAIT_L(8); PG8_BAR; PG8_WAIT_L(0); PG8_MMA(0, 0, At, B0); PG8_BAR; PG8_SCHED;
            PG8_LDB(B1, 1, 1); PG8_STAGE(PG8_SB(1, 0), b3, voffB);
            PG8_BAR; PG8_WAIT_L(0); PG8_MMA(0, 1, At, B1); PG8_BAR;
            PG8_LDA(At, 1, 1); PG8_STAGE(PG8_SA(1, 0), a3, voffA);
            PG8_BAR; PG8_WAIT_L(0); PG8_MMA(1, 0, At, B0); PG8_BAR; PG8_SCHED;
            PG8_STAGE(PG8_SB(1, 1), b3 + hstep, voffB);
            PG8_WAIT_V(6); PG8_BAR; PG8_MMA(1, 1, At, B1); PG8_BAR;
            }
        }
        if constexpr (ALIGN_EPI) { if (wr == 0) PG8_BAR; }
        if constexpr (!Epi::AFTER_DRAIN) { E(acc, cur, wr, wc, fr, fq); S.done(cur); }
        if (!has_next) break;
#pragma unroll
        for (int a = 0; a < 2; ++a)
#pragma unroll
            for (int b = 0; b < 2; ++b)
#pragma unroll
                for (int m = 0; m < 4; ++m)
#pragma unroll
                    for (int n = 0; n < 2; ++n) acc[a][b][m][n] = (f32x4){0.f, 0.f, 0.f, 0.f};
        cur = nxt; cA = nA; cB = nB; ++ui;
        if constexpr (ALIGN_EPI) { if (wr == 1) PG8_BAR; }
    }
    PG8_WAIT_V(0);
    if constexpr (!ALIGN_EPI) { if (wr == 0) PG8_BAR; }
    PG8_BAR;
    if constexpr (Epi::AFTER_DRAIN) { E.fused(acc, cur, wr, wc, fr, fq, lds, wid, lane); S.done(cur); }
#undef PG8_SA
#undef PG8_SB
#undef PG8_STAGE
#undef PG8_LDA
#undef PG8_LDB
#undef PG8_MMA
#undef PG8_WAIT_V
#undef PG8_WAIT_L
#undef PG8_BAR
#undef PG8_SCHED
}
}

#ifdef XSB
#define DIS_SB(x)
#else
#define DIS_SB(x) x
#endif
#ifdef XCONV
#define DIS_CONV(x)
#else
#define DIS_CONV(x) x
#endif
#ifdef XCMP
#define DIS_CMP(x)
#else
#define DIS_CMP(x) x
#endif
#ifdef XGMLP
#define DIS_GMLP(x)
#else
#define DIS_GMLP(x) x
#endif
#ifdef XNSA
#define DIS_NSA(x)
#else
#define DIS_NSA(x) x
#endif
#ifdef XGEMM
#define DIS_GEMM(x)
#else
#define DIS_GEMM(x) x
#endif

#define LAS __attribute__((address_space(3)))
typedef unsigned short bf16_t;
typedef short bf16x8 __attribute__((ext_vector_type(8)));
typedef short s16x4 __attribute__((ext_vector_type(4)));
typedef short v4i16_t __attribute__((ext_vector_type(4)));
typedef float f32x4 __attribute__((ext_vector_type(4)));
typedef float f32x16 __attribute__((ext_vector_type(16)));
typedef unsigned u32x4 __attribute__((ext_vector_type(4)));
typedef unsigned u32x2 __attribute__((ext_vector_type(2)));

constexpr int NB = 16, SEQ = 2048, DM = 1024, MTOK = NB * SEQ;
constexpr int HW = 2560;
constexpr int FF = 2816;
constexpr float ALPHA = 1.41421356237309515f;
constexpr float LN_EPS = 1e-5f;
constexpr float LOG2E = 1.4426950408889634f;
constexpr float C2 = 0.125f * LOG2E;

constexpr size_t MiB = 1u << 20;
constexpr size_t WS_IN0 = 0 * MiB, WS_OUT0 = 6 * MiB, WS_IN1 = 8 * MiB, WS_OUT1 = 14 * MiB;
constexpr size_t WS_GU0 = 16 * MiB, WS_GU1 = 28 * MiB, WS_DN0 = 40 * MiB, WS_DN1 = 46 * MiB;
constexpr size_t WS_W1TK = 52 * MiB, WS_W1TV = 53 * MiB, WS_TRIL = 54 * MiB, WS_KCMP = 55 * MiB, WS_VCMP = 56 * MiB;
constexpr size_t WS_XB = 64 * MiB, WS_H = 128 * MiB, WS_MIX = 304 * MiB, WS_MB = 368 * MiB, WS_END = 432 * MiB;

constexpr int LDS_BYTES = 147456;

struct Params { const float* in[26]; float* out; unsigned char* ws; };
__device__ __forceinline__ int opaque_tid() { int t = threadIdx.x; asm volatile("" : "+v"(t)); return t; }

__device__ __forceinline__ unsigned f2bf(float f) { unsigned u = __builtin_bit_cast(unsigned, f); return (u + 0x7fffu + ((u >> 16) & 1u)) >> 16; }
__device__ __forceinline__ unsigned pk2(float lo, float hi) { return pg8::cvt_pk_bf16(lo, hi); }
__device__ __forceinline__ float bf2f(unsigned b) { return __builtin_bit_cast(float, b << 16); }
__device__ __forceinline__ float bflo(unsigned w) { return __builtin_bit_cast(float, w << 16); }
__device__ __forceinline__ float bfhi(unsigned w) { return __builtin_bit_cast(float, w & 0xffff0000u); }
__device__ __forceinline__ float wave_sum(float v) {
#pragma unroll
    for (int o = 1; o < 64; o <<= 1) v += __shfl_xor(v, o);
    return v;
}
__device__ __forceinline__ float xor32(float v) { return __shfl_xor(v, 32); }
__device__ __forceinline__ float sigmoidf_(float x) { return 1.f / (1.f + __expf(-x)); }
__device__ __forceinline__ float siluf_(float x) { return x / (1.f + __expf(-x)); }
__device__ __forceinline__ float gelu_tanh(float x) {
    const float u = 0.7978845608028654f * (x + 0.044715f * x * x * x);
    const float t = 1.f - 2.f / (1.f + __expf(2.f * u));
    return 0.5f * x * (1.f + t);
}
#define LDSW() asm volatile("s_waitcnt lgkmcnt(0)" ::: "memory")
#define MFMA32(a, b, c) __builtin_amdgcn_mfma_f32_32x32x16_bf16((a), (b), (c), 0, 0, 0)
__device__ __forceinline__ int crow(int r, int hi) { return (r & 3) + 8 * (r >> 2) + 4 * hi; }

struct EpiStore {
    static constexpr bool PERM = true, AFTER_DRAIN = false;
    bf16_t* O; int ldc;
    __device__ __forceinline__ void operator()(const pg8::f32x4 (&acc)[2][2][4][2], const pg8::Unit& u, int wr, int wc, int fr, int fq) const {
        const int row0 = u.pm * 256 + wr * 64 + fr, col0 = u.pn * 256 + wc * 32 + 8 * fq;
#pragma unroll
        for (int ai = 0; ai < 2; ++ai)
#pragma unroll
            for (int m = 0; m < 4; ++m) { bf16_t* rowp = O + (size_t)(row0 + ai * 128 + m * 16) * ldc + col0;
#pragma unroll
                for (int bj = 0; bj < 2; ++bj) { const pg8::f32x4 v0 = acc[ai][bj][m][0], v1 = acc[ai][bj][m][1];
                    u32x4 w; w.x = pk2(v0[0], v0[1]); w.y = pk2(v0[2], v0[3]); w.z = pk2(v1[0], v1[1]); w.w = pk2(v1[2], v1[3]);
                    *(u32x4*)(rowp + bj * 128) = w; } }
    }
};
struct EpiSwiglu {
    static constexpr bool PERM = true, AFTER_DRAIN = false;
    bf16_t* O; int ldc;
    __device__ __forceinline__ void operator()(const pg8::f32x4 (&acc)[2][2][4][2], const pg8::Unit& u, int wr, int wc, int fr, int fq) const {
        const int row0 = u.pm * 256 + wr * 64 + fr, col0 = u.pn * 128 + wc * 16 + 4 * fq;
#pragma unroll
        for (int ai = 0; ai < 2; ++ai)
#pragma unroll
            for (int m = 0; m < 4; ++m) { bf16_t* rowp = O + (size_t)(row0 + ai * 128 + m * 16) * ldc + col0;
#pragma unroll
                for (int bj = 0; bj < 2; ++bj) { const pg8::f32x4 gv = acc[ai][bj][m][0], uv = acc[ai][bj][m][1];
                    u32x2 w; w.x = pk2(siluf_(gv[0]) * uv[0], siluf_(gv[1]) * uv[1]); w.y = pk2(siluf_(gv[2]) * uv[2], siluf_(gv[3]) * uv[3]);
                    *(u32x2*)(rowp + bj * 64) = w; } }
    }
};

template <class Epi>
__device__ __forceinline__ void run_gemm(LAS unsigned char* lds, const bf16_t* A, const bf16_t* Bt, int N, int K, const Epi& E) {
    pg8::Gemm g{A, Bt, MTOK, N, K}; pg8::StaticOrder S; S.init(MTOK, N, (int)gridDim.x, (int)blockIdx.x);
    DIS_GEMM((pg8::gemm_phase<Epi, pg8::StaticOrder, true, true>(lds, g, S, E)));
}

__device__ __forceinline__ int map_row(int mode, int n) {
    if (mode == 0) return n;
    if (mode == 1) return (n >> 2) * 8 + (n & 3);
    if (mode == 2) return (n >> 2) * 8 + 4 + (n & 3);
    if (n < 1280) return n;
    if (n < 1304) return 2304 + (n - 1280);
    return n - 24;
}
__device__ __forceinline__ void p0_transpose_item(const float* W, int K, int N, bf16_t* WT, int mode, LAS float* scr, int item, int lane) {
    const int nblk = (N + 31) / 32, kb = item / nblk, nb = item % nblk, k0 = 64 * kb, n0 = 32 * nb;
    const int nn = n0 + (lane & 31);
#pragma unroll 8
    for (int i = 0; i < 32; ++i) { const int kk = 2 * i + (lane >> 5); scr[kk * 33 + (lane & 31)] = (nn < N) ? W[(size_t)(k0 + kk) * N + nn] : 0.f; }
    LDSW();
    const int c = lane & 7;
#pragma unroll
    for (int j = 0; j < 4; ++j) { const int nl = (lane >> 3) + 8 * j, n = n0 + nl; const LAS float* s = scr + (8 * c) * 33 + nl;
        u32x4 o; o.x = pk2(s[0 * 33], s[1 * 33]); o.y = pk2(s[2 * 33], s[3 * 33]); o.z = pk2(s[4 * 33], s[5 * 33]); o.w = pk2(s[6 * 33], s[7 * 33]);
        if (n < N) *(u32x4*)(WT + (size_t)map_row(mode, n) * K + k0 + 8 * c) = o; }
    LDSW();
}
__device__ __forceinline__ void p0_prologue(const Params& p, LAS unsigned char* lds) {
    const int tid = opaque_tid(), lane = tid & 63, wave = tid >> 6;
    LAS float* scr = (LAS float*)(lds + wave * 16384);
    const int gw = blockIdx.x * 8 + wave, NGW = gridDim.x * 8;
    unsigned char* ws = p.ws;
    constexpr int I_IN0 = 16 * 80, I_OUT = 16 * 32, I_IN1 = 16 * 73, I_G = 16 * 88, I_DN = 44 * 32, I_W1 = 32 * 2;
    constexpr int NITEMS = I_IN0 + 2 * I_OUT + I_IN1 + 4 * I_G + 2 * I_DN + 2 * I_W1;
    for (int it = gw; it < NITEMS; it += NGW) {
        int r = it;
        if (r < I_IN0) { p0_transpose_item(p.in[1], 1024, 2560, (bf16_t*)(ws + WS_IN0), 0, scr, r, lane); continue; } r -= I_IN0;
        if (r < I_OUT) { p0_transpose_item(p.in[6], 1024, 1024, (bf16_t*)(ws + WS_OUT0), 0, scr, r, lane); continue; } r -= I_OUT;
        if (r < I_OUT) { p0_transpose_item(p.in[18], 1024, 1024, (bf16_t*)(ws + WS_OUT1), 0, scr, r, lane); continue; } r -= I_OUT;
        if (r < I_IN1) { p0_transpose_item(p.in[7], 1024, 2328, (bf16_t*)(ws + WS_IN1), 3, scr, r, lane); continue; } r -= I_IN1;
        if (r < I_G) { p0_transpose_item(p.in[19], 1024, FF, (bf16_t*)(ws + WS_GU0), 1, scr, r, lane); continue; } r -= I_G;
        if (r < I_G) { p0_transpose_item(p.in[20], 1024, FF, (bf16_t*)(ws + WS_GU0), 2, scr, r, lane); continue; } r -= I_G;
        if (r < I_G) { p0_transpose_item(p.in[19] + (size_t)1024 * FF, 1024, FF, (bf16_t*)(ws + WS_GU1), 1, scr, r, lane); continue; } r -= I_G;
        if (r < I_G) { p0_transpose_item(p.in[20] + (size_t)1024 * FF, 1024, FF, (bf16_t*)(ws + WS_GU1), 2, scr, r, lane); continue; } r -= I_G;
        if (r < I_DN) { p0_transpose_item(p.in[21], FF, 1024, (bf16_t*)(ws + WS_DN0), 0, scr, r, lane); continue; } r -= I_DN;
        if (r < I_DN) { p0_transpose_item(p.in[21] + (size_t)FF * 1024, FF, 1024, (bf16_t*)(ws + WS_DN1), 0, scr, r, lane); continue; } r -= I_DN;
        if (r < I_W1) { p0_transpose_item(p.in[9], 2048, 64, (bf16_t*)(ws + WS_W1TK), 0, scr, r, lane); continue; } r -= I_W1;
        p0_transpose_item(p.in[12], 2048, 64, (bf16_t*)(ws + WS_W1TV), 0, scr, r, lane);
    }
    const int gt = blockIdx.x * 512 + tid, NGT = gridDim.x * 512;
    { u32x4* z = (u32x4*)((bf16_t*)(ws + WS_IN1) + (size_t)2328 * 1024); const int n16 = 232 * 1024 * 2 / 16;
      for (int i = gt; i < n16; i += NGT) z[i] = (u32x4){0u, 0u, 0u, 0u}; }
    { const float* wsrc = p.in[16]; bf16_t* tr = (bf16_t*)(ws + WS_TRIL);
      for (int i = gt; i < 4 * 128 * 128; i += NGT) { const int t = (i >> 7) & 127, s = i & 127; tr[i] = (bf16_t)((s <= t) ? f2bf(wsrc[i]) : 0u); } }
    { const float* x = p.in[0]; bf16_t* xb = (bf16_t*)(ws + WS_XB);
      for (int m = gw; m < MTOK; m += NGW) { const f32x4* xr = (const f32x4*)(x + (size_t)m * DM) + lane; u32x2* o8 = (u32x2*)(xb + (size_t)m * DM) + lane;
#pragma unroll
          for (int j = 0; j < 4; ++j) { const f32x4 v = xr[64 * j]; u32x2 w; w.x = pk2(v.x, v.y); w.y = pk2(v.z, v.w); o8[64 * j] = w; } } }
}

__device__ __forceinline__ void ln_phase(const float* xin, const bf16_t* mb, const float* gam, const float* bet, float* xout, bf16_t* xb) {
    const int tid = opaque_tid(), lane = tid & 63, wave = tid >> 6;
    const int gw = blockIdx.x * 8 + wave, NGW = gridDim.x * 8;
    f32x4 gv[4], bv[4];
#pragma unroll
    for (int j = 0; j < 4; ++j) { gv[j] = ((const f32x4*)gam)[64 * j + lane]; bv[j] = ((const f32x4*)bet)[64 * j + lane]; }
    for (int m = gw; m < MTOK; m += NGW) {
        const f32x4* xr = (const f32x4*)(xin + (size_t)m * DM) + lane; const u32x2* mr = (const u32x2*)(mb + (size_t)m * DM) + lane;
        f32x4 v[4]; float s = 0.f;
#pragma unroll
        for (int j = 0; j < 4; ++j) { const f32x4 x = xr[64 * j]; const u32x2 w = mr[64 * j];
            v[j].x = ALPHA * x.x + bflo(w.x); v[j].y = ALPHA * x.y + bfhi(w.x); v[j].z = ALPHA * x.z + bflo(w.y); v[j].w = ALPHA * x.w + bfhi(w.y);
            s += (v[j].x + v[j].y) + (v[j].z + v[j].w); }
        const float mean = wave_sum(s) * (1.f / DM); float s2 = 0.f;
#pragma unroll
        for (int j = 0; j < 4; ++j) { v[j] = v[j] - mean; s2 += (v[j].x * v[j].x + v[j].y * v[j].y) + (v[j].z * v[j].z + v[j].w * v[j].w); }
        const float rstd = rsqrtf(wave_sum(s2) * (1.f / DM) + LN_EPS);
        f32x4* orow = (f32x4*)(xout + (size_t)m * DM) + lane; u32x2* o8 = (u32x2*)(xb + (size_t)m * DM) + lane;
#pragma unroll
        for (int j = 0; j < 4; ++j) { const f32x4 o = v[j] * rstd * gv[j] + bv[j]; orow[64 * j] = o; u32x2 w; w.x = pk2(o.x, o.y); w.y = pk2(o.z, o.w); o8[64 * j] = w; }
    }
}

constexpr int KS = 144;
constexpr int TILEB = 64 * KS;
constexpr int L_K = 0, L_V = 2 * TILEB, L_WSF = 4 * TILEB  , L_DONE = L_WSF + 1024, L_IMP = L_DONE + 256  , L_SEL = L_IMP + 4 * 64 * 33 * 4  , L_OACC = 73728;

__device__ __forceinline__ s16x4 vtr(const LAS char* p) { return __builtin_bit_cast(s16x4, __builtin_amdgcn_ds_read_tr16_b64_v4i16((LAS v4i16_t*)p)); }

__device__ __forceinline__ f32x16 qk_sub(const LAS char* kt, int sub, const bf16x8 (&qr)[4], int r32, int hi) {
    f32x16 s;
#pragma unroll
    for (int i = 0; i < 16; ++i) s[i] = 0.f;
    const LAS char* kp = kt + (32 * sub + r32) * KS + hi * 16;
#pragma unroll
    for (int d0 = 0; d0 < 4; ++d0) { const bf16x8 a = *(const LAS bf16x8*)(kp + d0 * 32); s = MFMA32(a, qr[d0], s); }
    return s;
}
__device__ __forceinline__ void pv_sub(f32x16 (&o)[2], const f32x16& p, const LAS char* vt, int sub, int lane) {
    const int hi = lane >> 5;
    const LAS char* vp = vt + (32 * sub + 4 * hi + ((lane & 15) >> 2)) * KS + (16 * ((lane >> 4) & 1) + 4 * (lane & 3)) * 2;
#pragma unroll
    for (int s = 0; s < 2; ++s) {
        u32x4 pw; pw.x = pk2(p[8 * s + 0], p[8 * s + 1]); pw.y = pk2(p[8 * s + 2], p[8 * s + 3]); pw.z = pk2(p[8 * s + 4], p[8 * s + 5]); pw.w = pk2(p[8 * s + 6], p[8 * s + 7]);
        const bf16x8 pa = __builtin_bit_cast(bf16x8, pw);
#pragma unroll
        for (int db = 0; db < 2; ++db) {
            const s16x4 lo = vtr(vp + (16 * s) * KS + db * 64), hi4 = vtr(vp + (16 * s + 8) * KS + db * 64);
            const bf16x8 vb = (bf16x8){lo[0], lo[1], lo[2], lo[3], hi4[0], hi4[1], hi4[2], hi4[3]};
            o[db] = MFMA32(pa, vb, o[db]);
        }
    }
}
__device__ __forceinline__ void bcast_rows(float (&f)[16], LAS float* wsf_w, float val, int r32, int hi) {
    LDSW();
    if (hi == 0) wsf_w[r32] = val;
    LDSW();
#pragma unroll
    for (int r = 0; r < 16; ++r) f[r] = wsf_w[crow(r, hi)];
    LDSW();
}

__device__ __forceinline__ void sb_unit(const Params& p, LAS unsigned char* lds8, int b, int hh, int qb) {
    LAS char* lds = (LAS char*)lds8;
    const int tid = opaque_tid(), lane = tid & 63, w = __builtin_amdgcn_readfirstlane(tid >> 6), r32 = lane & 31, hi = lane >> 5;
    const bf16_t* H0 = (const bf16_t*)(p.ws + WS_H);
    bf16_t* MIX = (bf16_t*)(p.ws + WS_MIX);
    const size_t rowbase = (size_t)b * SEQ;
    const int t = 256 * qb + 32 * w + r32, twmax = 256 * qb + 32 * w + 31;
    bf16x8 qr[4];
    { const bf16_t* qp = H0 + (rowbase + t) * HW + hh * 64;
#pragma unroll
      for (int d0 = 0; d0 < 4; ++d0) qr[d0] = *(const bf16x8*)(qp + 16 * d0 + 8 * hi); }
    f32x16 o[2];
#pragma unroll
    for (int i = 0; i < 16; ++i) { o[0][i] = 0.f; o[1][i] = 0.f; }
    float R = 0.f; bool wdone = false;
    const bf16_t* kg = H0 + rowbase * HW + 512 + hh * 64; const bf16_t* vg = kg + 512;
    const int lrow = tid >> 3, lch = tid & 7;
    LAS unsigned* doneL = (LAS unsigned*)(lds + L_DONE);
    int j = 4 * qb + 3;
    u32x4 kreg = *(const u32x4*)(kg + (size_t)(64 * j + lrow) * HW + lch * 8), vreg = *(const u32x4*)(vg + (size_t)(64 * j + lrow) * HW + lch * 8);
    for (int it = 0;; ++it) {
        LAS char* kt = lds + L_K + (it & 1) * TILEB; LAS char* vt = lds + L_V + (it & 1) * TILEB;
        *(LAS u32x4*)(kt + lrow * KS + lch * 16) = kreg; *(LAS u32x4*)(vt + lrow * KS + lch * 16) = vreg;
        if (lane == 0) doneL[(it & 1) * 8 + w] = wdone ? 1u : 0u;
        __syncthreads();
        { const u32x4 d0 = *(const LAS u32x4*)(doneL + (it & 1) * 8), d1 = *(const LAS u32x4*)(doneL + (it & 1) * 8 + 4);
          const unsigned all = d0.x & d0.y & d0.z & d0.w & d1.x & d1.y & d1.z & d1.w;
          if (all) break; }
        if (j > 0) { kreg = *(const u32x4*)(kg + (size_t)(64 * (j - 1) + lrow) * HW + lch * 8); vreg = *(const u32x4*)(vg + (size_t)(64 * (j - 1) + lrow) * HW + lch * 8); }
#pragma unroll
        for (int sb_ = 0; sb_ < 2; ++sb_) {
            const int sub = 1 - sb_;
            const int kvb = 64 * j + 32 * sub;
            if (kvb >= twmax || wdone) continue;
            const f32x16 s = qk_sub(kt, sub, qr, r32, hi);
            float lr[16], lb[16];
#pragma unroll
            for (int r = 0; r < 16; ++r) {
                const int kv = kvb + crow(r, hi); const float z = s[r] * 0.125f;
                const float sp = fmaxf(z, 0.f) + __logf(1.f + __expf(-fabsf(z)));
                const bool past = kv < t;
                lr[r] = past ? -sp : 0.f; lb[r] = z - sp;
            }
            float T[4], To[4], aft[16];
#pragma unroll
            for (int gq = 0; gq < 4; ++gq) {
                aft[4 * gq + 3] = 0.f; aft[4 * gq + 2] = lr[4 * gq + 3]; aft[4 * gq + 1] = aft[4 * gq + 2] + lr[4 * gq + 2]; aft[4 * gq + 0] = aft[4 * gq + 1] + lr[4 * gq + 1];
                T[gq] = aft[4 * gq + 0] + lr[4 * gq + 0];
            }
#pragma unroll
            for (int gq = 0; gq < 4; ++gq) To[gq] = xor32(T[gq]);
            float A = 0.f;
            f32x16 pw;
#pragma unroll
            for (int gq = 3; gq >= 0; --gq) {
                const float ga = A + (hi == 0 ? To[gq] : 0.f);
#pragma unroll
                for (int i = 0; i < 4; ++i) { const int r = 4 * gq + i; const int kv = kvb + crow(r, hi);
                    const float e = __expf(lb[r] + R + ga + aft[r]); pw[r] = (kv < t) ? e : 0.f; }
                A += T[gq] + To[gq];
            }
            R += A;
            pv_sub(o, pw, vt, sub, lane);
        }
        wdone = __all(R < -120.f);
        if (j == 0) break;
        --j;
    }
    __syncthreads();
    bf16_t* op = MIX + (rowbase + 256 * qb + 32 * w) * DM + hh * 64 + r32;
#pragma unroll
    for (int r = 0; r < 16; ++r) { const int q = crow(r, hi);
        op[(size_t)q * DM] = (bf16_t)f2bf(o[0][r]); op[(size_t)q * DM + 32] = (bf16_t)f2bf(o[1][r]); }
}

__device__ __forceinline__ void conv_unit(const Params& p, LAS unsigned char* lds8, int b, int tile) {
    const int tid = opaque_tid(), lane = tid & 63, w = tid >> 6;
    const bf16_t* H0 = (const bf16_t*)(p.ws + WS_H);
    bf16_t* MIX = (bf16_t*)(p.ws + WS_MIX);
    LAS bf16_t* hL = (LAS bf16_t*)lds8;
    LAS float* yL = (LAS float*)(lds8 + 63488);
    const int t0 = 32 * tile;
    for (int tt = w; tt < 62; tt += 8) {
        const int tok = t0 - 30 + tt; u32x4 o = (u32x4){0u, 0u, 0u, 0u};
        if (tok >= 0) {
            const bf16_t* rp = H0 + ((size_t)b * SEQ + tok) * HW + 1536 + lane * 8;
            const u32x4 a = *(const u32x4*)rp, g = *(const u32x4*)(rp + 512);
            o.x = pk2(bflo(a.x) * sigmoidf_(bflo(g.x)), bfhi(a.x) * sigmoidf_(bfhi(g.x)));
            o.y = pk2(bflo(a.y) * sigmoidf_(bflo(g.y)), bfhi(a.y) * sigmoidf_(bfhi(g.y)));
            o.z = pk2(bflo(a.z) * sigmoidf_(bflo(g.z)), bfhi(a.z) * sigmoidf_(bfhi(g.z)));
            o.w = pk2(bflo(a.w) * sigmoidf_(bflo(g.w)), bfhi(a.w) * sigmoidf_(bfhi(g.w)));
        }
        *(LAS u32x4*)(hL + tt * 512 + lane * 8) = o;
    }
    __syncthreads();
    {
        const int c = tid; const float* cw = p.in[2]; const float bias = p.in[3][c];
        float wd[31];
#pragma unroll
        for (int k = 0; k < 31; ++k) wd[k] = cw[k * 512 + c];
        float hv[62];
#pragma unroll
        for (int i = 0; i < 62; ++i) hv[i] = bf2f((unsigned)hL[i * 512 + c]);
#pragma unroll
        for (int tq = 0; tq < 32; ++tq) { float y = bias;
#pragma unroll
            for (int k = 0; k < 31; ++k) y += hv[tq + k] * wd[k];
            yL[tq * 512 + c] = y; }
    }
    __syncthreads();
    {
        const f32x4 g0 = ((const f32x4*)p.in[4])[lane * 2], g1 = ((const f32x4*)p.in[4])[lane * 2 + 1];
        const f32x4 b0 = ((const f32x4*)p.in[5])[lane * 2], b1 = ((const f32x4*)p.in[5])[lane * 2 + 1];
#pragma unroll
        for (int i = 0; i < 4; ++i) { const int tq = 4 * w + i;
            f32x4 v0 = *(const LAS f32x4*)(yL + tq * 512 + lane * 8), v1 = *(const LAS f32x4*)(yL + tq * 512 + lane * 8 + 4);
            const float mean = wave_sum((v0.x + v0.y) + (v0.z + v0.w) + (v1.x + v1.y) + (v1.z + v1.w)) * (1.f / 512.f);
            v0 = v0 - mean; v1 = v1 - mean;
            const float var = wave_sum((v0.x * v0.x + v0.y * v0.y) + (v0.z * v0.z + v0.w * v0.w) + (v1.x * v1.x + v1.y * v1.y) + (v1.z * v1.z + v1.w * v1.w)) * (1.f / 512.f);
            const float rstd = rsqrtf(var + LN_EPS);
            v0 = v0 * rstd * g0 + b0; v1 = v1 * rstd * g1 + b1;
            u32x4 o; o.x = pk2(siluf_(v0.x), siluf_(v0.y)); o.y = pk2(siluf_(v0.z), siluf_(v0.w)); o.z = pk2(siluf_(v1.x), siluf_(v1.y)); o.w = pk2(siluf_(v1.z), siluf_(v1.w));
            *(u32x4*)(MIX + ((size_t)b * SEQ + t0 + tq) * DM + 512 + lane * 8) = o; }
    }
    __syncthreads();
}

__device__ __forceinline__ void compress_unit(const Params& p, LAS unsigned char* lds8, int b, int g, int kv, int nt) {
    LAS char* lds = (LAS char*)lds8;
    const int tid = opaque_tid(), lane = tid & 63, w = __builtin_amdgcn_readfirstlane(tid >> 6), r32 = lane & 31, hi = lane >> 5;
    const bf16_t* H1 = (const bf16_t*)(p.ws + WS_H);
    const float* pos = p.in[kv ? 11 : 8]; const float* w1 = p.in[kv ? 12 : 9]; const float* w2 = p.in[kv ? 13 : 10];
    const bf16_t* w1t = (const bf16_t*)(p.ws + (kv ? WS_W1TV : WS_W1TK));
    bf16_t* outp = (bf16_t*)(p.ws + (kv ? WS_VCMP : WS_KCMP)) + (size_t)((b * 2 + g) * 128 + 32 * nt) * 64;
    constexpr int L_SLAB = 0, L_PART = 76032, L_PT = 76032 + 65536;
    LAS float* partL = (LAS float*)(lds + L_PART); LAS float* ptL = (LAS float*)(lds + L_PT);
    const int col = 512 + kv * 128 + g * 64;
    for (int idx = tid; idx < 528 * 8; idx += 512) { const int i = idx >> 3, ch = idx & 7, tok = 512 * nt + i;
        u32x4 v = (u32x4){0u, 0u, 0u, 0u};
        if (tok < SEQ) v = *(const u32x4*)(H1 + ((size_t)b * SEQ + tok) * HW + col + ch * 8);
        *(LAS u32x4*)(lds + L_SLAB + ((i & 15) * 33 + (i >> 4)) * KS + ch * 16) = v; }
    { const int e = tid & 63, part = tid >> 6; float acc = 0.f;
      for (int k = part * 256; k < part * 256 + 256; ++k) acc += pos[k] * w1[(size_t)k * 64 + e];
      ptL[part * 64 + e] = acc; }
    __syncthreads();
    f32x16 acc[2];
#pragma unroll
    for (int i = 0; i < 16; ++i) { acc[0][i] = 0.f; acc[1][i] = 0.f; }
#pragma unroll
    for (int li = 0; li < 4; ++li) { const int l = 4 * w + li, c = l & 15, mo = l >> 4;
        const LAS char* ap = lds + L_SLAB + (c * 33 + r32 + mo) * KS + hi * 16;
        const bf16_t* bp = w1t + (size_t)r32 * 2048 + l * 64 + 8 * hi;
#pragma unroll
        for (int d0 = 0; d0 < 4; ++d0) { const bf16x8 a = *(const LAS bf16x8*)(ap + d0 * 32);
            const bf16x8 b0 = *(const bf16x8*)(bp + 16 * d0), b1 = *(const bf16x8*)(bp + (size_t)32 * 2048 + 16 * d0);
            acc[0] = MFMA32(a, b0, acc[0]); acc[1] = MFMA32(a, b1, acc[1]); } }
#pragma unroll
    for (int r = 0; r < 16; ++r) { const int n = crow(r, hi); partL[(w * 32 + n) * 64 + r32] = acc[0][r]; partL[(w * 32 + n) * 64 + 32 + r32] = acc[1][r]; }
    __syncthreads();
    LAS float* hidL = (LAS float*)(lds + L_SLAB);
#pragma unroll
    for (int i = 0; i < 4; ++i) { const int idx = tid + 512 * i, n = idx >> 6, e = idx & 63; float s = 0.f;
#pragma unroll
        for (int ww = 0; ww < 8; ++ww) s += partL[(ww * 32 + n) * 64 + e];
        float pt = 0.f;
#pragma unroll
        for (int ww = 0; ww < 8; ++ww) pt += ptL[ww * 64 + e];
        hidL[n * 65 + e] = gelu_tanh(s + pt); }
    __syncthreads();
    { const int n = tid >> 4, e2 = (tid & 15) * 4; float o0 = 0.f, o1 = 0.f, o2 = 0.f, o3 = 0.f;
      for (int e = 0; e < 64; ++e) { const float hval = hidL[n * 65 + e]; const f32x4 wv = *(const f32x4*)(w2 + e * 64 + e2);
          o0 += hval * wv.x; o1 += hval * wv.y; o2 += hval * wv.z; o3 += hval * wv.w; }
      u32x2 ov; ov.x = pk2(o0, o1); ov.y = pk2(o2, o3);
      if (32 * nt + n >= 127) { ov.x = 0u; ov.y = 0u; }
      *(u32x2*)(outp + (size_t)n * 64 + e2) = ov; }
    __syncthreads();
}

__device__ __forceinline__ void gmlp_unit(const Params& p, LAS unsigned char* lds8, int b, int ch) {
    LAS char* lds = (LAS char*)lds8;
    const int tid = opaque_tid(), lane = tid & 63, w = __builtin_amdgcn_readfirstlane(tid >> 6), r32 = lane & 31, hi = lane >> 5;
    const bf16_t* H1 = (const bf16_t*)(p.ws + WS_H);
    bf16_t* MIX = (bf16_t*)(p.ws + WS_MIX);
    const bf16_t* TR = (const bf16_t*)(p.ws + WS_TRIL);
    constexpr int VS = 1040;
    const size_t row0 = (size_t)b * SEQ + 128 * ch;
    {
        const f32x4 g0 = ((const f32x4*)p.in[14])[lane * 2], g1 = ((const f32x4*)p.in[14])[lane * 2 + 1];
        const f32x4 b0 = ((const f32x4*)p.in[15])[lane * 2], b1 = ((const f32x4*)p.in[15])[lane * 2 + 1];
        for (int tq = w; tq < 128; tq += 8) {
            const u32x4 raw = *(const u32x4*)(H1 + (row0 + tq) * HW + 1792 + lane * 8);
            f32x4 v0, v1;
            v0.x = gelu_tanh(bflo(raw.x)); v0.y = gelu_tanh(bfhi(raw.x)); v0.z = gelu_tanh(bflo(raw.y)); v0.w = gelu_tanh(bfhi(raw.y));
            v1.x = gelu_tanh(bflo(raw.z)); v1.y = gelu_tanh(bfhi(raw.z)); v1.z = gelu_tanh(bflo(raw.w)); v1.w = gelu_tanh(bfhi(raw.w));
            const float mean = wave_sum((v0.x + v0.y) + (v0.z + v0.w) + (v1.x + v1.y) + (v1.z + v1.w)) * (1.f / 512.f);
            v0 = v0 - mean; v1 = v1 - mean;
            const float var = wave_sum((v0.x * v0.x + v0.y * v0.y) + (v0.z * v0.z + v0.w * v0.w) + (v1.x * v1.x + v1.y * v1.y) + (v1.z * v1.z + v1.w * v1.w)) * (1.f / 512.f);
            const float rstd = rsqrtf(var + LN_EPS);
            v0 = v0 * rstd * g0 + b0; v1 = v1 * rstd * g1 + b1;
            u32x4 o; o.x = pk2(v0.x, v0.y); o.y = pk2(v0.z, v0.w); o.z = pk2(v1.x, v1.y); o.w = pk2(v1.z, v1.w);
            *(LAS u32x4*)(lds + tq * VS + lane * 16) = o;
        }
    }
    __syncthreads();
    const int gi = w >> 1, th = w & 1;
    f32x16 acc[2][4];
#pragma unroll
    for (int a = 0; a < 2; ++a)
#pragma unroll
        for (int d = 0; d < 4; ++d)
#pragma unroll
            for (int i = 0; i < 16; ++i) acc[a][d][i] = 0.f;
    const bf16_t* ap = TR + (size_t)(gi * 128 + 64 * th + r32) * 128 + 8 * hi;
    const LAS char* vp = lds + (8 * hi + ((lane & 15) >> 2)) * VS + (128 * gi + 16 * ((lane >> 4) & 1) + 4 * (lane & 3)) * 2;
    const int nks = 4 * th + 4;
    for (int ks = 0; ks < nks; ++ks) {
        const bf16x8 a0 = *(const bf16x8*)(ap + 16 * ks), a1 = *(const bf16x8*)(ap + 32 * 128 + 16 * ks);
#pragma unroll
        for (int db = 0; db < 4; ++db) {
            const s16x4 lo = vtr(vp + (16 * ks) * VS + db * 64), hi4 = vtr(vp + (16 * ks + 4) * VS + db * 64);
            const bf16x8 vb = (bf16x8){lo[0], lo[1], lo[2], lo[3], hi4[0], hi4[1], hi4[2], hi4[3]};
            acc[0][db] = MFMA32(a0, vb, acc[0][db]); acc[1][db] = MFMA32(a1, vb, acc[1][db]);
        }
    }
    const float* bs = p.in[17] + gi * 128;
#pragma unroll
    for (int tb = 0; tb < 2; ++tb)
#pragma unroll
        for (int r = 0; r < 16; ++r) { const int tq = 64 * th + 32 * tb + crow(r, hi); const float bias = bs[tq];
            const bf16_t* up = H1 + (row0 + tq) * HW + 1280 + 128 * gi + r32; bf16_t* op = MIX + (row0 + tq) * DM + 512 + 128 * gi + r32;
#pragma unroll
            for (int db = 0; db < 4; ++db) { const float uu = gelu_tanh(bf2f((unsigned)up[32 * db])); op[32 * db] = (bf16_t)f2bf(uu * (acc[tb][db][r] + bias)); } }
    __syncthreads();
}

template <int MODE>
__device__ __forceinline__ void nsa_branch(LAS float* accw, bf16_t* gout, LAS char* lds, const bf16_t* kg, const bf16_t* vg, unsigned todo, const bf16x8 (&qr)[4],
                                           float gate, unsigned selm, int t, int twmin, int twmax, int tid, int lane, int w) {
    const int r32 = lane & 31, hi = lane >> 5, lrow = tid >> 3, lch = tid & 7;
    LAS float* wsf_w = (LAS float*)(lds + L_WSF) + w * 32;
    float m = -1e30f, l = 0.f;
    f32x16 o[2];
#pragma unroll
    for (int i = 0; i < 16; ++i) { o[0][i] = 0.f; o[1][i] = 0.f; }
    int j = (MODE == 1) ? __builtin_ctz(todo) : 31 - __builtin_clz(todo);
    todo &= ~(1u << j);
    u32x4 kreg = *(const u32x4*)(kg + (size_t)(64 * j + lrow) * HW + lch * 8), vreg = *(const u32x4*)(vg + (size_t)(64 * j + lrow) * HW + lch * 8);
    for (int it = 0;; ++it) {
        LAS char* kt = lds + L_K + (it & 1) * TILEB; LAS char* vt = lds + L_V + (it & 1) * TILEB;
        *(LAS u32x4*)(kt + lrow * KS + lch * 16) = kreg; *(LAS u32x4*)(vt + lrow * KS + lch * 16) = vreg;
        __syncthreads();
        const bool has_next = todo != 0u; int jn = 0;
        if (has_next) { jn = (MODE == 1) ? __builtin_ctz(todo) : 31 - __builtin_clz(todo); todo &= ~(1u << jn);
            kreg = *(const u32x4*)(kg + (size_t)(64 * jn + lrow) * HW + lch * 8); vreg = *(const u32x4*)(vg + (size_t)(64 * jn + lrow) * HW + lch * 8); }
        const bool selected = (MODE == 1) ? (((selm >> j) & 1u) != 0u) : true;
#pragma unroll 1
        for (int sub = 0; sub < 2; ++sub) {
            const int kvb = 64 * j + 32 * sub;
            if (kvb > twmax) continue;
            if (MODE == 2 && kvb + 31 + 512 <= twmin) continue;
            if (MODE == 1 && !__any(selected)) continue;
            const f32x16 s = qk_sub(kt, sub, qr, r32, hi);
            float s2[16]; float mx = -1e30f;
#pragma unroll
            for (int r = 0; r < 16; ++r) { const int kv = kvb + crow(r, hi);
                const bool valid = (kv <= t) && ((MODE == 1) ? selected : (t - kv < 512));
                s2[r] = valid ? s[r] * C2 : -1e30f; mx = fmaxf(mx, s2[r]); }
            mx = fmaxf(mx, xor32(mx));
            if (__any(mx > m + 8.f)) {
                const float mn = fmaxf(m, mx), f = __builtin_amdgcn_exp2f(m - mn);
                l *= f; m = mn;
                float fr[16]; bcast_rows(fr, wsf_w, f, r32, hi);
#pragma unroll
                for (int r = 0; r < 16; ++r) { o[0][r] *= fr[r]; o[1][r] *= fr[r]; }
            }
            f32x16 pw; float ls = 0.f;
#pragma unroll
            for (int r = 0; r < 16; ++r) { const float e = __builtin_amdgcn_exp2f(s2[r] - m); pw[r] = (s2[r] > -1e29f) ? e : 0.f; ls += pw[r]; }
            l += ls;
            pv_sub(o, pw, vt, sub, lane);
        }
        if (!has_next) break;
        j = jn;
    }
    __syncthreads();
    l += xor32(l);
    const float fac = (l > 0.f) ? gate / l : 0.f;
    float fr[16]; bcast_rows(fr, wsf_w, fac, r32, hi);
    if (MODE == 1) {
#pragma unroll
        for (int r = 0; r < 16; ++r) { const int q = crow(r, hi); accw[q * 64 + r32] += o[0][r] * fr[r]; accw[q * 64 + 32 + r32] += o[1][r] * fr[r]; }
    } else {
#pragma unroll
        for (int r = 0; r < 16; ++r) { const int q = crow(r, hi);
            gout[(size_t)q * DM] = (bf16_t)f2bf(accw[q * 64 + r32] + o[0][r] * fr[r]); gout[(size_t)q * DM + 32] = (bf16_t)f2bf(accw[q * 64 + 32 + r32] + o[1][r] * fr[r]); }
    }
    LDSW();
}

__device__ __forceinline__ void nsa_unit(const Params& p, LAS unsigned char* lds8, int b, int g, int qb) {
    LAS char* lds = (LAS char*)lds8;
    const int tid = opaque_tid(), lane = tid & 63, w = __builtin_amdgcn_readfirstlane(tid >> 6), r32 = lane & 31, hi = lane >> 5;
    const int rh = w >> 1, tsub = w & 1;
    const bf16_t* H1 = (const bf16_t*)(p.ws + WS_H);
    bf16_t* MIX = (bf16_t*)(p.ws + WS_MIX);
    const size_t rowbase = (size_t)b * SEQ;
    const int t0 = 64 * qb, t = t0 + 32 * tsub + r32, twmin = t0 + 32 * tsub, twmax = twmin + 31;
    LAS float* wsf_w = (LAS float*)(lds + L_WSF) + w * 32;
    LAS float* impL = (LAS float*)(lds + L_IMP);
    LAS unsigned* selL = (LAS unsigned*)(lds + L_SEL);
    bf16x8 qr[4];
    float g0, g1, g2;
    { const bf16_t* qp = H1 + (rowbase + t) * HW + (g * 4 + rh) * 64;
#pragma unroll
      for (int d0 = 0; d0 < 4; ++d0) qr[d0] = *(const bf16x8*)(qp + 16 * d0 + 8 * hi);
      const bf16_t* gp = H1 + (rowbase + t) * HW + 2304 + (g * 4 + rh) * 3;
      g0 = sigmoidf_(bf2f((unsigned)gp[0])); g1 = sigmoidf_(bf2f((unsigned)gp[1])); g2 = sigmoidf_(bf2f((unsigned)gp[2])); }
    LAS float* accw = (LAS float*)(lds + L_OACC) + w * 2048;
    bf16_t* gout = MIX + (rowbase + t0 + 32 * tsub) * DM + (g * 4 + rh) * 64 + r32;
    {
        const bf16_t* kc = (const bf16_t*)(p.ws + WS_KCMP) + (size_t)(b * 2 + g) * 128 * 64;
        const bf16_t* vc = (const bf16_t*)(p.ws + WS_VCMP) + (size_t)(b * 2 + g) * 128 * 64;
#pragma unroll
        for (int i = 0; i < 2; ++i) { const int idx = tid + 512 * i, row = idx >> 3, ch = idx & 7;
            *(LAS u32x4*)(lds + L_K + row * KS + ch * 16) = *(const u32x4*)(kc + row * 64 + ch * 8);
            *(LAS u32x4*)(lds + L_V + row * KS + ch * 16) = *(const u32x4*)(vc + row * 64 + ch * 8); }
        __syncthreads();
        const int nmax = (t - 31) >> 4;
        float m = -1e30f, l = 0.f;
#pragma unroll 1
        for (int sb = 0; sb < 4; ++sb) {
            const f32x16 s = qk_sub(lds + L_K, sb, qr, r32, hi);
            float s2[16]; float mx = m;
#pragma unroll
            for (int r = 0; r < 16; ++r) { const int n = 32 * sb + crow(r, hi); s2[r] = (n <= nmax) ? s[r] * C2 : -1e30f; mx = fmaxf(mx, s2[r]); }
            l *= __builtin_amdgcn_exp2f(m - mx); m = mx;
#pragma unroll
            for (int r = 0; r < 16; ++r) { const float e = __builtin_amdgcn_exp2f(s2[r] - m); l += (s2[r] > -1e29f) ? e : 0.f; }
        }
        { const float mt = fmaxf(m, xor32(m)); l *= __builtin_amdgcn_exp2f(m - mt); m = mt; l += xor32(l); }
        const float inv = (l > 0.f) ? 1.f / l : 0.f;
        f32x16 o[2];
#pragma unroll
        for (int i = 0; i < 16; ++i) { o[0][i] = 0.f; o[1][i] = 0.f; }
        LAS float* ip = impL + ((rh * 64) + 32 * tsub + r32) * 33 + hi; float lprev = 0.f;
#pragma unroll 1
        for (int sb = 0; sb < 4; ++sb) {
            const f32x16 s = qk_sub(lds + L_K, sb, qr, r32, hi);
            f32x16 pw;
#pragma unroll
            for (int r = 0; r < 16; ++r) { const int n = 32 * sb + crow(r, hi); const float e = __builtin_amdgcn_exp2f(s[r] * C2 - m) * inv; pw[r] = (n <= nmax) ? e : 0.f; }
#pragma unroll
            for (int gq = 0; gq < 4; ++gq) {
                const float Gv = (pw[4 * gq] + pw[4 * gq + 1]) + (pw[4 * gq + 2] + pw[4 * gq + 3]);
                const float lcur = xor32(pw[4 * gq + 3]);
                ip[2 * (4 * sb + gq)] = Gv + (hi ? lcur : lprev); lprev = lcur; }
            pv_sub(o, pw, lds + L_V, sb, lane);
        }
        float fr[16]; bcast_rows(fr, wsf_w, g0, r32, hi);
#pragma unroll
        for (int r = 0; r < 16; ++r) { const int q = crow(r, hi); accw[q * 64 + r32] = o[0][r] * fr[r]; accw[q * 64 + 32 + r32] = o[1][r] * fr[r]; }
    }
    __syncthreads();
#ifndef XTOPK
    { const int tok = tid >> 3, j0 = (tid & 7) * 4;
#pragma unroll
      for (int jj = 0; jj < 4; ++jj) { LAS float* q0 = impL + tok * 33 + j0 + jj; q0[0] = ((q0[0] + q0[64 * 33]) + q0[2 * 64 * 33]) + q0[3 * 64 * 33]; } }
    __syncthreads();
    if (w == 0) {
        float sc[32];
#pragma unroll
        for (int jj = 0; jj < 32; ++jj) { const float v = impL[lane * 33 + jj];
            const bool forced = (jj == 0) || (jj == qb) || (jj == qb - 1);
            sc[jj] = (jj <= qb) ? v + (forced ? 1000.f : 0.f) : -1e30f; }
        unsigned mask = 0u;
        if (qb < 8) mask = (2u << qb) - 1u;
        else {
#pragma unroll 1
            for (int k = 0; k < 8; ++k) { float best = -3e38f; int bj = 0;
#pragma unroll
                for (int jj = 0; jj < 32; ++jj) { const float v = ((mask >> jj) & 1u) ? -3e38f : sc[jj]; if (v > best) { best = v; bj = jj; } }
                mask |= 1u << bj; }
        }
        selL[lane] = mask;
        unsigned un = mask;
#pragma unroll
        for (int o = 1; o < 64; o <<= 1) un |= (unsigned)__shfl_xor((int)un, o);
        if (lane == 0) selL[64] = un;
    }
#endif
    __syncthreads();
    const unsigned selm = selL[32 * tsub + r32], uni = selL[64];
#ifndef XSEL
    { const unsigned vmask = (qb >= 31) ? 0xffffffffu : ((2u << qb) - 1u);
      nsa_branch<1>(accw, gout, lds, H1 + rowbase * HW + 768 + g * 64, H1 + rowbase * HW + 896 + g * 64, (uni & vmask) | 1u, qr, g1, selm, t, twmin, twmax, tid, lane, w); }
#endif
#ifndef XWIN
    { const int lo = qb > 8 ? qb - 8 : 0; const unsigned vmask = (qb >= 31) ? 0xffffffffu : ((2u << qb) - 1u); const unsigned todo = vmask & ~((1u << lo) - 1u);
      nsa_branch<2>(accw, gout, lds, H1 + rowbase * HW + 1024 + g * 64, H1 + rowbase * HW + 1152 + g * 64, todo, qr, g2, 0u, t, twmin, twmax, tid, lane, w); }
#endif
}

__global__ void __launch_bounds__(512, 2) fwd_megakernel(Params p) {
    extern __shared__ __attribute__((aligned(16))) unsigned char lds_raw[];
    LAS unsigned char* lds = (LAS unsigned char*)lds_raw;
    cg::grid_group grid = cg::this_grid();
    unsigned char* ws = p.ws;
    bf16_t* XB = (bf16_t*)(ws + WS_XB); bf16_t* HB = (bf16_t*)(ws + WS_H); bf16_t* MIX = (bf16_t*)(ws + WS_MIX); bf16_t* MB = (bf16_t*)(ws + WS_MB);
    const int G = gridDim.x, bx = blockIdx.x;

    p0_prologue(p, lds);
    grid.sync();
    run_gemm(lds, XB, (const bf16_t*)(ws + WS_IN0), 2560, 1024, EpiStore{HB, HW});
    grid.sync();
    for (int u = bx; u < 1024; u += G) { const int i = u >> 8, c = u & 255, bh = c >> 1, s = c & 1;
        const int qb = (i == 0) ? s : (i == 1) ? 3 - s : (i == 2) ? 4 + s : 7 - s;
        DIS_SB(sb_unit(p, lds, bh >> 3, bh & 7, qb)); }
    for (int u = bx; u < 1024; u += G) DIS_CONV(conv_unit(p, lds, u >> 6, u & 63));
    grid.sync();
    run_gemm(lds, MIX, (const bf16_t*)(ws + WS_OUT0), 1024, 1024, EpiStore{MB, DM});
    grid.sync();
    ln_phase(p.in[0], MB, p.in[22], p.in[23], p.out, XB);
    grid.sync();
    run_gemm(lds, XB, (const bf16_t*)(ws + WS_GU0), 2 * FF, 1024, EpiSwiglu{HB, FF});
    grid.sync();
    run_gemm(lds, HB, (const bf16_t*)(ws + WS_DN0), 1024, FF, EpiStore{MB, DM});
    grid.sync();
    ln_phase(p.out, MB, p.in[24], p.in[25], p.out, XB);
    grid.sync();
    run_gemm(lds, XB, (const bf16_t*)(ws + WS_IN1), 2560, 1024, EpiStore{HB, HW});
    grid.sync();
    for (int u = bx; u < 256; u += G) DIS_CMP(compress_unit(p, lds, u >> 4, (u >> 3) & 1, (u >> 2) & 1, u & 3));
    for (int u = bx; u < 256; u += G) DIS_GMLP(gmlp_unit(p, lds, u >> 4, u & 15));
    grid.sync();
    for (int u = bx; u < 1024; u += G) { const int i = u >> 8, c = u & 255, bg = c >> 3, s = c & 7;
        const int qb = (i == 0) ? s : (i == 1) ? 15 - s : (i == 2) ? 16 + s : 31 - s;
        DIS_NSA(nsa_unit(p, lds, bg >> 1, bg & 1, qb)); }
    grid.sync();
    run_gemm(lds, MIX, (const bf16_t*)(ws + WS_OUT1), 1024, 1024, EpiStore{MB, DM});
    grid.sync();
    ln_phase(p.out, MB, p.in[22] + DM, p.in[23] + DM, p.out, XB);
    grid.sync();
    run_gemm(lds, XB, (const bf16_t*)(ws + WS_GU1), 2 * FF, 1024, EpiSwiglu{HB, FF});
    grid.sync();
    run_gemm(lds, HB, (const bf16_t*)(ws + WS_DN1), 1024, FF, EpiStore{MB, DM});
    grid.sync();
    ln_phase(p.out, MB, p.in[24] + DM, p.in[25] + DM, p.out, XB);
}

extern "C" void kernel_launch(void* const* d_in, const int* in_sizes, int n_in, void* d_out, int out_size, void* d_ws, size_t ws_size, hipStream_t stream) {
    static int grid = 0;
    if (grid == 0) {
        if (n_in != 26 || out_size != MTOK * DM || ws_size < WS_END) { fprintf(stderr, "kernel_launch: unexpected problem shape (n_in %d, out %d, ws %zu)\n", n_in, out_size, ws_size); grid = -1; return; }
        int dev = 0, cus = 0, per_cu = 0;
        hipGetDevice(&dev); hipDeviceGetAttribute(&cus, hipDeviceAttributeMultiprocessorCount, dev);
        hipFuncSetAttribute((const void*)fwd_megakernel, hipFuncAttributeMaxDynamicSharedMemorySize, LDS_BYTES);
        hipOccupancyMaxActiveBlocksPerMultiprocessor(&per_cu, (const void*)fwd_megakernel, 512, LDS_BYTES);
        (void)hipGetLastError();
        if (per_cu < 1) { fprintf(stderr, "kernel_launch: occupancy query says %d blocks per CU\n", per_cu); per_cu = 1; }
        grid = cus;
    }
    if (grid < 0) return;
    Params prm{};
    for (int i = 0; i < 26; ++i) prm.in[i] = (const float*)d_in[i];
    prm.out = (float*)d_out; prm.ws = (unsigned char*)d_ws;
    void* args[] = {&prm};
    hipError_t e = hipLaunchCooperativeKernel((const void*)fwd_megakernel, dim3(grid), dim3(512), args, LDS_BYTES, stream);
    if (e != hipSuccess) fprintf(stderr, "cooperative launch failed: %s (grid %d)\n", hipGetErrorString(e), grid);
}
```

```cpp
#include <hip/hip_runtime.h>
#include <hip/hip_cooperative_groups.h>
#include <cstdio>
#include <cstdint>
namespace cg = cooperative_groups;
#define LAS __attribute__((address_space(3)))
namespace pg8 {
#define PG8_LAS __attribute__((address_space(3)))
typedef unsigned short bf16_t;
typedef short bf16x8 __attribute__((ext_vector_type(8)));
typedef float f32x4 __attribute__((ext_vector_type(4)));
typedef unsigned u32x4 __attribute__((ext_vector_type(4)));
constexpr int BM = 256, BK = 64, HALF = 128, HTB = HALF * BK * 2  , STAGE_BYTES = 8 * HTB, NXCD = 8, WGM = 8;

__host__ __device__ __forceinline__ int lds_byte(int r, int c) { const int st = (r >> 4) * 2 + (c >> 5), rr = r & 15, cc = c & 31, ob = rr * 64 + cc * 2; return st * 1024 + (ob ^ (((ob >> 9) & 1) << 5)); }
__host__ __device__ __forceinline__ void stage_rc(int b, int& R, int& C) { const int st = b / 1024, sb = b % 1024, swz = sb ^ (((sb >> 9) & 1) << 5); R = (st >> 1) * 16 + swz / 64; C = (st & 1) * 32 + (swz % 64) / 2; }
__host__ __device__ __forceinline__ int perm32(int rho) { const int n = rho >> 4, i = rho & 15; return 8 * (i >> 2) + 4 * n + (i & 3); }

struct Unit { int pm, pn; };
struct Gemm { const bf16_t* A; const bf16_t* Bt; int M, N, K; };

struct StaticOrder {
    int nM, nN, nwg, G, c;
    __host__ __device__ void init(int M, int N, int G_, int c_) { nM = M / BM; nN = N / BM; nwg = nM * nN; G = G_; c = c_; }
    __host__ __device__ bool next(int i, Unit& u) const {
        const long L = (long)i * G + c; if (L >= nwg) return false;
        int wgid = (int)L; { const int q = nwg / NXCD, r = nwg % NXCD, xcd = wgid % NXCD, off = wgid / NXCD; wgid = (xcd < r ? xcd * (q + 1) : r * (q + 1) + (xcd - r) * q) + off; }
        const int nig = WGM * nN, gid = wgid / nig, fm = gid * WGM, gsz = (nM - fm) < WGM ? (nM - fm) : WGM;
        u.pm = fm + ((wgid % nig) % gsz); u.pn = (wgid % nig) / gsz; return true;
    }
    __device__ __forceinline__ void a_ready(const Unit&) const {}
    __device__ __forceinline__ void done(const Unit&) const {}
};

__device__ __forceinline__ unsigned cvt_pk_bf16(float lo, float hi) { unsigned r; asm volatile("v_cvt_pk_bf16_f32 %0, %1, %2" : "=v"(r) : "v"(lo), "v"(hi)); return r; }
typedef float f32x2 __attribute__((ext_vector_type(2)));
__device__ __forceinline__ f32x2 gelu_pk(f32x2 v) {
    const f32x2 av = __builtin_elementwise_abs(v), d = av * 0.2316418882f + 1.0f;
    f32x2 t; t.x = __builtin_amdgcn_rcpf(d.x); t.y = __builtin_amdgcn_rcpf(d.y);
    f32x2 q = t * 0.5307027145f + (-0.7265760135f); q = q * t + 0.7107068705f; q = q * t + (-0.142248368f); q = q * t + 0.127414796f; q = q * t;
    const f32x2 s = (v * v) * (-0.72134752044f);
    f32x2 e; e.x = __builtin_amdgcn_exp2f(s.x); e.y = __builtin_amdgcn_exp2f(s.y);
    const f32x2 m = v * (q * e), r = v - m;
    f32x2 o; o.x = v.x < 0.f ? m.x : r.x; o.y = v.y < 0.f ? m.y : r.y; return o;
}

template <int ACT  > struct EpiBf16 {
    static constexpr bool PERM = true, AFTER_DRAIN = false; static_assert(ACT == 0 || ACT == 1, "EpiBf16: ACT is 0 (none) or 1 (gelu_pk)");
    bf16_t* O; int ldc; const float* bias; int split_cols; size_t split_stride; float scale0;
    __device__ __forceinline__ void operator()(const f32x4 (&acc)[2][2][4][2], const Unit& u, int wr, int wc, int fr, int fq) const {
        const int row0 = u.pm * BM + wr * 64 + fr; int colt = u.pn * BM; bf16_t* base = O;
        float sc = 1.f; if (split_cols) { const int t = colt / split_cols; base += (size_t)t * split_stride; colt -= t * split_cols; if (t == 0) sc = scale0; }
        const int col0 = colt + wc * 32 + 8 * fq, bcol0 = u.pn * BM + wc * 32 + 8 * fq;
        f32x4 bv[2][2];
#pragma unroll
        for (int bj = 0; bj < 2; ++bj)
#pragma unroll
            for (int n = 0; n < 2; ++n) bv[bj][n] = bias ? *(const f32x4*)(bias + bcol0 + bj * HALF + 4 * n) : (f32x4){0.f, 0.f, 0.f, 0.f};
#pragma unroll
        for (int ai = 0; ai < 2; ++ai)
#pragma unroll
            for (int m = 0; m < 4; ++m) { bf16_t* rowp = base + (size_t)(row0 + ai * HALF + m * 16) * ldc + col0;
#pragma unroll
                for (int bj = 0; bj < 2; ++bj) { f32x4 v0 = acc[ai][bj][m][0] + bv[bj][0], v1 = acc[ai][bj][m][1] + bv[bj][1];
                    if (ACT == 1) { f32x2 a = gelu_pk((f32x2){v0[0], v0[1]}), b = gelu_pk((f32x2){v0[2], v0[3]}), c = gelu_pk((f32x2){v1[0], v1[1]}), d = gelu_pk((f32x2){v1[2], v1[3]});
                        v0 = (f32x4){a.x, a.y, b.x, b.y}; v1 = (f32x4){c.x, c.y, d.x, d.y}; }
                    v0 = v0 * sc; v1 = v1 * sc; u32x4 w; w.x = cvt_pk_bf16(v0[0], v0[1]); w.y = cvt_pk_bf16(v0[2], v0[3]); w.z = cvt_pk_bf16(v1[0], v1[1]); w.w = cvt_pk_bf16(v1[2], v1[3]);
                    *(u32x4*)(rowp + bj * HALF) = w; } }
    }
};

struct PanelStats {
    unsigned* xbuf;
    unsigned* cnt;
    unsigned* tmo;
    int ntn; float eps;
    unsigned code;
    __device__ __forceinline__ bool run(const f32x4 (&v)[2][2][4][2], const Unit& u, int wr, int wc, int fr, int fq, PG8_LAS unsigned char* lds, int wid, int lane) const {
        typedef float f32x2v __attribute__((ext_vector_type(2)));
        PG8_LAS f32x2v* P = (PG8_LAS f32x2v*)lds;
        PG8_LAS f32x2v* S = (PG8_LAS f32x2v*)(lds + 8192);
        PG8_LAS unsigned* flag = (PG8_LAS unsigned*)(lds + 8192 + 2048);
#pragma unroll
        for (int ai = 0; ai < 2; ++ai)
#pragma unroll
            for (int m = 0; m < 4; ++m) {
                float s = 0.f;
#pragma unroll
                for (int bj = 0; bj < 2; ++bj)
#pragma unroll
                    for (int n = 0; n < 2; ++n) { const f32x4 x = v[ai][bj][m][n]; s += (x[0] + x[1]) + (x[2] + x[3]); }
                s += __shfl_xor(s, 16); s += __shfl_xor(s, 32);
                const float mw = s * (1.0f / 64.0f); float q = 0.f;
#pragma unroll
                for (int bj = 0; bj < 2; ++bj)
#pragma unroll
                    for (int n = 0; n < 2; ++n) { const f32x4 d = v[ai][bj][m][n] - mw; q += (d[0] * d[0] + d[1] * d[1]) + (d[2] * d[2] + d[3] * d[3]); }
                q += __shfl_xor(q, 16); q += __shfl_xor(q, 32);
                if (fq == 0) P[(ai * HALF + wr * 64 + m * 16 + fr) * 4 + wc] = (f32x2v){mw, q};
            }
        asm volatile("s_waitcnt lgkmcnt(0)" ::: "memory"); __builtin_amdgcn_s_barrier(); asm volatile("" ::: "memory");
#if defined(BROKEN_EXCHANGE_NO_WAIT)
#warning BROKEN CONTROL BUILD: the row-statistics exchange does not wait; results are wrong by design
        if (blockIdx.x >= 64) { const long long t0_ = clock64(); while (clock64() - t0_ < 60000) __builtin_amdgcn_s_sleep(8); }
#endif
        const int row = wid * 32 + (lane & 31);
        if (lane < 32) {
            const f32x2v a = P[row * 4 + 0], b = P[row * 4 + 1], c = P[row * 4 + 2], d = P[row * 4 + 3];
            const float mt = (a.x + b.x + c.x + d.x) * 0.25f;
            const float da = a.x - mt, db = b.x - mt, dc = c.x - mt, dd = d.x - mt;
            const float m2 = (a.y + b.y) + (c.y + d.y) + 64.0f * ((da * da + db * db) + (dc * dc + dd * dd));
            unsigned long long* slot = (unsigned long long*)xbuf + ((size_t)(u.pm * BM + row) * 4 + u.pn);
            __hip_atomic_store(slot, ((unsigned long long)__float_as_uint(m2) << 32) | __float_as_uint(mt), __ATOMIC_RELAXED, __HIP_MEMORY_SCOPE_AGENT);
        }
        asm volatile("s_waitcnt vmcnt(0)" ::: "memory");
        if (lane == 0) __hip_atomic_fetch_add(cnt + 64 * u.pm, 1u, __ATOMIC_RELAXED, __HIP_MEMORY_SCOPE_AGENT);
        if (wid == 0) {
            bool dead = false; const unsigned long long t0 = __builtin_amdgcn_s_memrealtime(); const unsigned want = 8u * (unsigned)ntn;
            for (;;) {
#if defined(BROKEN_EXCHANGE_NO_WAIT)
                break;
#endif
                if ((unsigned)__builtin_amdgcn_readfirstlane(__hip_atomic_load(cnt + 64 * u.pm, __ATOMIC_RELAXED, __HIP_MEMORY_SCOPE_AGENT)) >= want) break;
                if (__builtin_amdgcn_s_memrealtime() - t0 > 2000000ull) {
                    if (lane == 0) { unsigned expect = 0u; __hip_atomic_compare_exchange_strong(tmo + 1, &expect, code | (unsigned)(u.pm & 0xff), __ATOMIC_RELAXED, __ATOMIC_RELAXED, __HIP_MEMORY_SCOPE_AGENT);
                                     __hip_atomic_store(tmo, 1u, __ATOMIC_RELAXED, __HIP_MEMORY_SCOPE_AGENT); }
                    dead = true; break; }
                __builtin_amdgcn_s_sleep(2);
            }
            __builtin_amdgcn_fence(__ATOMIC_ACQUIRE, "agent");
            if (lane == 0) flag[0] = dead ? 1u : 0u;
        }
        asm volatile("s_waitcnt vmcnt(0) lgkmcnt(0)" ::: "memory"); __builtin_amdgcn_s_barrier(); asm volatile("" ::: "memory");
        const bool bad = flag[0] != 0u;
        if (lane < 32) {
            const unsigned long long* slot = (const unsigned long long*)xbuf + (size_t)(u.pm * BM + row) * 4; float mt[4], m2[4]; float ms = 0.f;
#pragma unroll
            for (int t = 0; t < 4; ++t) { if (t < ntn) { const unsigned long long w = __hip_atomic_load(slot + t, __ATOMIC_RELAXED, __HIP_MEMORY_SCOPE_AGENT); mt[t] = __uint_as_float((unsigned)w); m2[t] = __uint_as_float((unsigned)(w >> 32)); } else { mt[t] = 0.f; m2[t] = 0.f; } ms += mt[t]; }
            const float mean = ms / (float)ntn; float q = 0.f;
#pragma unroll
            for (int t = 0; t < 4; ++t) if (t < ntn) { const float dm = mt[t] - mean; q += m2[t] + 256.0f * dm * dm; }
            S[row] = (f32x2v){mean, 1.0f / sqrtf(q / (256.0f * (float)ntn) + eps)};
        }
        asm volatile("s_waitcnt lgkmcnt(0)" ::: "memory"); __builtin_amdgcn_s_barrier(); asm volatile("" ::: "memory");
        return bad;
    }
};
struct EpiLnRes {
    static constexpr bool PERM = false, AFTER_DRAIN = true;
    const float* base; float* out; int ldc; const float* bias; PanelStats st; unsigned poison;
    __device__ __forceinline__ void fused(f32x4 (&acc)[2][2][4][2], const Unit& u, int wr, int wc, int fr, int fq, PG8_LAS unsigned char* lds, int wid, int lane) const {
        typedef float f32x2v __attribute__((ext_vector_type(2)));
        const PG8_LAS f32x2v* S = (const PG8_LAS f32x2v*)(lds + 8192);
        const int col0 = u.pn * BM + wc * 32 + 4 * fq;
#pragma unroll
        for (int bj = 0; bj < 2; ++bj)
#pragma unroll
            for (int n = 0; n < 2; ++n) { const f32x4 bv = bias ? *(const f32x4*)(bias + col0 + bj * HALF + n * 16) : (f32x4){0.f, 0.f, 0.f, 0.f};
#pragma unroll
                for (int ai = 0; ai < 2; ++ai)
#pragma unroll
                    for (int m = 0; m < 4; ++m) acc[ai][bj][m][n] += bv; }
        f32x4 pre[4][2][2];
#pragma unroll
        for (int m = 0; m < 4; ++m) { const size_t off = (size_t)(u.pm * BM + wr * 64 + m * 16 + fr) * ldc + col0;
#pragma unroll
            for (int bj = 0; bj < 2; ++bj)
#pragma unroll
                for (int n = 0; n < 2; ++n) pre[m][bj][n] = *(const f32x4*)(base + off + bj * HALF + n * 16); }
        const bool bad = st.run(acc, u, wr, wc, fr, fq, lds, wid, lane) || poison != 0u;
        const float qnan = __builtin_nanf("");
#pragma unroll
        for (int ai = 0; ai < 2; ++ai)
#pragma unroll
            for (int m = 0; m < 4; ++m) { const int r = ai * HALF + wr * 64 + m * 16 + fr; const f32x2v sr = S[r]; const size_t off = (size_t)(u.pm * BM + r) * ldc + col0;
#pragma unroll
                for (int bj = 0; bj < 2; ++bj)
#pragma unroll
                    for (int n = 0; n < 2; ++n) { const f32x4 bs = ai == 0 ? pre[m][bj][n] : *(const f32x4*)(base + off + bj * HALF + n * 16); f32x4 o = bs + (acc[ai][bj][m][n] - sr.x) * sr.y;
                        if (bad) o = (f32x4){qnan, qnan, qnan, qnan}; *(f32x4*)(out + off + bj * HALF + n * 16) = o; }
                if (m & 1) asm volatile("" ::: "memory"); }
    }
};
struct EpiLnResLn {
    static constexpr bool PERM = false, AFTER_DRAIN = true;
    const float* base; float* out; bf16_t* xn; int ldc; const float* bias; PanelStats st1, st2; unsigned poison;
    __device__ __forceinline__ void fused(f32x4 (&acc)[2][2][4][2], const Unit& u, int wr, int wc, int fr, int fq, PG8_LAS unsigned char* lds, int wid, int lane) const {
        typedef float f32x2v __attribute__((ext_vector_type(2))); typedef unsigned u32x2v __attribute__((ext_vector_type(2)));
        const PG8_LAS f32x2v* S = (const PG8_LAS f32x2v*)(lds + 8192);
        const int col0 = u.pn * BM + wc * 32 + 4 * fq;
#pragma unroll
        for (int bj = 0; bj < 2; ++bj)
#pragma unroll
            for (int n = 0; n < 2; ++n) { const f32x4 bv = bias ? *(const f32x4*)(bias + col0 + bj * HALF + n * 16) : (f32x4){0.f, 0.f, 0.f, 0.f};
#pragma unroll
                for (int ai = 0; ai < 2; ++ai)
#pragma unroll
                    for (int m = 0; m < 4; ++m) acc[ai][bj][m][n] += bv; }
        bool bad = st1.run(acc, u, wr, wc, fr, fq, lds, wid, lane) || poison != 0u;
        const float qnan = __builtin_nanf("");
#pragma unroll
        for (int ai = 0; ai < 2; ++ai)
#pragma unroll
            for (int m = 0; m < 4; ++m) { const int r = ai * HALF + wr * 64 + m * 16 + fr; const f32x2v sr = S[r]; const size_t off = (size_t)(u.pm * BM + r) * ldc + col0;
#pragma unroll
                for (int bj = 0; bj < 2; ++bj)
#pragma unroll
                    for (int n = 0; n < 2; ++n) { const f32x4 bs = *(const f32x4*)(base + off + bj * HALF + n * 16); acc[ai][bj][m][n] = bs + (acc[ai][bj][m][n] - sr.x) * sr.y; }
                asm volatile("" : "+v"(acc[ai][0][m][0]), "+v"(acc[ai][0][m][1]), "+v"(acc[ai][1][m][0]), "+v"(acc[ai][1][m][1]));
                if (m & 1) asm volatile("" ::: "memory"); }
        const bool bad1 = bad;
        bad = st2.run(acc, u, wr, wc, fr, fq, lds, wid, lane) || bad;
#pragma unroll
        for (int ai = 0; ai < 2; ++ai)
#pragma unroll
            for (int m = 0; m < 4; ++m) { const int r = ai * HALF + wr * 64 + m * 16 + fr; const f32x2v sr = S[r]; const size_t off = (size_t)(u.pm * BM + r) * ldc + col0;
#pragma unroll
                for (int bj = 0; bj < 2; ++bj)
#pragma unroll
                    for (int n = 0; n < 2; ++n) { const f32x4 x1 = acc[ai][bj][m][n]; *(f32x4*)(out + off + bj * HALF + n * 16) = bad1 ? (f32x4){qnan, qnan, qnan, qnan} : x1;
                        const f32x4 o = (x1 - sr.x) * sr.y; u32x2v w; w.x = cvt_pk_bf16(o[0], o[1]); w.y = cvt_pk_bf16(o[2], o[3]);
                        if (bad) { w.x = 0x7fc07fc0u; w.y = 0x7fc07fc0u; } *(u32x2v*)(xn + off + bj * HALF + n * 16) = w; }
                asm volatile("" ::: "memory"); }
    }
};

template <class Epi, class Sched, bool ALIGN_EPI = false, bool SP2 = false>
__device__ __forceinline__ void gemm_phase(PG8_LAS unsigned char* lds, const Gemm g, const Sched& S, const Epi& E) {
    int tid_ = threadIdx.x; asm volatile("" : "+v"(tid_)); const int tid = tid_, wid = __builtin_amdgcn_readfirstlane(tid >> 6), lane = tid & 63, wr = wid >> 2, wc = wid & 3, fr = lane & 15, fq = lane >> 4;
    const int K = g.K, nt = K / BK;
    unsigned voffA[2], voffB[2];
#pragma unroll
    for (int i = 0; i < 2; ++i) { int R, C; stage_rc(tid * 16 + i * 8192, R, C); const int Rb = Epi::PERM ? ((R & ~31) + perm32(R & 31)) : R;
        voffA[i] = (unsigned)(R * K + C) * 2u; voffB[i] = (unsigned)(Rb * K + C) * 2u; }
    const size_t kstep = (size_t)(BK * 2);
    const size_t hstep = (size_t)HALF * K * 2;
    const size_t tstep = 2 * hstep;
    const unsigned ldsw = (unsigned)wid * 1024u;
    const int aoff = lds_byte(wr * 64 + fr, fq * 8), boff = lds_byte(wc * 32 + fr, fq * 8);
#define PG8_SA(b, h) (((b) * 2 + (h)) * HTB)
#define PG8_SB(b, h) ((4 + (b) * 2 + (h)) * HTB)
#define PG8_STAGE(bufoff, gbase, voff) do { _Pragma("unroll") for (int _i = 0; _i < 2; ++_i) \
        __builtin_amdgcn_global_load_lds((const unsigned*)((const char*)(gbase) + (voff)[_i]), (PG8_LAS unsigned*)(lds + (bufoff) + ldsw + _i * 8192), 16, 0, 0); } while (0)
#define PG8_LDA(dst, b, h) do { _Pragma("unroll") for (int m = 0; m < 4; ++m) _Pragma("unroll") for (int k = 0; k < 2; ++k) dst[m][k] = *(const PG8_LAS bf16x8*)(lds + PG8_SA(b, h) + aoff + m * 2048 + k * 1024); } while (0)
#define PG8_LDB(dst, b, h) do { _Pragma("unroll") for (int n = 0; n < 2; ++n) _Pragma("unroll") for (int k = 0; k < 2; ++k) dst[n][k] = *(const PG8_LAS bf16x8*)(lds + PG8_SB(b, h) + boff + n * 2048 + k * 1024); } while (0)
#define PG8_MMA(ai, bj, At, Bt) do { __builtin_amdgcn_s_setprio(1); _Pragma("unroll") for (int m = 0; m < 4; ++m) _Pragma("unroll") for (int n = 0; n < 2; ++n) _Pragma("unroll") for (int k = 0; k < 2; ++k) \
        acc[ai][bj][m][n] = __builtin_amdgcn_mfma_f32_16x16x32_bf16(Bt[n][k], At[m][k], acc[ai][bj][m][n], 0, 0, 0); __builtin_amdgcn_s_setprio(0); } while (0)
#define PG8_WAIT_V(n) asm volatile("s_waitcnt vmcnt(" #n ")" ::: "memory")
#define PG8_WAIT_L(n) asm volatile("s_waitcnt lgkmcnt(" #n ")" ::: "memory")
#define PG8_BAR __builtin_amdgcn_s_barrier()
#define PG8_SCHED __builtin_amdgcn_sched_barrier(0)
    Unit cur, nxt; int ui = 0;
    if (!S.next(0, cur)) return;
    f32x4 acc[2][2][4][2];
#pragma unroll
    for (int a = 0; a < 2; ++a)
#pragma unroll
        for (int b = 0; b < 2; ++b)
#pragma unroll
            for (int m = 0; m < 4; ++m)
#pragma unroll
                for (int n = 0; n < 2; ++n) acc[a][b][m][n] = (f32x4){0.f, 0.f, 0.f, 0.f};
    bf16x8 At[4][2], B0[2][2], B1[2][2];
    const char* cA = (const char*)g.A + (size_t)cur.pm * tstep; const char* cB = (const char*)g.Bt + (size_t)cur.pn * tstep;
    S.a_ready(cur);
    if constexpr (SP2) {
        PG8_STAGE(PG8_SB(0, 0), cB, voffB); PG8_STAGE(PG8_SB(0, 1), cB + hstep, voffB); PG8_STAGE(PG8_SA(0, 0), cA, voffA); PG8_STAGE(PG8_SA(0, 1), cA + hstep, voffA);
        if (wr == 1) PG8_BAR;
        PG8_WAIT_V(2); PG8_BAR;
        PG8_STAGE(PG8_SB(1, 0), cB + kstep, voffB); PG8_STAGE(PG8_SA(1, 0), cA + kstep, voffA); PG8_STAGE(PG8_SB(1, 1), cB + hstep + kstep, voffB);
        PG8_WAIT_V(6); PG8_BAR;
    } else {
        PG8_STAGE(PG8_SB(0, 0), cB, voffB); PG8_STAGE(PG8_SA(0, 0), cA, voffA); PG8_STAGE(PG8_SB(0, 1), cB + hstep, voffB); PG8_STAGE(PG8_SA(0, 1), cA + hstep, voffA);
        if (wr == 1) PG8_BAR;
        PG8_WAIT_V(4); PG8_BAR;
        PG8_STAGE(PG8_SB(1, 0), cB + kstep, voffB); PG8_STAGE(PG8_SA(1, 0), cA + kstep, voffA); PG8_STAGE(PG8_SB(1, 1), cB + hstep + kstep, voffB);
        PG8_WAIT_V(6); PG8_BAR;
    }
    for (;;) {
        const bool has_next = S.next(ui + 1, nxt);
        const char* nA = has_next ? (const char*)g.A + (size_t)nxt.pm * tstep : cA; const char* nB = has_next ? (const char*)g.Bt + (size_t)nxt.pn * tstep : cB;
        for (int t = 0; t < nt; t += 2) {
            const bool last = (t == nt - 2);
            const char* a1 = cA + (size_t)(t + 1) * kstep;
            const char* a2 = last ? nA : cA + (size_t)(t + 2) * kstep; const char* b2 = last ? nB : cB + (size_t)(t + 2) * kstep;
            const char* a3 = a2 + kstep; const char* b3 = b2 + kstep;
            if (last && has_next) S.a_ready(nxt);
            if constexpr (SP2) {
            PG8_LDB(B0, 0, 0); PG8_LDB(B1, 0, 1); PG8_SCHED; PG8_LDA(At, 0, 0); PG8_STAGE(PG8_SA(1, 1), a1 + hstep, voffA);
            PG8_WAIT_V(8); PG8_WAIT_L(0); PG8_BAR; PG8_MMA(0, 0, At, B0); PG8_MMA(0, 1, At, B1); PG8_BAR; PG8_SCHED;
            PG8_LDA(At, 0, 1); PG8_STAGE(PG8_SB(0, 0), b2, voffB); PG8_STAGE(PG8_SB(0, 1), b2 + hstep, voffB); PG8_STAGE(PG8_SA(0, 0), a2, voffA);
            PG8_WAIT_V(8); PG8_WAIT_L(0); PG8_BAR; PG8_MMA(1, 0, At, B0); PG8_MMA(1, 1, At, B1); PG8_BAR; PG8_SCHED;
            PG8_LDB(B0, 1, 0); PG8_LDB(B1, 1, 1); PG8_SCHED; PG8_LDA(At, 1, 0); PG8_STAGE(PG8_SA(0, 1), a2 + hstep, voffA);
            PG8_WAIT_V(8); PG8_WAIT_L(0); PG8_BAR; PG8_MMA(0, 0, At, B0); PG8_MMA(0, 1, At, B1); PG8_BAR; PG8_SCHED;
            PG8_LDA(At, 1, 1); PG8_STAGE(PG8_SB(1, 0), b3, voffB); PG8_STAGE(PG8_SB(1, 1), b3 + hstep, voffB); PG8_STAGE(PG8_SA(1, 0), a3, voffA);
            PG8_WAIT_V(8); PG8_WAIT_L(0); PG8_BAR; PG8_MMA(1, 0, At, B0); PG8_MMA(1, 1, At, B1); PG8_BAR; PG8_SCHED;
            } else {
            PG8_LDB(B0, 0, 0); PG8_SCHED; PG8_LDA(At, 0, 0); PG8_STAGE(PG8_SA(1, 1), a1 + hstep, voffA);
            PG8_WAIT_L(8); PG8_BAR; PG8_WAIT_L(0); PG8_MMA(0, 0, At, B0); PG8_BAR; PG8_SCHED;
            PG8_LDB(B1, 0, 1); PG8_STAGE(PG8_SB(0, 0), b2, voffB);
            PG8_BAR; PG8_WAIT_L(0); PG8_MMA(0, 1, At, B1); PG8_BAR;
            PG8_LDA(At, 0, 1); PG8_STAGE(PG8_SA(0, 0), a2, voffA);
            PG8_BAR; PG8_WAIT_L(0); PG8_MMA(1, 0, At, B0); PG8_BAR; PG8_SCHED;
            PG8_STAGE(PG8_SB(0, 1), b2 + hstep, voffB);
            PG8_WAIT_V(6); PG8_BAR; PG8_MMA(1, 1, At, B1); PG8_BAR;
            PG8_LDB(B0, 1, 0); PG8_SCHED; PG8_LDA(At, 1, 0); PG8_STAGE(PG8_SA(0, 1), a2 + hstep, voffA);
            PG8_WAIT_L(8); PG8_BAR; PG8_WAIT_L(0); PG8_MMA(0, 0, At, B0); PG8_BAR; PG8_SCHED;
            PG8_LDB(B1, 1, 1); PG8_STAGE(PG8_SB(1, 0), b3, voffB);
            PG8_BAR; PG8_WAIT_L(0); PG8_MMA(0, 1, At, B1); PG8_BAR;
            PG8_LDA(At, 1, 1); PG8_STAGE(PG8_SA(1, 0), a3, voffA);
            PG8_BAR; PG8_WAIT_L(0); PG8_MMA(1, 0, At, B0); PG8_BAR; PG8_SCHED;
            PG8_STAGE(PG8_SB(1, 1), b3 + hstep, voffB);
            PG8_WAIT_V(6); PG8_BAR; PG8_MMA(1, 1, At, B1); PG8_BAR;
            }
        }
        if constexpr (ALIGN_EPI) { if (wr == 0) PG8_BAR; }
        if constexpr (!Epi::AFTER_DRAIN) { E(acc, cur, wr, wc, fr, fq); S.done(cur); }
        if (!has_next) break;
#pragma unroll
        for (int a = 0; a < 2; ++a)
#pragma unroll
            for (int b = 0; b < 2; ++b)
#pragma unroll
                for (int m = 0; m < 4; ++m)
#pragma unroll
                    for (int n = 0; n < 2; ++n) acc[a][b][m][n] = (f32x4){0.f, 0.f, 0.f, 0.f};
        cur = nxt; cA = nA; cB = nB; ++ui;
        if constexpr (ALIGN_EPI) { if (wr == 1) PG8_BAR; }
    }
    PG8_WAIT_V(0);
    if constexpr (!ALIGN_EPI) { if (wr == 0) PG8_BAR; }
    PG8_BAR;
    if constexpr (Epi::AFTER_DRAIN) { E.fused(acc, cur, wr, wc, fr, fq, lds, wid, lane); S.done(cur); }
#undef PG8_SA
#undef PG8_SB
#undef PG8_STAGE
#undef PG8_LDA
#undef PG8_LDB
#undef PG8_MMA
#undef PG8_WAIT_V
#undef PG8_WAIT_L
#undef PG8_BAR
#undef PG8_SCHED
}
}
#define XB_TMO      128
#define XB_XCNT(j)  (256  + 64 * (j))
#define XB_XSUB(j)  (1280 + 64 * (j))
#define XB_XGEN(j)  (2304 + 64 * (j))
#define XB_TOP      3328
#define XB_TOPGEN   3392
#define XCD_BAR_WORDS 3456
#define XB_SPIN_CAP (1u << 18)

__device__ __forceinline__ unsigned xb_ld(unsigned* p)              { return __hip_atomic_load(p, __ATOMIC_RELAXED, __HIP_MEMORY_SCOPE_AGENT); }
__device__ __forceinline__ unsigned xb_add(unsigned* p, unsigned v) { return __hip_atomic_fetch_add(p, v, __ATOMIC_RELAXED, __HIP_MEMORY_SCOPE_AGENT); }
__device__ __forceinline__ unsigned xb_xcc_id() { return (unsigned)__builtin_amdgcn_s_getreg((3 << 11) | 20) & 0xFu; }
#define XB_SPIN(cond, bar) do { unsigned _sp = 0; while (cond) { __builtin_amdgcn_s_sleep(1); \
    if ((++_sp & 255u) == 0u) { if (xb_ld(&(bar)[XB_TMO])) break; if (_sp > XB_SPIN_CAP) { atomicAdd(&(bar)[XB_TMO], 1u); break; } } } } while (0)

struct XcdBarrier {
    unsigned* bar; unsigned x;
    volatile LAS unsigned* st;
};

__device__ __forceinline__ XcdBarrier xcd_barrier_post(unsigned* bar, volatile LAS unsigned* st) {
    XcdBarrier b; b.bar = bar; b.x = xb_xcc_id(); b.st = st;
    if (threadIdx.x == 0) (void)xb_add(&bar[XB_XCNT(b.x)], 1u);
    return b;
}
__device__ __forceinline__ void xcd_barrier_complete(unsigned* bar, unsigned x, unsigned& nloc, unsigned& nx) {
    const unsigned G = gridDim.x * gridDim.y * gridDim.z;
    unsigned sum, cnt, mine, sp = 0u;
    for (;;) {
        sum = 0u; cnt = 0u; mine = 0u;
#pragma unroll
        for (unsigned j = 0; j < 16; ++j) { const unsigned c = xb_ld(&bar[XB_XCNT(j)]); sum += c; cnt += (c > 0u) ? 1u : 0u; mine = (j == x) ? c : mine; }
        if (sum == G) break;
        __builtin_amdgcn_s_sleep(1);
        if ((++sp & 255u) == 0u) { if (xb_ld(&bar[XB_TMO])) break; if (sp > XB_SPIN_CAP) { atomicAdd(&bar[XB_TMO], 1u); break; } }
    }
    nloc = mine > 0u ? mine : 1u; nx = cnt > 0u ? cnt : 1u;
}

__device__ __forceinline__ void xcd_barrier(const XcdBarrier& b) {
    asm volatile("s_waitcnt vmcnt(0)" ::: "memory");
    __syncthreads();
    if (threadIdx.x == 0) {
        unsigned* bar = b.bar;
        __builtin_amdgcn_s_waitcnt(0);
        unsigned nloc = b.st[0], nx = b.st[1];
        if (nloc == 0u) { xcd_barrier_complete(bar, b.x, nloc, nx); b.st[0] = nloc; b.st[1] = nx; }
        const unsigned old = xb_add(&bar[XB_XSUB(b.x)], 1u);
        const unsigned gen = old / nloc;
        if (old + 1u == (gen + 1u) * nloc) {
            __builtin_amdgcn_fence(__ATOMIC_RELEASE, "agent");
            asm volatile("s_waitcnt vmcnt(0)" ::: "memory");
            const unsigned og = xb_add(&bar[XB_TOP], 1u);
            const unsigned tg = og / nx;
            if (og + 1u == (tg + 1u) * nx) xb_add(&bar[XB_TOPGEN], 1u);
            else XB_SPIN(xb_ld(&bar[XB_TOPGEN]) == tg, bar);
            __builtin_amdgcn_fence(__ATOMIC_ACQUIRE, "agent");
            xb_add(&bar[XB_XGEN(b.x)], 1u);
            asm volatile("s_waitcnt vmcnt(0)" ::: "memory");
        } else {
            XB_SPIN(xb_ld(&bar[XB_XGEN(b.x)]) == gen, bar);
            __builtin_amdgcn_fence(__ATOMIC_ACQUIRE, "agent");
            asm volatile("s_waitcnt vmcnt(0)" ::: "memory");
        }
    }
    __syncthreads();
}

__device__ __forceinline__ void xcd_barrier_local(const XcdBarrier& b) {
    asm volatile("s_waitcnt vmcnt(0)" ::: "memory");
    __syncthreads();
    if (threadIdx.x == 0) {
        unsigned* bar = b.bar;
        __builtin_amdgcn_s_waitcnt(0);
        const unsigned nloc = b.st[0];
        const unsigned old = xb_add(&bar[XB_XSUB(b.x)], 1u);
        const unsigned gen = old / nloc;
        if (old + 1u == (gen + 1u) * nloc) xb_add(&bar[XB_XGEN(b.x)], 1u);
        else XB_SPIN(xb_ld(&bar[XB_XGEN(b.x)]) == gen, bar);
        __builtin_amdgcn_fence(__ATOMIC_ACQUIRE, "agent");
        asm volatile("s_waitcnt vmcnt(0)" ::: "memory");
    }
    __syncthreads();
}

#define XB_QSUB(q) (24576 + 64 * (q))
#define XB_QGEN(q) (28672 + 64 * (q))
__device__ __forceinline__ void quad_barrier(const XcdBarrier& b, unsigned q) {
    asm volatile("s_waitcnt vmcnt(0)" ::: "memory");
    __syncthreads();
    if (threadIdx.x == 0) {
        unsigned* bar = b.bar;
        __builtin_amdgcn_s_waitcnt(0);
        const unsigned old = xb_add(&bar[XB_QSUB(q)], 1u);
        const unsigned gen = old / 4u;
        if (old + 1u == (gen + 1u) * 4u) xb_add(&bar[XB_QGEN(q)], 1u);
        else XB_SPIN(xb_ld(&bar[XB_QGEN(q)]) == gen, bar);
        __builtin_amdgcn_fence(__ATOMIC_ACQUIRE, "agent");
        asm volatile("s_waitcnt vmcnt(0)" ::: "memory");
    }
    __syncthreads();
}

#define XB_OSUB(o) (36864 + 64 * (o))
#define XB_OGEN(o) (40960 + 64 * (o))
__device__ __forceinline__ void octet_barrier(const XcdBarrier& b, unsigned o) {
    asm volatile("s_waitcnt vmcnt(0)" ::: "memory");
    __syncthreads();
    if (threadIdx.x == 0) {
        unsigned* bar = b.bar;
        __builtin_amdgcn_s_waitcnt(0);
        const unsigned old = xb_add(&bar[XB_OSUB(o)], 1u);
        const unsigned gen = old / 8u;
        if (old + 1u == (gen + 1u) * 8u) xb_add(&bar[XB_OGEN(o)], 1u);
        else XB_SPIN(xb_ld(&bar[XB_OGEN(o)]) == gen, bar);
        __builtin_amdgcn_fence(__ATOMIC_ACQUIRE, "agent");
        asm volatile("s_waitcnt vmcnt(0)" ::: "memory");
    }
    __syncthreads();
}

#ifndef REP_GU
#define REP_GU 1
#endif
#ifndef REP_DN
#define REP_DN 1
#endif
#ifndef REP_IN
#define REP_IN 1
#endif
#ifndef REP_PRO
#define REP_PRO 1
#endif
#ifndef REP_SB
#define REP_SB 1
#endif
#ifndef REP_CONV
#define REP_CONV 1
#endif
#ifndef REP_CMP
#define REP_CMP 1
#endif
#ifndef REP_GMLP
#define REP_GMLP 1
#endif
#ifndef REP_NSA
#define REP_NSA 1
#endif
#ifndef REP_LN
#define REP_LN 1
#endif
#ifndef REP_SYNC
#define REP_SYNC 1
#endif

#ifdef XSB
#define DIS_SB(x)
#else
#define DIS_SB(x) x
#endif
#ifdef XCONV
#define DIS_CONV(x)
#else
#define DIS_CONV(x) x
#endif
#ifdef XCMP
#define DIS_CMP(x)
#else
#define DIS_CMP(x) x
#endif
#ifdef XGMLP
#define DIS_GMLP(x)
#else
#define DIS_GMLP(x) x
#endif
#ifdef XNSA
#define DIS_NSA(x)
#else
#define DIS_NSA(x) x
#endif
#ifdef XGEMM
#define DIS_GEMM(x)
#else
#define DIS_GEMM(x) x
#endif

#define LAS __attribute__((address_space(3)))
typedef unsigned short bf16_t;
typedef short bf16x8 __attribute__((ext_vector_type(8)));
typedef short s16x4 __attribute__((ext_vector_type(4)));
typedef short v4i16_t __attribute__((ext_vector_type(4)));
typedef float f32x4 __attribute__((ext_vector_type(4)));
typedef float f32x16 __attribute__((ext_vector_type(16)));
typedef unsigned u32x4 __attribute__((ext_vector_type(4)));
typedef unsigned u32x2 __attribute__((ext_vector_type(2)));

constexpr int NB = 16, SEQ = 2048, DM = 1024, MTOK = NB * SEQ;
constexpr int HW = 2560;
constexpr int FF = 2816;
constexpr float ALPHA = 1.41421356237309515f;
constexpr float LN_EPS = 1e-5f;
constexpr float LOG2E = 1.4426950408889634f;
constexpr float C2 = 0.125f * LOG2E;

constexpr size_t MiB = 1u << 20;
constexpr size_t WS_IN0 = 0 * MiB, WS_OUT0 = 6 * MiB, WS_IN1 = 8 * MiB, WS_OUT1 = 14 * MiB;
constexpr size_t WS_GU0 = 16 * MiB, WS_GU1 = 28 * MiB, WS_DN0 = 40 * MiB, WS_DN1 = 46 * MiB;
constexpr size_t WS_W1TK = 52 * MiB, WS_W1TV = 53 * MiB, WS_TRIL = 54 * MiB, WS_KCMP = 55 * MiB, WS_VCMP = 56 * MiB;
constexpr size_t WS_PT = 56 * MiB + 768 * 1024;
constexpr size_t WS_XCH = 57 * MiB, WS_CTL = 61 * MiB, CTL_BYTES = 256 * 1024;
constexpr int CW_TMO = 4096, CW_SEAM = 8192;
constexpr size_t WS_XB = 64 * MiB, WS_H = 128 * MiB, WS_MIX = 304 * MiB, WS_MB = 368 * MiB, WS_END = 432 * MiB;

constexpr int LDS_BYTES = 147456;

struct Params { const float* in[26]; float* out; unsigned char* ws; };
__device__ __forceinline__ int opaque_tid() { int t = threadIdx.x; asm volatile("" : "+v"(t)); return t; }

__device__ __forceinline__ unsigned f2bf(float f) { unsigned u = __builtin_bit_cast(unsigned, f); return (u + 0x7fffu + ((u >> 16) & 1u)) >> 16; }
__device__ __forceinline__ unsigned pk2(float lo, float hi) { return pg8::cvt_pk_bf16(lo, hi); }
__device__ __forceinline__ float bf2f(unsigned b) { return __builtin_bit_cast(float, b << 16); }
__device__ __forceinline__ float bflo(unsigned w) { return __builtin_bit_cast(float, w << 16); }
__device__ __forceinline__ float bfhi(unsigned w) { return __builtin_bit_cast(float, w & 0xffff0000u); }
__device__ __forceinline__ float wave_sum(float v) {
#pragma unroll
    for (int o = 1; o < 64; o <<= 1) v += __shfl_xor(v, o);
    return v;
}
__device__ __forceinline__ float xor32(float v) {
    const unsigned u = __builtin_bit_cast(unsigned, v);
    auto rr = __builtin_amdgcn_permlane32_swap(u, u, false, false);
    return __builtin_bit_cast(float, (threadIdx.x & 32u) ? rr[0] : rr[1]);
}
__device__ __forceinline__ float sigmoidf_(float x) { return __builtin_amdgcn_rcpf(1.f + __expf(-x)); }
__device__ __forceinline__ float siluf_(float x) { return x * __builtin_amdgcn_rcpf(1.f + __expf(-x)); }
__device__ __forceinline__ float gelu_tanh(float x) {
    const float u = 0.7978845608028654f * (x + 0.044715f * x * x * x);
    return x * __builtin_amdgcn_rcpf(1.f + __expf(-2.f * u));
}
#define LDSW() asm volatile("s_waitcnt lgkmcnt(0)" ::: "memory")
#define MFMA32(a, b, c) __builtin_amdgcn_mfma_f32_32x32x16_bf16((a), (b), (c), 0, 0, 0)
__device__ __forceinline__ int crow(int r, int hi) { return (r & 3) + 8 * (r >> 2) + 4 * hi; }

struct EpiStore {
    static constexpr bool PERM = true, AFTER_DRAIN = false;
    bf16_t* O; int ldc;
    __device__ __forceinline__ void operator()(const pg8::f32x4 (&acc)[2][2][4][2], const pg8::Unit& u, int wr, int wc, int fr, int fq) const {
        const int row0 = u.pm * 256 + wr * 64 + fr, col0 = u.pn * 256 + wc * 32 + 8 * fq;
#pragma unroll
        for (int ai = 0; ai < 2; ++ai)
#pragma unroll
            for (int m = 0; m < 4; ++m) { bf16_t* rowp = O + (size_t)(row0 + ai * 128 + m * 16) * ldc + col0;
#pragma unroll
                for (int bj = 0; bj < 2; ++bj) { const pg8::f32x4 v0 = acc[ai][bj][m][0], v1 = acc[ai][bj][m][1];
                    u32x4 w; w.x = pk2(v0[0], v0[1]); w.y = pk2(v0[2], v0[3]); w.z = pk2(v1[0], v1[1]); w.w = pk2(v1[2], v1[3]);
                    *(u32x4*)(rowp + bj * 128) = w; } }
    }
};
struct EpiResid {
    static constexpr bool PERM = true, AFTER_DRAIN = false;
    bf16_t* O; const bf16_t* X;
    __device__ __forceinline__ void operator()(const pg8::f32x4 (&acc)[2][2][4][2], const pg8::Unit& u, int wr, int wc, int fr, int fq) const {
        const int row0 = u.pm * 256 + wr * 64 + fr, col0 = u.pn * 256 + wc * 32 + 8 * fq;
#pragma unroll
        for (int ai = 0; ai < 2; ++ai)
#pragma unroll
            for (int m = 0; m < 4; ++m) { const size_t off = (size_t)(row0 + ai * 128 + m * 16) * DM + col0;
#pragma unroll
                for (int bj = 0; bj < 2; ++bj) { const pg8::f32x4 v0 = acc[ai][bj][m][0], v1 = acc[ai][bj][m][1];
                    const u32x4 xr = *(const u32x4*)(X + off + bj * 128);
                    u32x4 w; w.x = pk2(v0[0] + ALPHA * bflo(xr.x), v0[1] + ALPHA * bfhi(xr.x)); w.y = pk2(v0[2] + ALPHA * bflo(xr.y), v0[3] + ALPHA * bfhi(xr.y));
                    w.z = pk2(v1[0] + ALPHA * bflo(xr.z), v1[1] + ALPHA * bfhi(xr.z)); w.w = pk2(v1[2] + ALPHA * bflo(xr.w), v1[3] + ALPHA * bfhi(xr.w));
                    *(u32x4*)(O + off + bj * 128) = w; } }
    }
};
struct EpiSwiglu {
    static constexpr bool PERM = true, AFTER_DRAIN = false;
    bf16_t* O; int ldc;
    __device__ __forceinline__ void operator()(const pg8::f32x4 (&acc)[2][2][4][2], const pg8::Unit& u, int wr, int wc, int fr, int fq) const {
        const int row0 = u.pm * 256 + wr * 64 + fr, col0 = u.pn * 128 + wc * 16 + 4 * fq;
#pragma unroll
        for (int ai = 0; ai < 2; ++ai)
#pragma unroll
            for (int m = 0; m < 4; ++m) { bf16_t* rowp = O + (size_t)(row0 + ai * 128 + m * 16) * ldc + col0;
#pragma unroll
                for (int bj = 0; bj < 2; ++bj) { const pg8::f32x4 gv = acc[ai][bj][m][0], uv = acc[ai][bj][m][1];
                    u32x2 w; w.x = pk2(siluf_(gv[0]) * uv[0], siluf_(gv[1]) * uv[1]); w.y = pk2(siluf_(gv[2]) * uv[2], siluf_(gv[3]) * uv[3]);
                    *(u32x2*)(rowp + bj * 64) = w; } }
    }
};


struct EpiLnOut {
    static constexpr bool PERM = false, AFTER_DRAIN = true;
    const float* base; float* out; bf16_t* xb; const float* gam; const float* bet; pg8::PanelStats st;
    __device__ __forceinline__ void fused(pg8::f32x4 (&acc)[2][2][4][2], const pg8::Unit& u, int wr, int wc, int fr, int fq, PG8_LAS unsigned char* lds, int wid, int lane) const {
        typedef float f32x2v __attribute__((ext_vector_type(2)));
        const PG8_LAS f32x2v* S = (const PG8_LAS f32x2v*)(lds + 8192);
        const int col0 = u.pn * 256 + wc * 32 + 4 * fq;
#pragma unroll
        for (int ai = 0; ai < 2; ++ai)
#pragma unroll
            for (int m = 0; m < 4; ++m) { const size_t off = (size_t)(u.pm * 256 + ai * 128 + wr * 64 + m * 16 + fr) * DM + col0;
#pragma unroll
                for (int bj = 0; bj < 2; ++bj)
#pragma unroll
                    for (int n = 0; n < 2; ++n) { const pg8::f32x4 bs = *(const pg8::f32x4*)(base + off + bj * 128 + n * 16); acc[ai][bj][m][n] += bs * ALPHA; }
                asm volatile("" : "+v"(acc[ai][0][m][0]), "+v"(acc[ai][0][m][1]), "+v"(acc[ai][1][m][0]), "+v"(acc[ai][1][m][1]));
                if (m & 1) asm volatile("" ::: "memory"); }
        const bool bad = st.run(acc, u, wr, wc, fr, fq, lds, wid, lane);
        const float qnan = __builtin_nanf("");
        pg8::f32x4 gv[2][2], bv[2][2];
#pragma unroll
        for (int bj = 0; bj < 2; ++bj)
#pragma unroll
            for (int n = 0; n < 2; ++n) { gv[bj][n] = *(const pg8::f32x4*)(gam + col0 + bj * 128 + n * 16); bv[bj][n] = *(const pg8::f32x4*)(bet + col0 + bj * 128 + n * 16); }
#pragma unroll
        for (int ai = 0; ai < 2; ++ai)
#pragma unroll
            for (int m = 0; m < 4; ++m) { const int r = ai * 128 + wr * 64 + m * 16 + fr; const f32x2v sr = S[r]; const size_t off = (size_t)(u.pm * 256 + r) * DM + col0;
#pragma unroll
                for (int bj = 0; bj < 2; ++bj)
#pragma unroll
                    for (int n = 0; n < 2; ++n) {
                        pg8::f32x4 o = (acc[ai][bj][m][n] - sr.x) * sr.y * gv[bj][n] + bv[bj][n];
                        if (bad) o = (pg8::f32x4){qnan, qnan, qnan, qnan};
                        *(pg8::f32x4*)(out + off + bj * 128 + n * 16) = o; u32x2 w; w.x = pk2(o[0], o[1]); w.y = pk2(o[2], o[3]); *(u32x2*)(xb + off + bj * 128 + n * 16) = w; }
                asm volatile("" ::: "memory"); }
    }
};
struct RoundOrder {
    pg8::StaticOrder so; int round;
    __device__ __forceinline__ bool next(int i, pg8::Unit& u) const { if (i != 0) return false; return so.next(round, u); }
    __device__ __forceinline__ void a_ready(const pg8::Unit&) const {}
    __device__ __forceinline__ void done(const pg8::Unit&) const {}
};
__device__ __forceinline__ void run_gemm_ln(LAS unsigned char* lds, unsigned char* ws, const bf16_t* A, const bf16_t* Bt, int K, int inst,
                                            const float* base, float* out, bf16_t* xb, const float* gam, const float* bet) {
    pg8::Gemm g{A, Bt, MTOK, 1024, K};
    unsigned* ctl = (unsigned*)(ws + WS_CTL);
    const int nrounds = (MTOK / 256) * 4 / (int)gridDim.x;
    for (int r = 0; r < nrounds; ++r) {
        RoundOrder S; S.so.init(MTOK, 1024, (int)gridDim.x, (int)blockIdx.x); S.round = r;
        pg8::PanelStats st{(unsigned*)(ws + WS_XCH + (size_t)inst * MiB), ctl + CW_SEAM + inst * 8192, ctl + CW_TMO, 4, LN_EPS, 0x700u + (unsigned)inst};
#ifdef TEST_EXEPI
        pg8::EpiLnRes E{base, out, DM, nullptr, st, 0u};
        pg8::gemm_phase<pg8::EpiLnRes, RoundOrder, false, true>(lds, g, S, E);
#else
        EpiLnOut E{base, out, xb, gam, bet, st};
        pg8::gemm_phase<EpiLnOut, RoundOrder, false, true>(lds, g, S, E);
#endif
        __syncthreads();
    }
}

template <class Epi>
__device__ __forceinline__ void run_gemm(LAS unsigned char* lds, const bf16_t* A, const bf16_t* Bt, int N, int K, const Epi& E) {
    pg8::Gemm g{A, Bt, MTOK, N, K}; pg8::StaticOrder S; S.init(MTOK, N, (int)gridDim.x, (int)blockIdx.x);
    DIS_GEMM((pg8::gemm_phase<Epi, pg8::StaticOrder, true, true>(lds, g, S, E)));
}

__device__ __forceinline__ int map_row(int mode, int n) {
    if (mode == 0) return n;
    if (mode == 1) return (n >> 2) * 8 + (n & 3);
    if (mode == 2) return (n >> 2) * 8 + 4 + (n & 3);
    if (n < 1280) return n;
    if (n < 1304) return 2304 + (n - 1280);
    return n - 24;
}
__device__ __forceinline__ void p0_transpose_item(const float* W, int K, int N, bf16_t* WT, int mode, LAS float* scr, int item, int lane) {
    const int nblk = (N + 31) / 32, kb = item / nblk, nb = item % nblk, k0 = 64 * kb, n0 = 32 * nb;
    const int nn = n0 + (lane & 31);
    float wv[32];
#pragma unroll
    for (int i = 0; i < 32; ++i) { const int kk = 2 * i + (lane >> 5); wv[i] = (nn < N) ? W[(size_t)(k0 + kk) * N + nn] : 0.f; }
#pragma unroll
    for (int i = 0; i < 32; ++i) { const int kk = 2 * i + (lane >> 5); scr[kk * 33 + (lane & 31)] = wv[i]; }
    LDSW();
    const int c = lane & 7;
#pragma unroll
    for (int j = 0; j < 4; ++j) { const int nl = (lane >> 3) + 8 * j, n = n0 + nl; const LAS float* s = scr + (8 * c) * 33 + nl;
        u32x4 o; o.x = pk2(s[0 * 33], s[1 * 33]); o.y = pk2(s[2 * 33], s[3 * 33]); o.z = pk2(s[4 * 33], s[5 * 33]); o.w = pk2(s[6 * 33], s[7 * 33]);
        if (n < N) *(u32x4*)(WT + (size_t)map_row(mode, n) * K + k0 + 8 * c) = o; }
    LDSW();
}
__device__ __forceinline__ void p0_prologue(const Params& p, LAS unsigned char* lds) {
    const int tid = opaque_tid(), lane = tid & 63, wave = tid >> 6;
    LAS float* scr = (LAS float*)(lds + wave * 16384);
    const int gw = blockIdx.x * 8 + wave, NGW = gridDim.x * 8;
    unsigned char* ws = p.ws;
    constexpr int I_IN0 = 16 * 80, I_OUT = 16 * 32, I_IN1 = 16 * 73, I_G = 16 * 88, I_DN = 44 * 32, I_W1 = 32 * 2;
    constexpr int NITEMS = I_IN0 + 2 * I_OUT + I_IN1 + 4 * I_G + 2 * I_DN + 2 * I_W1;
    for (int it = gw; it < NITEMS; it += NGW) {
        int r = it;
        if (r < I_IN0) { p0_transpose_item(p.in[1], 1024, 2560, (bf16_t*)(ws + WS_IN0), 0, scr, r, lane); continue; } r -= I_IN0;
        if (r < I_OUT) { p0_transpose_item(p.in[6], 1024, 1024, (bf16_t*)(ws + WS_OUT0), 0, scr, r, lane); continue; } r -= I_OUT;
        if (r < I_OUT) { p0_transpose_item(p.in[18], 1024, 1024, (bf16_t*)(ws + WS_OUT1), 0, scr, r, lane); continue; } r -= I_OUT;
        if (r < I_IN1) { p0_transpose_item(p.in[7], 1024, 2328, (bf16_t*)(ws + WS_IN1), 3, scr, r, lane); continue; } r -= I_IN1;
        if (r < I_G) { p0_transpose_item(p.in[19], 1024, FF, (bf16_t*)(ws + WS_GU0), 1, scr, r, lane); continue; } r -= I_G;
        if (r < I_G) { p0_transpose_item(p.in[20], 1024, FF, (bf16_t*)(ws + WS_GU0), 2, scr, r, lane); continue; } r -= I_G;
        if (r < I_G) { p0_transpose_item(p.in[19] + (size_t)1024 * FF, 1024, FF, (bf16_t*)(ws + WS_GU1), 1, scr, r, lane); continue; } r -= I_G;
        if (r < I_G) { p0_transpose_item(p.in[20] + (size_t)1024 * FF, 1024, FF, (bf16_t*)(ws + WS_GU1), 2, scr, r, lane); continue; } r -= I_G;
        if (r < I_DN) { p0_transpose_item(p.in[21], FF, 1024, (bf16_t*)(ws + WS_DN0), 0, scr, r, lane); continue; } r -= I_DN;
        if (r < I_DN) { p0_transpose_item(p.in[21] + (size_t)FF * 1024, FF, 1024, (bf16_t*)(ws + WS_DN1), 0, scr, r, lane); continue; } r -= I_DN;
        if (r < I_W1) { p0_transpose_item(p.in[9], 2048, 64, (bf16_t*)(ws + WS_W1TK), 0, scr, r, lane); continue; } r -= I_W1;
        p0_transpose_item(p.in[12], 2048, 64, (bf16_t*)(ws + WS_W1TV), 0, scr, r, lane);
    }
    if (blockIdx.x < 16) {
        const int kv = blockIdx.x >> 3, kp = blockIdx.x & 7; const float* pos = p.in[kv ? 11 : 8]; const float* w1 = p.in[kv ? 12 : 9];
        LAS float* ptL = (LAS float*)(lds + 135168);
        const int e = tid & 63, sub = tid >> 6, k0 = kp * 256 + sub * 32;
        float pv_[32], wv_[32];
#pragma unroll
        for (int i = 0; i < 32; ++i) { pv_[i] = pos[k0 + i]; wv_[i] = w1[(size_t)(k0 + i) * 64 + e]; }
        float a0 = 0.f, a1 = 0.f, a2 = 0.f, a3 = 0.f;
#pragma unroll
        for (int i = 0; i < 32; i += 4) { a0 += pv_[i] * wv_[i]; a1 += pv_[i + 1] * wv_[i + 1]; a2 += pv_[i + 2] * wv_[i + 2]; a3 += pv_[i + 3] * wv_[i + 3]; }
        ptL[sub * 64 + e] = (a0 + a1) + (a2 + a3);
        __syncthreads();
        if (tid < 64) { float pt = 0.f;
#pragma unroll
            for (int ww = 0; ww < 8; ++ww) pt += ptL[ww * 64 + tid];
            ((float*)(ws + WS_PT))[(kv * 8 + kp) * 64 + tid] = pt; }
        __syncthreads();
    }
    const int gt = blockIdx.x * 512 + tid, NGT = gridDim.x * 512;
    { u32x4* z = (u32x4*)((bf16_t*)(ws + WS_IN1) + (size_t)2328 * 1024); const int n16 = 232 * 1024 * 2 / 16;
      for (int i = gt; i < n16; i += NGT) z[i] = (u32x4){0u, 0u, 0u, 0u}; }
    { const float* wsrc = p.in[16]; bf16_t* tr = (bf16_t*)(ws + WS_TRIL);
      for (int i = gt; i < 4 * 128 * 128; i += NGT) { const int t = (i >> 7) & 127, s = i & 127; tr[i] = (bf16_t)((s <= t) ? f2bf(wsrc[i]) : 0u); } }
    { const float* x = p.in[0]; bf16_t* xb = (bf16_t*)(ws + WS_XB);
      for (int m = gw; m < MTOK; m += 4 * NGW) {
          f32x4 v[4][4];
#pragma unroll
          for (int r = 0; r < 4; ++r) { const int mm = m + r * NGW; if (mm < MTOK) { const f32x4* xr = (const f32x4*)(x + (size_t)mm * DM) + lane;
#pragma unroll
              for (int j = 0; j < 4; ++j) v[r][j] = xr[64 * j]; } }
#pragma unroll
          for (int r = 0; r < 4; ++r) { const int mm = m + r * NGW; if (mm < MTOK) { u32x2* o8 = (u32x2*)(xb + (size_t)mm * DM) + lane;
#pragma unroll
              for (int j = 0; j < 4; ++j) { u32x2 w; w.x = pk2(v[r][j].x, v[r][j].y); w.y = pk2(v[r][j].z, v[r][j].w); o8[64 * j] = w; } } } } }
}

template <bool F32IN, bool F32OUT>
__device__ __forceinline__ void ln_phase(const float* xin, const bf16_t* xbin, const bf16_t* mb, const float* gam, const float* bet, float* xout, bf16_t* xb) {
    const int tid = opaque_tid(), lane = tid & 63, wave = tid >> 6;
    const int G_ = gridDim.x, bx_ = blockIdx.x; const bool xown = (G_ == 256);
    const int vc_ = xown ? (bx_ % 8) * 32 + bx_ / 8 : bx_;
    const int r_ = bx_ / 8, p_ = r_ & 7, qw_ = (r_ >> 3) * 8 + wave, panel0 = (bx_ % 8) * 16 + p_;
    f32x4 gv[4], bv[4];
#pragma unroll
    for (int j = 0; j < 4; ++j) { gv[j] = ((const f32x4*)gam)[64 * j + lane]; bv[j] = ((const f32x4*)bet)[64 * j + lane]; }
    const int nrows = xown ? 16 : (MTOK + G_ * 8 - 1) / (G_ * 8);
    for (int it_ = 0; it_ < nrows; ++it_) {
        const int m = xown ? (panel0 + 8 * (it_ >> 3)) * 256 + qw_ + 32 * (it_ & 7) : bx_ * 8 + wave + it_ * G_ * 8;
        if (m >= MTOK) break;
        const u32x2* mr = (const u32x2*)(mb + (size_t)m * DM) + lane;
        f32x4 v[4]; float s = 0.f;
#pragma unroll
        for (int j = 0; j < 4; ++j) { f32x4 x;
            if (F32IN) x = ((const f32x4*)(xin + (size_t)m * DM) + lane)[64 * j];
            else { const u32x2 xw = ((const u32x2*)(xbin + (size_t)m * DM) + lane)[64 * j]; x.x = bflo(xw.x); x.y = bfhi(xw.x); x.z = bflo(xw.y); x.w = bfhi(xw.y); }
            const u32x2 w = mr[64 * j];
            v[j].x = ALPHA * x.x + bflo(w.x); v[j].y = ALPHA * x.y + bfhi(w.x); v[j].z = ALPHA * x.z + bflo(w.y); v[j].w = ALPHA * x.w + bfhi(w.y);
            s += (v[j].x + v[j].y) + (v[j].z + v[j].w); }
        const float mean = wave_sum(s) * (1.f / DM); float s2 = 0.f;
#pragma unroll
        for (int j = 0; j < 4; ++j) { v[j] = v[j] - mean; s2 += (v[j].x * v[j].x + v[j].y * v[j].y) + (v[j].z * v[j].z + v[j].w * v[j].w); }
        const float rstd = rsqrtf(wave_sum(s2) * (1.f / DM) + LN_EPS);
#pragma unroll
        for (int j = 0; j < 4; ++j) { const f32x4 o = v[j] * rstd * gv[j] + bv[j];
            if (F32OUT) ((f32x4*)(xout + (size_t)m * DM) + lane)[64 * j] = o;
            else { u32x2 w; w.x = pk2(o.x, o.y); w.y = pk2(o.z, o.w); ((u32x2*)(xb + (size_t)m * DM) + lane)[64 * j] = w; } }
    }
}

constexpr int KS = 144;
constexpr int TILEB = 64 * KS;
constexpr int L_K = 0, L_V = 2 * TILEB, L_WSF = 4 * TILEB  , L_DONE = L_WSF + 1024, L_IMP = L_DONE + 256  , L_SEL = L_IMP + 4 * 64 * 33 * 4  , L_OACC = 73728;

__device__ __forceinline__ s16x4 vtr(const LAS char* p) { return __builtin_bit_cast(s16x4, __builtin_amdgcn_ds_read_tr16_b64_v4i16((LAS v4i16_t*)p)); }

__device__ __forceinline__ f32x16 qk_sub(const LAS char* kt, int sub, const bf16x8 (&qr)[4], int r32, int hi) {
    f32x16 s;
#pragma unroll
    for (int i = 0; i < 16; ++i) s[i] = 0.f;
    const LAS char* kp = kt + (32 * sub + r32) * KS + hi * 16;
#pragma unroll
    for (int d0 = 0; d0 < 4; ++d0) { const bf16x8 a = *(const LAS bf16x8*)(kp + d0 * 32); s = MFMA32(a, qr[d0], s); }
    return s;
}
__device__ __forceinline__ void pv_sub(f32x16 (&o)[2], const f32x16& p, const LAS char* vt, int sub, int lane) {
    const int hi = lane >> 5;
    const LAS char* vp = vt + (32 * sub + 4 * hi + ((lane & 15) >> 2)) * KS + (16 * ((lane >> 4) & 1) + 4 * (lane & 3)) * 2;
#pragma unroll
    for (int s = 0; s < 2; ++s) {
        u32x4 pw; pw.x = pk2(p[8 * s + 0], p[8 * s + 1]); pw.y = pk2(p[8 * s + 2], p[8 * s + 3]); pw.z = pk2(p[8 * s + 4], p[8 * s + 5]); pw.w = pk2(p[8 * s + 6], p[8 * s + 7]);
        const bf16x8 pa = __builtin_bit_cast(bf16x8, pw);
#pragma unroll
        for (int db = 0; db < 2; ++db) {
            const s16x4 lo = vtr(vp + (16 * s) * KS + db * 64), hi4 = vtr(vp + (16 * s + 8) * KS + db * 64);
            const bf16x8 vb = (bf16x8){lo[0], lo[1], lo[2], lo[3], hi4[0], hi4[1], hi4[2], hi4[3]};
            o[db] = MFMA32(pa, vb, o[db]);
        }
    }
}
__device__ __forceinline__ void bcast_rows(float (&f)[16], LAS float* wsf_w, float val, int r32, int hi) {
    LDSW();
    if (hi == 0) wsf_w[r32] = val;
    LDSW();
#pragma unroll
    for (int r = 0; r < 16; ++r) f[r] = wsf_w[crow(r, hi)];
    LDSW();
}

__device__ __forceinline__ void sb_unit(const Params& p, LAS unsigned char* lds8, int b, int hp, int qb) {
    LAS char* lds = (LAS char*)lds8;
    const int tid = opaque_tid(), lane = tid & 63, w = __builtin_amdgcn_readfirstlane(tid >> 6), r32 = lane & 31, hi = lane >> 5;
    const int hd = w >> 2, hh = 2 * hp + hd, wq = w & 3;
    const bf16_t* H0 = (const bf16_t*)(p.ws + WS_H);
    bf16_t* MIX = (bf16_t*)(p.ws + WS_MIX);
    const size_t rowbase = (size_t)b * SEQ;
    const int t = 128 * qb + 32 * wq + r32, twmax = 128 * qb + 32 * wq + 31;
    constexpr int SB_K = 0, SB_V = 4 * TILEB, SB_DONE = 8 * TILEB;
    bf16x8 qr[4];
    { const bf16_t* qp = H0 + (rowbase + t) * HW + hh * 64;
#pragma unroll
      for (int d0 = 0; d0 < 4; ++d0) qr[d0] = *(const bf16x8*)(qp + 16 * d0 + 8 * hi); }
    f32x16 o[2];
#pragma unroll
    for (int i = 0; i < 16; ++i) { o[0][i] = 0.f; o[1][i] = 0.f; }
    float R = 0.f; bool wdone = false;
    const int lrow = tid >> 3, lch = tid & 7;
    const bf16_t* kg = H0 + (rowbase + lrow) * HW + 512 + (2 * hp) * 64 + lch * 8; const bf16_t* vg = kg + 512;
    LAS unsigned* doneL = (LAS unsigned*)(lds + SB_DONE);
    int j = 2 * qb + 1;
    u32x4 k0 = *(const u32x4*)(kg + (size_t)(64 * j) * HW), k1 = *(const u32x4*)(kg + (size_t)(64 * j) * HW + 64);
    u32x4 v0 = *(const u32x4*)(vg + (size_t)(64 * j) * HW), v1 = *(const u32x4*)(vg + (size_t)(64 * j) * HW + 64);
    for (int it = 0;; ++it) {
        LAS char* kw = lds + SB_K + (it & 1) * 2 * TILEB + lrow * KS + lch * 16; LAS char* vw = lds + SB_V + (it & 1) * 2 * TILEB + lrow * KS + lch * 16;
        *(LAS u32x4*)kw = k0; *(LAS u32x4*)(kw + TILEB) = k1; *(LAS u32x4*)vw = v0; *(LAS u32x4*)(vw + TILEB) = v1;
        if (lane == 0) doneL[(it & 1) * 8 + w] = wdone ? 1u : 0u;
        __syncthreads();
        { const u32x4 d0 = *(const LAS u32x4*)(doneL + (it & 1) * 8), d1 = *(const LAS u32x4*)(doneL + (it & 1) * 8 + 4);
          const unsigned all = d0.x & d0.y & d0.z & d0.w & d1.x & d1.y & d1.z & d1.w;
          if (all) break; }
        if (j > 0) { k0 = *(const u32x4*)(kg + (size_t)(64 * (j - 1)) * HW); k1 = *(const u32x4*)(kg + (size_t)(64 * (j - 1)) * HW + 64);
                     v0 = *(const u32x4*)(vg + (size_t)(64 * (j - 1)) * HW); v1 = *(const u32x4*)(vg + (size_t)(64 * (j - 1)) * HW + 64); }
        const LAS char* kt = lds + SB_K + ((it & 1) * 2 + hd) * TILEB; const LAS char* vt = lds + SB_V + ((it & 1) * 2 + hd) * TILEB;
#pragma unroll
        for (int sb_ = 0; sb_ < 2; ++sb_) {
            const int sub = 1 - sb_;
            const int kvb = 64 * j + 32 * sub;
            if (kvb >= twmax || wdone) continue;
            const f32x16 s = qk_sub(kt, sub, qr, r32, hi);
            float lr[16], lb[16];
#pragma unroll
            for (int r = 0; r < 16; ++r) {
                const int kv = kvb + crow(r, hi); const float z = s[r] * 0.125f;
                const float sp = fmaxf(z, 0.f) + __logf(1.f + __expf(-fabsf(z)));
                const bool past = kv < t;
                lr[r] = past ? -sp : 0.f; lb[r] = z - sp;
            }
            float T[4], To[4], aft[16];
#pragma unroll
            for (int gq = 0; gq < 4; ++gq) {
                aft[4 * gq + 3] = 0.f; aft[4 * gq + 2] = lr[4 * gq + 3]; aft[4 * gq + 1] = aft[4 * gq + 2] + lr[4 * gq + 2]; aft[4 * gq + 0] = aft[4 * gq + 1] + lr[4 * gq + 1];
                T[gq] = aft[4 * gq + 0] + lr[4 * gq + 0];
            }
#pragma unroll
            for (int gq = 0; gq < 4; ++gq) To[gq] = xor32(T[gq]);
            float A = 0.f;
            f32x16 pw;
#pragma unroll
            for (int gq = 3; gq >= 0; --gq) {
                const float ga = A + (hi == 0 ? To[gq] : 0.f);
#pragma unroll
                for (int i = 0; i < 4; ++i) { const int r = 4 * gq + i; const int kv = kvb + crow(r, hi);
                    const float e = __expf(lb[r] + R + ga + aft[r]); pw[r] = (kv < t) ? e : 0.f; }
                A += T[gq] + To[gq];
            }
            R += A;
            pv_sub(o, pw, vt, sub, lane);
            wdone = __all(R < -45.f);
        }
        wdone = wdone || __all(R < -45.f);
        if (j == 0) break;
        --j;
    }
    __syncthreads();
    bf16_t* op = MIX + (rowbase + 128 * qb + 32 * wq) * DM + hh * 64 + r32;
#pragma unroll
    for (int r = 0; r < 16; ++r) { const int q = crow(r, hi);
        op[(size_t)q * DM] = (bf16_t)f2bf(o[0][r]); op[(size_t)q * DM + 32] = (bf16_t)f2bf(o[1][r]); }
}

__device__ __forceinline__ void conv_unit(const Params& p, LAS unsigned char* lds8, int b, int tile) {
    const int tid = opaque_tid(), lane = tid & 63, w = tid >> 6;
    const bf16_t* H0 = (const bf16_t*)(p.ws + WS_H);
    bf16_t* MIX = (bf16_t*)(p.ws + WS_MIX);
    LAS bf16_t* hL = (LAS bf16_t*)lds8;
    LAS float* yL = (LAS float*)(lds8 + 63488);
    const int t0 = 32 * tile;
    const float* cw = p.in[2]; const float bias = p.in[3][tid];
    float wd[31];
#pragma unroll
    for (int k = 0; k < 31; ++k) wd[k] = cw[k * 512 + tid];
    const f32x4 g0 = ((const f32x4*)p.in[4])[lane * 2], g1 = ((const f32x4*)p.in[4])[lane * 2 + 1];
    const f32x4 b0 = ((const f32x4*)p.in[5])[lane * 2], b1 = ((const f32x4*)p.in[5])[lane * 2 + 1];
    {
        u32x4 av[8], gv8[8];
#pragma unroll
        for (int i = 0; i < 8; ++i) { const int tt = w + 8 * i, tok = t0 - 30 + tt; av[i] = (u32x4){0u, 0u, 0u, 0u}; gv8[i] = (u32x4){0u, 0u, 0u, 0u};
            if (tt < 62 && tok >= 0) { const bf16_t* rp = H0 + ((size_t)b * SEQ + tok) * HW + 1536 + lane * 8; av[i] = *(const u32x4*)rp; gv8[i] = *(const u32x4*)(rp + 512); } }
#pragma unroll
        for (int i = 0; i < 8; ++i) { const int tt = w + 8 * i; const u32x4 a = av[i], g = gv8[i]; u32x4 o;
            o.x = pk2(bflo(a.x) * sigmoidf_(bflo(g.x)), bfhi(a.x) * sigmoidf_(bfhi(g.x)));
            o.y = pk2(bflo(a.y) * sigmoidf_(bflo(g.y)), bfhi(a.y) * sigmoidf_(bfhi(g.y)));
            o.z = pk2(bflo(a.z) * sigmoidf_(bflo(g.z)), bfhi(a.z) * sigmoidf_(bfhi(g.z)));
            o.w = pk2(bflo(a.w) * sigmoidf_(bflo(g.w)), bfhi(a.w) * sigmoidf_(bfhi(g.w)));
            if (tt < 62) *(LAS u32x4*)(hL + tt * 512 + lane * 8) = o; }
    }
    __syncthreads();
    {
        const int c = tid;
        float hv[62];
#pragma unroll
        for (int i = 0; i < 62; ++i) hv[i] = bf2f((unsigned)hL[i * 512 + c]);
#pragma unroll
        for (int tq = 0; tq < 32; ++tq) { float y = bias;
#pragma unroll
            for (int k = 0; k < 31; ++k) y += hv[tq + k] * wd[k];
            yL[tq * 512 + c] = y; }
    }
    __syncthreads();
    {
#pragma unroll
        for (int i = 0; i < 4; ++i) { const int tq = 4 * w + i;
            f32x4 v0 = *(const LAS f32x4*)(yL + tq * 512 + lane * 8), v1 = *(const LAS f32x4*)(yL + tq * 512 + lane * 8 + 4);
            const float mean = wave_sum((v0.x + v0.y) + (v0.z + v0.w) + (v1.x + v1.y) + (v1.z + v1.w)) * (1.f / 512.f);
            v0 = v0 - mean; v1 = v1 - mean;
            const float var = wave_sum((v0.x * v0.x + v0.y * v0.y) + (v0.z * v0.z + v0.w * v0.w) + (v1.x * v1.x + v1.y * v1.y) + (v1.z * v1.z + v1.w * v1.w)) * (1.f / 512.f);
            const float rstd = rsqrtf(var + LN_EPS);
            v0 = v0 * rstd * g0 + b0; v1 = v1 * rstd * g1 + b1;
            u32x4 o; o.x = pk2(siluf_(v0.x), siluf_(v0.y)); o.y = pk2(siluf_(v0.z), siluf_(v0.w)); o.z = pk2(siluf_(v1.x), siluf_(v1.y)); o.w = pk2(siluf_(v1.z), siluf_(v1.w));
            *(u32x4*)(MIX + ((size_t)b * SEQ + t0 + tq) * DM + 512 + lane * 8) = o; }
    }
    __syncthreads();
}

__device__ __forceinline__ void compress_unit(const Params& p, LAS unsigned char* lds8, int b, int g, int kv, int nt) {
    LAS char* lds = (LAS char*)lds8;
    const int tid = opaque_tid(), lane = tid & 63, w = __builtin_amdgcn_readfirstlane(tid >> 6), r32 = lane & 31, hi = lane >> 5;
    const bf16_t* H1 = (const bf16_t*)(p.ws + WS_H);
    const float* w2 = p.in[kv ? 13 : 10];
    const bf16_t* w1t = (const bf16_t*)(p.ws + (kv ? WS_W1TV : WS_W1TK));
    bf16_t* outp = (bf16_t*)(p.ws + (kv ? WS_VCMP : WS_KCMP)) + (size_t)((b * 2 + g) * 128 + 32 * nt) * 64;
    constexpr int L_SLAB = 0, L_PART = 76032, L_PT = 76032 + 65536;
    LAS float* partL = (LAS float*)(lds + L_PART); const float* ptg = (const float*)(p.ws + WS_PT) + kv * 512;
    const int col = 512 + kv * 128 + g * 64;
#pragma unroll
    for (int it9 = 0; it9 < 9; ++it9) { const int idx = tid + 512 * it9; if (idx >= 528 * 8) break; const int i = idx >> 3, ch = idx & 7, tok = 512 * nt + i;
        u32x4 v = (u32x4){0u, 0u, 0u, 0u};
        if (tok < SEQ) v = *(const u32x4*)(H1 + ((size_t)b * SEQ + tok) * HW + col + ch * 8);
        *(LAS u32x4*)(lds + L_SLAB + ((i & 15) * 33 + (i >> 4)) * KS + ch * 16) = v; }
    __syncthreads();
    f32x16 acc[2];
#pragma unroll
    for (int i = 0; i < 16; ++i) { acc[0][i] = 0.f; acc[1][i] = 0.f; }
#pragma unroll
    for (int li = 0; li < 4; ++li) { const int l = 4 * w + li, c = l & 15, mo = l >> 4;
        const LAS char* ap = lds + L_SLAB + (c * 33 + r32 + mo) * KS + hi * 16;
        const bf16_t* bp = w1t + (size_t)r32 * 2048 + l * 64 + 8 * hi;
#pragma unroll
        for (int d0 = 0; d0 < 4; ++d0) { const bf16x8 a = *(const LAS bf16x8*)(ap + d0 * 32);
            const bf16x8 b0 = *(const bf16x8*)(bp + 16 * d0), b1 = *(const bf16x8*)(bp + (size_t)32 * 2048 + 16 * d0);
            acc[0] = MFMA32(a, b0, acc[0]); acc[1] = MFMA32(a, b1, acc[1]); } }
#pragma unroll
    for (int r = 0; r < 16; ++r) { const int n = crow(r, hi); partL[(w * 32 + n) * 64 + r32] = acc[0][r]; partL[(w * 32 + n) * 64 + 32 + r32] = acc[1][r]; }
    __syncthreads();
    LAS float* hidL = (LAS float*)(lds + L_SLAB);
    LAS float* w2L = (LAS float*)(lds + L_SLAB + 8448);
    { const f32x4 wa = ((const f32x4*)w2)[tid], wb = ((const f32x4*)w2)[tid + 512]; *(LAS f32x4*)(w2L + tid * 4) = wa; *(LAS f32x4*)(w2L + (tid + 512) * 4) = wb; }
#pragma unroll
    for (int i = 0; i < 4; ++i) { const int idx = tid + 512 * i, n = idx >> 6, e = idx & 63; float s = 0.f;
#pragma unroll
        for (int ww = 0; ww < 8; ++ww) s += partL[(ww * 32 + n) * 64 + e];
        const float pt = ((ptg[e] + ptg[64 + e]) + (ptg[128 + e] + ptg[192 + e])) + ((ptg[256 + e] + ptg[320 + e]) + (ptg[384 + e] + ptg[448 + e]));
        hidL[n * 65 + e] = gelu_tanh(s + pt); }
    __syncthreads();
    { const int n = tid >> 4, e2 = (tid & 15) * 4; float o0 = 0.f, o1 = 0.f, o2 = 0.f, o3 = 0.f;
#pragma unroll 8
      for (int e = 0; e < 64; ++e) { const float hval = hidL[n * 65 + e]; const f32x4 wv = *(const LAS f32x4*)(w2L + e * 64 + e2);
          o0 += hval * wv.x; o1 += hval * wv.y; o2 += hval * wv.z; o3 += hval * wv.w; }
      u32x2 ov; ov.x = pk2(o0, o1); ov.y = pk2(o2, o3);
      if (32 * nt + n >= 127) { ov.x = 0u; ov.y = 0u; }
      *(u32x2*)(outp + (size_t)n * 64 + e2) = ov; }
    __syncthreads();
}

__device__ __forceinline__ void gmlp_unit(const Params& p, LAS unsigned char* lds8, int b, int ch) {
    LAS char* lds = (LAS char*)lds8;
    const int tid = opaque_tid(), lane = tid & 63, w = __builtin_amdgcn_readfirstlane(tid >> 6), r32 = lane & 31, hi = lane >> 5;
    const bf16_t* H1 = (const bf16_t*)(p.ws + WS_H);
    bf16_t* MIX = (bf16_t*)(p.ws + WS_MIX);
    const bf16_t* TR = (const bf16_t*)(p.ws + WS_TRIL);
    constexpr int VS = 1040;
    const size_t row0 = (size_t)b * SEQ + 128 * ch;
    {
        const f32x4 g0 = ((const f32x4*)p.in[14])[lane * 2], g1 = ((const f32x4*)p.in[14])[lane * 2 + 1];
        const f32x4 b0 = ((const f32x4*)p.in[15])[lane * 2], b1 = ((const f32x4*)p.in[15])[lane * 2 + 1];
        for (int tq0 = w; tq0 < 128; tq0 += 64) {
            u32x4 raw4[8];
#pragma unroll
            for (int i = 0; i < 8; ++i) raw4[i] = *(const u32x4*)(H1 + (row0 + tq0 + 8 * i) * HW + 1792 + lane * 8);
#pragma unroll
            for (int i = 0; i < 8; ++i) { const int tq = tq0 + 8 * i; const u32x4 raw = raw4[i];
            f32x4 v0, v1;
            v0.x = gelu_tanh(bflo(raw.x)); v0.y = gelu_tanh(bfhi(raw.x)); v0.z = gelu_tanh(bflo(raw.y)); v0.w = gelu_tanh(bfhi(raw.y));
            v1.x = gelu_tanh(bflo(raw.z)); v1.y = gelu_tanh(bfhi(raw.z)); v1.z = gelu_tanh(bflo(raw.w)); v1.w = gelu_tanh(bfhi(raw.w));
            const float mean = wave_sum((v0.x + v0.y) + (v0.z + v0.w) + (v1.x + v1.y) + (v1.z + v1.w)) * (1.f / 512.f);
            v0 = v0 - mean; v1 = v1 - mean;
            const float var = wave_sum((v0.x * v0.x + v0.y * v0.y) + (v0.z * v0.z + v0.w * v0.w) + (v1.x * v1.x + v1.y * v1.y) + (v1.z * v1.z + v1.w * v1.w)) * (1.f / 512.f);
            const float rstd = rsqrtf(var + LN_EPS);
            v0 = v0 * rstd * g0 + b0; v1 = v1 * rstd * g1 + b1;
            u32x4 o; o.x = pk2(v0.x, v0.y); o.y = pk2(v0.z, v0.w); o.z = pk2(v1.x, v1.y); o.w = pk2(v1.z, v1.w);
            *(LAS u32x4*)(lds + tq * VS + lane * 16) = o; }
        }
    }
    __syncthreads();
    const int gi = w >> 1, th = w & 1;
    f32x16 acc[2][4];
#pragma unroll
    for (int a = 0; a < 2; ++a)
#pragma unroll
        for (int d = 0; d < 4; ++d)
#pragma unroll
            for (int i = 0; i < 16; ++i) acc[a][d][i] = 0.f;
    const bf16_t* ap = TR + (size_t)(gi * 128 + 64 * th + r32) * 128 + 8 * hi;
    const LAS char* vp = lds + (8 * hi + ((lane & 15) >> 2)) * VS + (128 * gi + 16 * ((lane >> 4) & 1) + 4 * (lane & 3)) * 2;
    const int nks = 4 * th + 4;
    for (int ks = 0; ks < nks; ++ks) {
        const bf16x8 a0 = *(const bf16x8*)(ap + 16 * ks), a1 = *(const bf16x8*)(ap + 32 * 128 + 16 * ks);
#pragma unroll
        for (int db = 0; db < 4; ++db) {
            const s16x4 lo = vtr(vp + (16 * ks) * VS + db * 64), hi4 = vtr(vp + (16 * ks + 4) * VS + db * 64);
            const bf16x8 vb = (bf16x8){lo[0], lo[1], lo[2], lo[3], hi4[0], hi4[1], hi4[2], hi4[3]};
            acc[0][db] = MFMA32(a0, vb, acc[0][db]); acc[1][db] = MFMA32(a1, vb, acc[1][db]);
        }
    }
    __syncthreads();
    {
        const float* bs = p.in[17] + gi * 128;
        LAS float* st = (LAS float*)(lds + w * 16896);
        const int rrow = lane >> 4, c8 = (lane & 15) * 8;
#pragma unroll
        for (int tb = 0; tb < 2; ++tb) {
#pragma unroll
            for (int r = 0; r < 16; ++r) { const int q = crow(r, hi); const float bias = bs[64 * th + 32 * tb + q];
#pragma unroll
                for (int db = 0; db < 4; ++db) st[q * 132 + 32 * db + r32] = acc[tb][db][r] + bias; }
            LDSW();
#pragma unroll
            for (int i = 0; i < 8; ++i) { const int row = 4 * i + rrow, tq = 64 * th + 32 * tb + row;
                const f32x4 m0 = *(const LAS f32x4*)(st + row * 132 + c8), m1 = *(const LAS f32x4*)(st + row * 132 + c8 + 4);
                const u32x4 uu = *(const u32x4*)(H1 + (row0 + tq) * HW + 1280 + 128 * gi + c8);
                u32x4 o; o.x = pk2(gelu_tanh(bflo(uu.x)) * m0.x, gelu_tanh(bfhi(uu.x)) * m0.y); o.y = pk2(gelu_tanh(bflo(uu.y)) * m0.z, gelu_tanh(bfhi(uu.y)) * m0.w);
                o.z = pk2(gelu_tanh(bflo(uu.z)) * m1.x, gelu_tanh(bfhi(uu.z)) * m1.y); o.w = pk2(gelu_tanh(bflo(uu.w)) * m1.z, gelu_tanh(bfhi(uu.w)) * m1.w);
                *(u32x4*)(MIX + (row0 + tq) * DM + 512 + 128 * gi + c8) = o; }
            LDSW();
        }
    }
    __syncthreads();
}

template <int MODE>
__device__ __forceinline__ void nsa_tile(float& m, float& l, f32x16 (&o)[2], const LAS char* kt, const LAS char* vt, LAS float* wsf_w, const bf16x8 (&qr)[4],
                                         int j, unsigned selm, int t, int twmin, int twmax, int lane) {
    const int r32 = lane & 31, hi = lane >> 5;
    const bool selected = (MODE == 1) ? (((selm >> j) & 1u) != 0u) : true;
    if (64 * j + 63 <= twmin && (MODE == 1 || 64 * j >= twmax - 511)) {
        if (MODE == 1 && !__any(selected)) return;
        bf16x8 kf[8];
        { const LAS char* kp = kt + r32 * KS + hi * 16;
#pragma unroll
          for (int i = 0; i < 8; ++i) kf[i] = *(const LAS bf16x8*)(kp + (i >> 2) * (32 * KS) + (i & 3) * 32); }
        __builtin_amdgcn_sched_barrier(0);
        f32x16 s0, s1;
#pragma unroll
        for (int i = 0; i < 16; ++i) { s0[i] = 0.f; s1[i] = 0.f; }
#pragma unroll
        for (int d0 = 0; d0 < 4; ++d0) { s0 = MFMA32(kf[d0], qr[d0], s0); s1 = MFMA32(kf[4 + d0], qr[d0], s1); }
        s16x4 vf[16];
        { const LAS char* vp = vt + (4 * hi + ((lane & 15) >> 2)) * KS + (16 * ((lane >> 4) & 1) + 4 * (lane & 3)) * 2;
#pragma unroll
          for (int i = 0; i < 16; ++i) { const int sub = i >> 3, ss = (i >> 2) & 1, db = (i >> 1) & 1, jj = i & 1;
              vf[i] = vtr(vp + (32 * sub + 16 * ss + 8 * jj) * KS + db * 64); } }
        __builtin_amdgcn_sched_barrier(0);
        float mx = fmaxf(fmaxf(s0[0], s0[1]), fmaxf(s1[0], s1[1]));
#pragma unroll
        for (int r = 2; r < 16; r += 2) mx = fmaxf(mx, fmaxf(fmaxf(s0[r], s0[r + 1]), fmaxf(s1[r], s1[r + 1])));
        mx *= C2; mx = fmaxf(mx, xor32(mx));
        const float cand = selected ? mx : -1e30f;
        if (__any(cand > m + 8.f)) {
            const float mn = fmaxf(m, cand), f = __builtin_amdgcn_exp2f(m - mn);
            l *= f; m = mn;
            float fr[16]; bcast_rows(fr, wsf_w, f, r32, hi);
#pragma unroll
            for (int r = 0; r < 16; ++r) { o[0][r] *= fr[r]; o[1][r] *= fr[r]; }
        }
        const float nme = selected ? -m : -1e30f;
        f32x16 p0, p1; float ls0 = 0.f, ls1 = 0.f, ls2 = 0.f, ls3 = 0.f;
#pragma unroll
        for (int r = 0; r < 16; r += 2) { p0[r] = __builtin_amdgcn_exp2f(__builtin_fmaf(s0[r], C2, nme)); ls0 += p0[r]; p0[r + 1] = __builtin_amdgcn_exp2f(__builtin_fmaf(s0[r + 1], C2, nme)); ls1 += p0[r + 1];
            p1[r] = __builtin_amdgcn_exp2f(__builtin_fmaf(s1[r], C2, nme)); ls2 += p1[r]; p1[r + 1] = __builtin_amdgcn_exp2f(__builtin_fmaf(s1[r + 1], C2, nme)); ls3 += p1[r + 1]; }
        l += (ls0 + ls1) + (ls2 + ls3);
#pragma unroll
        for (int i = 0; i < 4; ++i) { const int sub = i >> 1, ss = i & 1; const f32x16& pp = sub ? p1 : p0;
            u32x4 pw; pw.x = pk2(pp[8 * ss + 0], pp[8 * ss + 1]); pw.y = pk2(pp[8 * ss + 2], pp[8 * ss + 3]); pw.z = pk2(pp[8 * ss + 4], pp[8 * ss + 5]); pw.w = pk2(pp[8 * ss + 6], pp[8 * ss + 7]);
            const bf16x8 pa = __builtin_bit_cast(bf16x8, pw);
#pragma unroll
            for (int db = 0; db < 2; ++db) { const s16x4 lo = vf[i * 4 + db * 2], h4 = vf[i * 4 + db * 2 + 1];
                const bf16x8 vb = (bf16x8){lo[0], lo[1], lo[2], lo[3], h4[0], h4[1], h4[2], h4[3]};
                o[db] = MFMA32(pa, vb, o[db]); } }
        return;
    }
#pragma unroll 1
    for (int sub = 0; sub < 2; ++sub) {
        const int kvb = 64 * j + 32 * sub;
        if (kvb > twmax) continue;
        if (MODE == 2 && kvb + 31 + 512 <= twmin) continue;
        if (MODE == 1 && !__any(selected)) continue;
        const f32x16 s = qk_sub(kt, sub, qr, r32, hi);
        const bool need_mask = (kvb + 31 > twmin) || (MODE == 2 && kvb < twmax - 511);
        f32x16 pw; float ls = 0.f;
        if (!need_mask) {
            float mx = fmaxf(fmaxf(s[0], s[1]), fmaxf(s[2], s[3]));
#pragma unroll
            for (int r = 4; r < 16; r += 4) mx = fmaxf(mx, fmaxf(fmaxf(s[r], s[r + 1]), fmaxf(s[r + 2], s[r + 3])));
            mx *= C2; mx = fmaxf(mx, xor32(mx));
            const float cand = selected ? mx : -1e30f;
            if (__any(cand > m + 8.f)) {
                const float mn = fmaxf(m, cand), f = __builtin_amdgcn_exp2f(m - mn);
                l *= f; m = mn;
                float fr[16]; bcast_rows(fr, wsf_w, f, r32, hi);
#pragma unroll
                for (int r = 0; r < 16; ++r) { o[0][r] *= fr[r]; o[1][r] *= fr[r]; }
            }
            const float nme = selected ? -m : -1e30f;
#pragma unroll
            for (int r = 0; r < 16; ++r) { pw[r] = __builtin_amdgcn_exp2f(__builtin_fmaf(s[r], C2, nme)); ls += pw[r]; }
        } else {
            float s2[16]; float mx = -1e30f;
#pragma unroll
            for (int r = 0; r < 16; ++r) { const int kv = kvb + crow(r, hi);
                const bool valid = (kv <= t) && ((MODE == 1) ? selected : (t - kv < 512));
                s2[r] = valid ? s[r] * C2 : -1e30f; mx = fmaxf(mx, s2[r]); }
            mx = fmaxf(mx, xor32(mx));
            if (__any(mx > m + 8.f)) {
                const float mn = fmaxf(m, mx), f = __builtin_amdgcn_exp2f(m - mn);
                l *= f; m = mn;
                float fr[16]; bcast_rows(fr, wsf_w, f, r32, hi);
#pragma unroll
                for (int r = 0; r < 16; ++r) { o[0][r] *= fr[r]; o[1][r] *= fr[r]; }
            }
#pragma unroll
            for (int r = 0; r < 16; ++r) { const float e = __builtin_amdgcn_exp2f(s2[r] - m); pw[r] = (s2[r] > -1e29f) ? e : 0.f; ls += pw[r]; }
        }
        l += ls;
        pv_sub(o, pw, vt, sub, lane);
    }
}
template <int MODE, bool FINAL>
__device__ __forceinline__ void nsa_branch(LAS float* accw, bf16_t* gout, LAS char* lds, const bf16_t* kg, const bf16_t* vg, unsigned todo, const bf16x8 (&qr)[4],
                                           float gate, unsigned selm, int t, int twmin, int twmax, int tid, int lane, int w) {
    const int r32 = lane & 31, hi = lane >> 5, lrow = tid >> 3, lch = tid & 7;
    LAS float* wsf_w = (LAS float*)(lds + L_WSF) + w * 32;
    float m = -1e30f, l = 0.f;
    f32x16 o[2];
#pragma unroll
    for (int i = 0; i < 16; ++i) { o[0][i] = 0.f; o[1][i] = 0.f; }
    const bf16_t* kgl = kg + (size_t)lrow * HW + lch * 8; const bf16_t* vgl = vg + (size_t)lrow * HW + lch * 8;
    LAS char* kw0 = lds + L_K + lrow * KS + lch * 16; LAS char* vw0 = lds + L_V + lrow * KS + lch * 16;
#define NSA_POP(jv) do { jv = (MODE == 1) ? __builtin_ctz(todo) : 31 - __builtin_clz(todo); todo &= ~(1u << jv); } while (0)
#define NSA_LOAD(KR, VR, jv) do { const bf16_t* kp_ = kgl + (size_t)(64 * (jv)) * HW; const bf16_t* vp_ = vgl + (size_t)(64 * (jv)) * HW; \
        asm volatile("global_load_dwordx4 %0, %2, off\n\tglobal_load_dwordx4 %1, %3, off" : "=&v"(KR), "=&v"(VR) : "v"(kp_), "v"(vp_) : "memory"); } while (0)
#define NSA_WAIT(KR, VR) asm volatile("s_waitcnt vmcnt(2)" : "+v"(KR), "+v"(VR) : : "memory")
    u32x4 kA, vA, kB, vB;
    int j0, j1, jl; bool h1;
    NSA_POP(j0); NSA_LOAD(kA, vA, j0); jl = j0;
    h1 = todo != 0u; if (h1) { NSA_POP(j1); jl = j1; } else j1 = jl;
    NSA_LOAD(kB, vB, j1);
    for (;;) {
        NSA_WAIT(kA, vA);
        *(LAS u32x4*)kw0 = kA; *(LAS u32x4*)vw0 = vA;
        __syncthreads();
        int j2; const bool h2 = h1 && todo != 0u; if (h2) { NSA_POP(j2); jl = j2; } else j2 = jl;
        NSA_LOAD(kA, vA, j2);
        nsa_tile<MODE>(m, l, o, lds + L_K, lds + L_V, wsf_w, qr, j0, selm, t, twmin, twmax, lane);
        if (!h1) break;
        NSA_WAIT(kB, vB);
        *(LAS u32x4*)(kw0 + TILEB) = kB; *(LAS u32x4*)(vw0 + TILEB) = vB;
        __syncthreads();
        int j3; const bool h3 = h2 && todo != 0u; if (h3) { NSA_POP(j3); jl = j3; } else j3 = jl;
        NSA_LOAD(kB, vB, j3);
        nsa_tile<MODE>(m, l, o, lds + L_K + TILEB, lds + L_V + TILEB, wsf_w, qr, j1, selm, t, twmin, twmax, lane);
        if (!h2) break;
        j0 = j2; j1 = j3; h1 = h3;
    }
    asm volatile("s_waitcnt vmcnt(0)" : "+v"(kA), "+v"(vA), "+v"(kB), "+v"(vB) : : "memory");
#undef NSA_POP
#undef NSA_LOAD
#undef NSA_WAIT
    __syncthreads();
    l += xor32(l);
    const float fac = (l > 0.f) ? gate / l : 0.f;
    float fr[16]; bcast_rows(fr, wsf_w, fac, r32, hi);
    if (!FINAL) {
#pragma unroll
        for (int r = 0; r < 16; ++r) { const int q = crow(r, hi); accw[q * 64 + r32] += o[0][r] * fr[r]; accw[q * 64 + 32 + r32] += o[1][r] * fr[r]; }
    } else {
#pragma unroll
        for (int r = 0; r < 16; ++r) { const int q = crow(r, hi); bf16_t* gq_ = gout + (size_t)(q & 7) * DM + (q >> 3) * 64;
            gq_[0] = (bf16_t)f2bf(accw[q * 64 + r32] + o[0][r] * fr[r]); gq_[32] = (bf16_t)f2bf(accw[q * 64 + 32 + r32] + o[1][r] * fr[r]); }
    }
    LDSW();
}

__device__ __forceinline__ void nsa_unit(const Params& p, LAS unsigned char* lds8, int b, int g, int qb) {
    LAS char* lds = (LAS char*)lds8;
    const int tid = opaque_tid(), lane = tid & 63, w = __builtin_amdgcn_readfirstlane(tid >> 6), r32 = lane & 31, hi = lane >> 5;
    const int rh = r32 >> 3, tl = 8 * w + (r32 & 7);
    const bf16_t* H1 = (const bf16_t*)(p.ws + WS_H);
    bf16_t* MIX = (bf16_t*)(p.ws + WS_MIX);
    const size_t rowbase = (size_t)b * SEQ;
    const int t0 = 64 * qb, t = t0 + tl, twmin = t0 + 8 * w, twmax = twmin + 7;
    LAS float* wsf_w = (LAS float*)(lds + L_WSF) + w * 32;
    LAS float* impL = (LAS float*)(lds + L_IMP);
    LAS unsigned* selL = (LAS unsigned*)(lds + L_SEL);
    bf16x8 qr[4];
    float g0, g1, g2;
    { const bf16_t* qp = H1 + (rowbase + t) * HW + (g * 4 + rh) * 64;
#pragma unroll
      for (int d0 = 0; d0 < 4; ++d0) qr[d0] = *(const bf16x8*)(qp + 16 * d0 + 8 * hi);
      const bf16_t* gp = H1 + (rowbase + t) * HW + 2304 + (g * 4 + rh) * 3;
      g0 = sigmoidf_(bf2f((unsigned)gp[0])); g1 = sigmoidf_(bf2f((unsigned)gp[1])); g2 = sigmoidf_(bf2f((unsigned)gp[2])); }
    LAS float* accw = (LAS float*)(lds + L_OACC) + w * 2048;
    bf16_t* gout = MIX + (rowbase + t0 + 8 * w) * DM + (g * 4) * 64 + r32;
    {
        const bf16_t* kc = (const bf16_t*)(p.ws + WS_KCMP) + (size_t)(b * 2 + g) * 128 * 64;
        const bf16_t* vc = (const bf16_t*)(p.ws + WS_VCMP) + (size_t)(b * 2 + g) * 128 * 64;
#pragma unroll
        for (int i = 0; i < 2; ++i) { const int idx = tid + 512 * i, row = idx >> 3, ch = idx & 7;
            *(LAS u32x4*)(lds + L_K + row * KS + ch * 16) = *(const u32x4*)(kc + row * 64 + ch * 8);
            *(LAS u32x4*)(lds + L_V + row * KS + ch * 16) = *(const u32x4*)(vc + row * 64 + ch * 8); }
        __syncthreads();
        const int nmax = (t - 31) >> 4;
        const int nmaxw = (twmax - 31) >> 4;
        float m = -1e30f, l = 0.f;
#pragma unroll 1
        for (int sb = 0; sb < 4; ++sb) {
            if (32 * sb > nmaxw) break;
            const f32x16 s = qk_sub(lds + L_K, sb, qr, r32, hi);
            float s2[16]; float mx = m;
#pragma unroll
            for (int r = 0; r < 16; ++r) { const int n = 32 * sb + crow(r, hi); s2[r] = (n <= nmax) ? s[r] * C2 : -1e30f; mx = fmaxf(mx, s2[r]); }
            l *= __builtin_amdgcn_exp2f(m - mx); m = mx;
#pragma unroll
            for (int r = 0; r < 16; ++r) { const float e = __builtin_amdgcn_exp2f(s2[r] - m); l += (s2[r] > -1e29f) ? e : 0.f; }
        }
        { const float mt = fmaxf(m, xor32(m)); l *= __builtin_amdgcn_exp2f(m - mt); m = mt; l += xor32(l); }
        const float inv = (l > 0.f) ? 1.f / l : 0.f;
        f32x16 o[2];
#pragma unroll
        for (int i = 0; i < 16; ++i) { o[0][i] = 0.f; o[1][i] = 0.f; }
        LAS float* ip = impL + ((rh * 64) + tl) * 33 + hi; float lprev = 0.f;
#pragma unroll 1
        for (int sb = 0; sb < 4; ++sb) {
            if (32 * sb > nmaxw) {
#pragma unroll
                for (int gq = 0; gq < 4; ++gq) ip[2 * (4 * sb + gq)] = (hi == 0 && gq == 0) ? lprev : 0.f;
                lprev = 0.f; continue; }
            const f32x16 s = qk_sub(lds + L_K, sb, qr, r32, hi);
            f32x16 pw;
#pragma unroll
            for (int r = 0; r < 16; ++r) { const int n = 32 * sb + crow(r, hi); const float e = __builtin_amdgcn_exp2f(s[r] * C2 - m) * inv; pw[r] = (n <= nmax) ? e : 0.f; }
#pragma unroll
            for (int gq = 0; gq < 4; ++gq) {
                const float Gv = (pw[4 * gq] + pw[4 * gq + 1]) + (pw[4 * gq + 2] + pw[4 * gq + 3]);
                const float lcur = xor32(pw[4 * gq + 3]);
                ip[2 * (4 * sb + gq)] = Gv + (hi ? lcur : lprev); lprev = lcur; }
            pv_sub(o, pw, lds + L_V, sb, lane);
        }
        float fr[16]; bcast_rows(fr, wsf_w, g0, r32, hi);
#pragma unroll
        for (int r = 0; r < 16; ++r) { const int q = crow(r, hi); accw[q * 64 + r32] = o[0][r] * fr[r]; accw[q * 64 + 32 + r32] = o[1][r] * fr[r]; }
    }
    __syncthreads();
#ifndef XTOPK
    { const int tok = tid >> 3, j0 = (tid & 7) * 4;
#pragma unroll
      for (int jj = 0; jj < 4; ++jj) { LAS float* q0 = impL + tok * 33 + j0 + jj; q0[0] = ((q0[0] + q0[64 * 33]) + q0[2 * 64 * 33]) + q0[3 * 64 * 33]; } }
    __syncthreads();
    if (w == 0) {
        float sc[32];
#pragma unroll
        for (int jj = 0; jj < 32; ++jj) { const float v = impL[lane * 33 + jj];
            const bool forced = (jj == 0) || (jj == qb) || (jj == qb - 1);
            sc[jj] = (jj <= qb) ? v + (forced ? 1000.f : 0.f) : -1e30f; }
        unsigned mask = 0u;
        if (qb < 8) mask = (2u << qb) - 1u;
        else {
#pragma unroll 1
            for (int k = 0; k < 8; ++k) { float best = -3e38f; int bj = 0;
#pragma unroll
                for (int jj = 0; jj < 32; ++jj) { const float v = ((mask >> jj) & 1u) ? -3e38f : sc[jj]; if (v > best) { best = v; bj = jj; } }
                mask |= 1u << bj; }
        }
        selL[lane] = mask;
        unsigned un = mask;
#pragma unroll
        for (int o = 1; o < 64; o <<= 1) un |= (unsigned)__shfl_xor((int)un, o);
        if (lane == 0) selL[64] = un;
    }
#endif
    __syncthreads();
    const unsigned selm = selL[tl], uni = selL[64];
#ifndef XSEL
    { const unsigned vmask = (qb >= 31) ? 0xffffffffu : ((2u << qb) - 1u);
      nsa_branch<1, false>(accw, gout, lds, H1 + rowbase * HW + 768 + g * 64, H1 + rowbase * HW + 896 + g * 64, (uni & vmask) | 1u, qr, g1, selm, t, twmin, twmax, tid, lane, w);
#ifdef PROBE_SEL
      nsa_branch<1, false>(accw, gout, lds, H1 + rowbase * HW + 768 + g * 64, H1 + rowbase * HW + 896 + g * 64, (uni & vmask) | 1u, qr, 0.f, selm, t, twmin, twmax, tid, lane, w);
#endif
    }
#endif
#ifndef XWIN
    { const int lo = qb > 8 ? qb - 8 : 0; const unsigned vmask = (qb >= 31) ? 0xffffffffu : ((2u << qb) - 1u); const unsigned todo = vmask & ~((1u << lo) - 1u);
#ifdef PROBE_WIN
      nsa_branch<2, false>(accw, gout, lds, H1 + rowbase * HW + 1024 + g * 64, H1 + rowbase * HW + 1152 + g * 64, todo, qr, 0.f, 0u, t, twmin, twmax, tid, lane, w);
#endif
      nsa_branch<2, true>(accw, gout, lds, H1 + rowbase * HW + 1024 + g * 64, H1 + rowbase * HW + 1152 + g * 64, todo, qr, g2, 0u, t, twmin, twmax, tid, lane, w); }
#endif
}

__global__ void __launch_bounds__(512, 2) fwd_megakernel(Params p) {
    extern __shared__ __attribute__((aligned(16))) unsigned char lds_raw[];
    LAS unsigned char* lds = (LAS unsigned char*)lds_raw;
    cg::grid_group grid = cg::this_grid();
    unsigned char* ws = p.ws;
    bf16_t* XB = (bf16_t*)(ws + WS_XB); bf16_t* HB = (bf16_t*)(ws + WS_H); bf16_t* MIX = (bf16_t*)(ws + WS_MIX); bf16_t* MB = (bf16_t*)(ws + WS_MB);
    const int G = gridDim.x, bx = blockIdx.x;
    const int vcu = (G % 8 == 0) ? (bx % 8) * (G / 8) + bx / 8 : bx;
    LAS unsigned* misc = (LAS unsigned*)(lds + LDS_BYTES - 64);
    if (threadIdx.x < 16) misc[threadIdx.x] = 0u;
    __syncthreads();
    XcdBarrier bar = xcd_barrier_post((unsigned*)(ws + WS_CTL), (volatile LAS unsigned*)misc);
    if (G == 0x7fffffff) grid.sync();
#define GSYNC() do { for (int rep_ = 0; rep_ < REP_SYNC; ++rep_) xcd_barrier(bar); } while (0)
#define LSYNC() do { if (loc_ok) xcd_barrier_local(bar); else xcd_barrier(bar); } while (0)
#define QSYNC() do { if (loc_ok) quad_barrier(bar, (unsigned)((bx & 7) * 8 + ((bx >> 3) & 7))); else xcd_barrier(bar); } while (0)
    unsigned* xcctab = (unsigned*)(ws + WS_CTL) + 16384; unsigned* xccflag = (unsigned*)(ws + WS_CTL) + 20480;
    if (threadIdx.x == 0) __hip_atomic_store(&xcctab[bx], bar.x + 1u, __ATOMIC_RELAXED, __HIP_MEMORY_SCOPE_AGENT);

    for (int rep = 0; rep < REP_PRO; ++rep) p0_prologue(p, lds);
    GSYNC();
    int bad_ = (G != 256) ? 1 : 0;
    if (G == 256 && threadIdx.x < 256) { const unsigned a_ = xb_ld(&xcctab[threadIdx.x]), r_ = xb_ld(&xcctab[threadIdx.x & 7]); bad_ = (a_ != r_ || a_ == 0u) ? 1 : 0; }
    const bool loc_ok = (__syncthreads_or(bad_) == 0);
    for (int rep = 0; rep < REP_IN; ++rep) run_gemm(lds, XB, (const bf16_t*)(ws + WS_IN0), 2560, 1024, EpiStore{HB, HW});
    LSYNC();
    for (int rep = 0; rep < REP_SB; ++rep)
    for (int u = vcu; u < 1024; u += G) { const int i = u >> 8, c = u & 255, bhp = c >> 2, s = c & 3;
        const int qb = (i == 0) ? s : (i == 1) ? 7 - s : (i == 2) ? 8 + s : 15 - s;
        sb_unit(p, lds, bhp >> 2, bhp & 3, qb); }
    for (int rep = 0; rep < REP_CONV; ++rep)
    if (G == 256) { for (int i = 0; i < 4; ++i) { const int lu = (vcu & 31) + 32 * i; conv_unit(p, lds, 2 * (vcu >> 5) + (lu >> 6), lu & 63); } }
    else for (int u = bx; u < 1024; u += G) conv_unit(p, lds, u >> 6, u & 63);
    LSYNC();
    run_gemm(lds, MIX, (const bf16_t*)(ws + WS_OUT0), 1024, 1024, EpiStore{MB, DM});
    QSYNC();
    for (int rep = 0; rep < REP_LN; ++rep) ln_phase<true, false>(p.in[0], XB, MB, p.in[22], p.in[23], p.out, XB);
    QSYNC();
    for (int rep = 0; rep < REP_GU; ++rep) run_gemm(lds, XB, (const bf16_t*)(ws + WS_GU0), 2 * FF, 1024, EpiSwiglu{HB, FF});
    QSYNC();
    for (int rep = 0; rep < REP_DN; ++rep) run_gemm(lds, HB, (const bf16_t*)(ws + WS_DN0), 1024, FF, EpiStore{MB, DM});
    QSYNC();
    ln_phase<false, false>(p.in[0], XB, MB, p.in[24], p.in[25], p.out, XB);
    QSYNC();
    run_gemm(lds, XB, (const bf16_t*)(ws + WS_IN1), 2560, 1024, EpiStore{HB, HW});
    LSYNC();
    for (int u = vcu; u < 256; u += G) compress_unit(p, lds, u >> 4, (u >> 3) & 1, (u >> 2) & 1, u & 3);
    if (loc_ok && G == 256) octet_barrier(bar, (unsigned)(vcu >> 3)); else xcd_barrier(bar);
    for (int u = vcu; u < 1024; u += G) { const int i = u >> 8, c = u & 255, bg = c >> 3, s = c & 7;
        const int qb = (i == 0) ? s : (i == 1) ? 15 - s : (i == 2) ? 16 + s : 31 - s;
        nsa_unit(p, lds, bg >> 1, bg & 1, qb); }
    for (int u = vcu; u < 256; u += G) gmlp_unit(p, lds, u >> 4, u & 15);
    LSYNC();
    run_gemm(lds, MIX, (const bf16_t*)(ws + WS_OUT1), 1024, 1024, EpiStore{MB, DM});
    QSYNC();
    ln_phase<false, false>(p.in[0], XB, MB, p.in[22] + DM, p.in[23] + DM, p.out, XB);
    QSYNC();
    run_gemm(lds, XB, (const bf16_t*)(ws + WS_GU1), 2 * FF, 1024, EpiSwiglu{HB, FF});
    QSYNC();
    run_gemm(lds, HB, (const bf16_t*)(ws + WS_DN1), 1024, FF, EpiStore{MB, DM});
    QSYNC();
    ln_phase<false, true>(p.in[0], XB, MB, p.in[24] + DM, p.in[25] + DM, p.out, XB);
}

extern "C" void kernel_launch(void* const* d_in, const int* in_sizes, int n_in, void* d_out, int out_size, void* d_ws, size_t ws_size, hipStream_t stream) {
    static int grid = 0;
    if (grid == 0) {
        if (n_in != 26 || out_size != MTOK * DM || ws_size < WS_END) { fprintf(stderr, "kernel_launch: unexpected problem shape (n_in %d, out %d, ws %zu)\n", n_in, out_size, ws_size); grid = -1; return; }
        int dev = 0, cus = 0, per_cu = 0;
        hipGetDevice(&dev); hipDeviceGetAttribute(&cus, hipDeviceAttributeMultiprocessorCount, dev);
        hipFuncSetAttribute((const void*)fwd_megakernel, hipFuncAttributeMaxDynamicSharedMemorySize, LDS_BYTES);
        hipOccupancyMaxActiveBlocksPerMultiprocessor(&per_cu, (const void*)fwd_megakernel, 512, LDS_BYTES);
        (void)hipGetLastError();
        if (per_cu < 1) { fprintf(stderr, "kernel_launch: occupancy query says %d blocks per CU\n", per_cu); per_cu = 1; }
        grid = cus;
    }
    if (grid < 0) return;
    if (hipMemsetAsync((char*)d_ws + WS_CTL, 0, CTL_BYTES, stream) != hipSuccess) { fprintf(stderr, "kernel_launch: memset failed\n"); return; }
    Params prm{};
    for (int i = 0; i < 26; ++i) prm.in[i] = (const float*)d_in[i];
    prm.out = (float*)d_out; prm.ws = (unsigned char*)d_ws;
    void* args[] = {&prm};
    hipError_t e = hipLaunchCooperativeKernel((const void*)fwd_megakernel, dim3(grid), dim3(512), args, LDS_BYTES, stream);
    if (e != hipSuccess) fprintf(stderr, "cooperative launch failed: %s (grid %d)\n", hipGetErrorString(e), grid);
}
```

```cpp
#include <hip/hip_runtime.h>
#include <hip/hip_cooperative_groups.h>
#include <cstdio>
#include <cstdint>
namespace cg = cooperative_groups;
#define LAS __attribute__((address_space(3)))
namespace pg8 {
#define PG8_LAS __attribute__((address_space(3)))
typedef unsigned short bf16_t;
typedef short bf16x8 __attribute__((ext_vector_type(8)));
typedef float f32x4 __attribute__((ext_vector_type(4)));
typedef unsigned u32x4 __attribute__((ext_vector_type(4)));
constexpr int BM = 256, BK = 64, HALF = 128, HTB = HALF * BK * 2  , STAGE_BYTES = 8 * HTB, NXCD = 8, WGM = 8;

__host__ __device__ __forceinline__ int lds_byte(int r, int c) { const int st = (r >> 4) * 2 + (c >> 5), rr = r & 15, cc = c & 31, ob = rr * 64 + cc * 2; return st * 1024 + (ob ^ (((ob >> 9) & 1) << 5)); }
__host__ __device__ __forceinline__ void stage_rc(int b, int& R, int& C) { const int st = b / 1024, sb = b % 1024, swz = sb ^ (((sb >> 9) & 1) << 5); R = (st >> 1) * 16 + swz / 64; C = (st & 1) * 32 + (swz % 64) / 2; }
__host__ __device__ __forceinline__ int perm32(int rho) { const int n = rho >> 4, i = rho & 15; return 8 * (i >> 2) + 4 * n + (i & 3); }

struct Unit { int pm, pn; };
struct Gemm { const bf16_t* A; const bf16_t* Bt; int M, N, K; };

struct StaticOrder {
    int nM, nN, nwg, G, c;
    __host__ __device__ void init(int M, int N, int G_, int c_) { nM = M / BM; nN = N / BM; nwg = nM * nN; G = G_; c = c_; }
    __host__ __device__ bool next(int i, Unit& u) const {
        const long L = (long)i * G + c; if (L >= nwg) return false;
        int wgid = (int)L; { const int q = nwg / NXCD, r = nwg % NXCD, xcd = wgid % NXCD, off = wgid / NXCD; wgid = (xcd < r ? xcd * (q + 1) : r * (q + 1) + (xcd - r) * q) + off; }
        const int nig = WGM * nN, gid = wgid / nig, fm = gid * WGM, gsz = (nM - fm) < WGM ? (nM - fm) : WGM;
        u.pm = fm + ((wgid % nig) % gsz); u.pn = (wgid % nig) / gsz; return true;
    }
    __device__ __forceinline__ void a_ready(const Unit&) const {}
    __device__ __forceinline__ void done(const Unit&) const {}
};

__device__ __forceinline__ unsigned cvt_pk_bf16(float lo, float hi) { unsigned r; asm volatile("v_cvt_pk_bf16_f32 %0, %1, %2" : "=v"(r) : "v"(lo), "v"(hi)); return r; }
typedef float f32x2 __attribute__((ext_vector_type(2)));
__device__ __forceinline__ f32x2 gelu_pk(f32x2 v) {
    const f32x2 av = __builtin_elementwise_abs(v), d = av * 0.2316418882f + 1.0f;
    f32x2 t; t.x = __builtin_amdgcn_rcpf(d.x); t.y = __builtin_amdgcn_rcpf(d.y);
    f32x2 q = t * 0.5307027145f + (-0.7265760135f); q = q * t + 0.7107068705f; q = q * t + (-0.142248368f); q = q * t + 0.127414796f; q = q * t;
    const f32x2 s = (v * v) * (-0.72134752044f);
    f32x2 e; e.x = __builtin_amdgcn_exp2f(s.x); e.y = __builtin_amdgcn_exp2f(s.y);
    const f32x2 m = v * (q * e), r = v - m;
    f32x2 o; o.x = v.x < 0.f ? m.x : r.x; o.y = v.y < 0.f ? m.y : r.y; return o;
}

template <int ACT  > struct EpiBf16 {
    static constexpr bool PERM = true, AFTER_DRAIN = false; static_assert(ACT == 0 || ACT == 1, "EpiBf16: ACT is 0 (none) or 1 (gelu_pk)");
    bf16_t* O; int ldc; const float* bias; int split_cols; size_t split_stride; float scale0;
    __device__ __forceinline__ void operator()(const f32x4 (&acc)[2][2][4][2], const Unit& u, int wr, int wc, int fr, int fq) const {
        const int row0 = u.pm * BM + wr * 64 + fr; int colt = u.pn * BM; bf16_t* base = O;
        float sc = 1.f; if (split_cols) { const int t = colt / split_cols; base += (size_t)t * split_stride; colt -= t * split_cols; if (t == 0) sc = scale0; }
        const int col0 = colt + wc * 32 + 8 * fq, bcol0 = u.pn * BM + wc * 32 + 8 * fq;
        f32x4 bv[2][2];
#pragma unroll
        for (int bj = 0; bj < 2; ++bj)
#pragma unroll
            for (int n = 0; n < 2; ++n) bv[bj][n] = bias ? *(const f32x4*)(bias + bcol0 + bj * HALF + 4 * n) : (f32x4){0.f, 0.f, 0.f, 0.f};
#pragma unroll
        for (int ai = 0; ai < 2; ++ai)
#pragma unroll
            for (int m = 0; m < 4; ++m) { bf16_t* rowp = base + (size_t)(row0 + ai * HALF + m * 16) * ldc + col0;
#pragma unroll
                for (int bj = 0; bj < 2; ++bj) { f32x4 v0 = acc[ai][bj][m][0] + bv[bj][0], v1 = acc[ai][bj][m][1] + bv[bj][1];
                    if (ACT == 1) { f32x2 a = gelu_pk((f32x2){v0[0], v0[1]}), b = gelu_pk((f32x2){v0[2], v0[3]}), c = gelu_pk((f32x2){v1[0], v1[1]}), d = gelu_pk((f32x2){v1[2], v1[3]});
                        v0 = (f32x4){a.x, a.y, b.x, b.y}; v1 = (f32x4){c.x, c.y, d.x, d.y}; }
                    v0 = v0 * sc; v1 = v1 * sc; u32x4 w; w.x = cvt_pk_bf16(v0[0], v0[1]); w.y = cvt_pk_bf16(v0[2], v0[3]); w.z = cvt_pk_bf16(v1[0], v1[1]); w.w = cvt_pk_bf16(v1[2], v1[3]);
                    *(u32x4*)(rowp + bj * HALF) = w; } }
    }
};

struct PanelStats {
    unsigned* xbuf;
    unsigned* cnt;
    unsigned* tmo;
    int ntn; float eps;
    unsigned code;
    __device__ __forceinline__ bool run(const f32x4 (&v)[2][2][4][2], const Unit& u, int wr, int wc, int fr, int fq, PG8_LAS unsigned char* lds, int wid, int lane) const {
        typedef float f32x2v __attribute__((ext_vector_type(2)));
        PG8_LAS f32x2v* P = (PG8_LAS f32x2v*)lds;
        PG8_LAS f32x2v* S = (PG8_LAS f32x2v*)(lds + 8192);
        PG8_LAS unsigned* flag = (PG8_LAS unsigned*)(lds + 8192 + 2048);
#pragma unroll
        for (int ai = 0; ai < 2; ++ai)
#pragma unroll
            for (int m = 0; m < 4; ++m) {
                float s = 0.f;
#pragma unroll
                for (int bj = 0; bj < 2; ++bj)
#pragma unroll
                    for (int n = 0; n < 2; ++n) { const f32x4 x = v[ai][bj][m][n]; s += (x[0] + x[1]) + (x[2] + x[3]); }
                s += __shfl_xor(s, 16); s += __shfl_xor(s, 32);
                const float mw = s * (1.0f / 64.0f); float q = 0.f;
#pragma unroll
                for (int bj = 0; bj < 2; ++bj)
#pragma unroll
                    for (int n = 0; n < 2; ++n) { const f32x4 d = v[ai][bj][m][n] - mw; q += (d[0] * d[0] + d[1] * d[1]) + (d[2] * d[2] + d[3] * d[3]); }
                q += __shfl_xor(q, 16); q += __shfl_xor(q, 32);
                if (fq == 0) P[(ai * HALF + wr * 64 + m * 16 + fr) * 4 + wc] = (f32x2v){mw, q};
            }
        asm volatile("s_waitcnt lgkmcnt(0)" ::: "memory"); __builtin_amdgcn_s_barrier(); asm volatile("" ::: "memory");
#if defined(BROKEN_EXCHANGE_NO_WAIT)
#warning BROKEN CONTROL BUILD: the row-statistics exchange does not wait; results are wrong by design
        if (blockIdx.x >= 64) { const long long t0_ = clock64(); while (clock64() - t0_ < 60000) __builtin_amdgcn_s_sleep(8); }
#endif
        const int row = wid * 32 + (lane & 31);
        if (lane < 32) {
            const f32x2v a = P[row * 4 + 0], b = P[row * 4 + 1], c = P[row * 4 + 2], d = P[row * 4 + 3];
            const float mt = (a.x + b.x + c.x + d.x) * 0.25f;
            const float da = a.x - mt, db = b.x - mt, dc = c.x - mt, dd = d.x - mt;
            const float m2 = (a.y + b.y) + (c.y + d.y) + 64.0f * ((da * da + db * db) + (dc * dc + dd * dd));
            unsigned long long* slot = (unsigned long long*)xbuf + ((size_t)(u.pm * BM + row) * 4 + u.pn);
            __hip_atomic_store(slot, ((unsigned long long)__float_as_uint(m2) << 32) | __float_as_uint(mt), __ATOMIC_RELAXED, __HIP_MEMORY_SCOPE_AGENT);
        }
        asm volatile("s_waitcnt vmcnt(0)" ::: "memory");
        if (lane == 0) __hip_atomic_fetch_add(cnt + 64 * u.pm, 1u, __ATOMIC_RELAXED, __HIP_MEMORY_SCOPE_AGENT);
        if (wid == 0) {
            bool dead = false; const unsigned long long t0 = __builtin_amdgcn_s_memrealtime(); const unsigned want = 8u * (unsigned)ntn;
            for (;;) {
#if defined(BROKEN_EXCHANGE_NO_WAIT)
                break;
#endif
                if ((unsigned)__builtin_amdgcn_readfirstlane(__hip_atomic_load(cnt + 64 * u.pm, __ATOMIC_RELAXED, __HIP_MEMORY_SCOPE_AGENT)) >= want) break;
                if (__builtin_amdgcn_s_memrealtime() - t0 > 2000000ull) {
                    if (lane == 0) { unsigned expect = 0u; __hip_atomic_compare_exchange_strong(tmo + 1, &expect, code | (unsigned)(u.pm & 0xff), __ATOMIC_RELAXED, __ATOMIC_RELAXED, __HIP_MEMORY_SCOPE_AGENT);
                                     __hip_atomic_store(tmo, 1u, __ATOMIC_RELAXED, __HIP_MEMORY_SCOPE_AGENT); }
                    dead = true; break; }
                __builtin_amdgcn_s_sleep(2);
            }
            __builtin_amdgcn_fence(__ATOMIC_ACQUIRE, "agent");
            if (lane == 0) flag[0] = dead ? 1u : 0u;
        }
        asm volatile("s_waitcnt vmcnt(0) lgkmcnt(0)" ::: "memory"); __builtin_amdgcn_s_barrier(); asm volatile("" ::: "memory");
        const bool bad = flag[0] != 0u;
        if (lane < 32) {
            const unsigned long long* slot = (const unsigned long long*)xbuf + (size_t)(u.pm * BM + row) * 4; float mt[4], m2[4]; float ms = 0.f;
#pragma unroll
            for (int t = 0; t < 4; ++t) { if (t < ntn) { const unsigned long long w = __hip_atomic_load(slot + t, __ATOMIC_RELAXED, __HIP_MEMORY_SCOPE_AGENT); mt[t] = __uint_as_float((unsigned)w); m2[t] = __uint_as_float((unsigned)(w >> 32)); } else { mt[t] = 0.f; m2[t] = 0.f; } ms += mt[t]; }
            const float mean = ms / (float)ntn; float q = 0.f;
#pragma unroll
            for (int t = 0; t < 4; ++t) if (t < ntn) { const float dm = mt[t] - mean; q += m2[t] + 256.0f * dm * dm; }
            S[row] = (f32x2v){mean, 1.0f / sqrtf(q / (256.0f * (float)ntn) + eps)};
        }
        asm volatile("s_waitcnt lgkmcnt(0)" ::: "memory"); __builtin_amdgcn_s_barrier(); asm volatile("" ::: "memory");
        return bad;
    }
};
struct EpiLnRes {
    static constexpr bool PERM = false, AFTER_DRAIN = true;
    const float* base; float* out; int ldc; const float* bias; PanelStats st; unsigned poison;
    __device__ __forceinline__ void fused(f32x4 (&acc)[2][2][4][2], const Unit& u, int wr, int wc, int fr, int fq, PG8_LAS unsigned char* lds, int wid, int lane) const {
        typedef float f32x2v __attribute__((ext_vector_type(2)));
        const PG8_LAS f32x2v* S = (const PG8_LAS f32x2v*)(lds + 8192);
        const int col0 = u.pn * BM + wc * 32 + 4 * fq;
#pragma unroll
        for (int bj = 0; bj < 2; ++bj)
#pragma unroll
            for (int n = 0; n < 2; ++n) { const f32x4 bv = bias ? *(const f32x4*)(bias + col0 + bj * HALF + n * 16) : (f32x4){0.f, 0.f, 0.f, 0.f};
#pragma unroll
                for (int ai = 0; ai < 2; ++ai)
#pragma unroll
                    for (int m = 0; m < 4; ++m) acc[ai][bj][m][n] += bv; }
        f32x4 pre[4][2][2];
#pragma unroll
        for (int m = 0; m < 4; ++m) { const size_t off = (size_t)(u.pm * BM + wr * 64 + m * 16 + fr) * ldc + col0;
#pragma unroll
            for (int bj = 0; bj < 2; ++bj)
#pragma unroll
                for (int n = 0; n < 2; ++n) pre[m][bj][n] = *(const f32x4*)(base + off + bj * HALF + n * 16); }
        const bool bad = st.run(acc, u, wr, wc, fr, fq, lds, wid, lane) || poison != 0u;
        const float qnan = __builtin_nanf("");
#pragma unroll
        for (int ai = 0; ai < 2; ++ai)
#pragma unroll
            for (int m = 0; m < 4; ++m) { const int r = ai * HALF + wr * 64 + m * 16 + fr; const f32x2v sr = S[r]; const size_t off = (size_t)(u.pm * BM + r) * ldc + col0;
#pragma unroll
                for (int bj = 0; bj < 2; ++bj)
#pragma unroll
                    for (int n = 0; n < 2; ++n) { const f32x4 bs = ai == 0 ? pre[m][bj][n] : *(const f32x4*)(base + off + bj * HALF + n * 16); f32x4 o = bs + (acc[ai][bj][m][n] - sr.x) * sr.y;
                        if (bad) o = (f32x4){qnan, qnan, qnan, qnan}; *(f32x4*)(out + off + bj * HALF + n * 16) = o; }
                if (m & 1) asm volatile("" ::: "memory"); }
    }
};
struct EpiLnResLn {
    static constexpr bool PERM = false, AFTER_DRAIN = true;
    const float* base; float* out; bf16_t* xn; int ldc; const float* bias; PanelStats st1, st2; unsigned poison;
    __device__ __forceinline__ void fused(f32x4 (&acc)[2][2][4][2], const Unit& u, int wr, int wc, int fr, int fq, PG8_LAS unsigned char* lds, int wid, int lane) const {
        typedef float f32x2v __attribute__((ext_vector_type(2))); typedef unsigned u32x2v __attribute__((ext_vector_type(2)));
        const PG8_LAS f32x2v* S = (const PG8_LAS f32x2v*)(lds + 8192);
        const int col0 = u.pn * BM + wc * 32 + 4 * fq;
#pragma unroll
        for (int bj = 0; bj < 2; ++bj)
#pragma unroll
            for (int n = 0; n < 2; ++n) { const f32x4 bv = bias ? *(const f32x4*)(bias + col0 + bj * HALF + n * 16) : (f32x4){0.f, 0.f, 0.f, 0.f};
#pragma unroll
                for (int ai = 0; ai < 2; ++ai)
#pragma unroll
                    for (int m = 0; m < 4; ++m) acc[ai][bj][m][n] += bv; }
        bool bad = st1.run(acc, u, wr, wc, fr, fq, lds, wid, lane) || poison != 0u;
        const float qnan = __builtin_nanf("");
#pragma unroll
        for (int ai = 0; ai < 2; ++ai)
#pragma unroll
            for (int m = 0; m < 4; ++m) { const int r = ai * HALF + wr * 64 + m * 16 + fr; const f32x2v sr = S[r]; const size_t off = (size_t)(u.pm * BM + r) * ldc + col0;
#pragma unroll
                for (int bj = 0; bj < 2; ++bj)
#pragma unroll
                    for (int n = 0; n < 2; ++n) { const f32x4 bs = *(const f32x4*)(base + off + bj * HALF + n * 16); acc[ai][bj][m][n] = bs + (acc[ai][bj][m][n] - sr.x) * sr.y; }
                asm volatile("" : "+v"(acc[ai][0][m][0]), "+v"(acc[ai][0][m][1]), "+v"(acc[ai][1][m][0]), "+v"(acc[ai][1][m][1]));
                if (m & 1) asm volatile("" ::: "memory"); }
        const bool bad1 = bad;
        bad = st2.run(acc, u, wr, wc, fr, fq, lds, wid, lane) || bad;
#pragma unroll
        for (int ai = 0; ai < 2; ++ai)
#pragma unroll
            for (int m = 0; m < 4; ++m) { const int r = ai * HALF + wr * 64 + m * 16 + fr; const f32x2v sr = S[r]; const size_t off = (size_t)(u.pm * BM + r) * ldc + col0;
#pragma unroll
                for (int bj = 0; bj < 2; ++bj)
#pragma unroll
                    for (int n = 0; n < 2; ++n) { const f32x4 x1 = acc[ai][bj][m][n]; *(f32x4*)(out + off + bj * HALF + n * 16) = bad1 ? (f32x4){qnan, qnan, qnan, qnan} : x1;
                        const f32x4 o = (x1 - sr.x) * sr.y; u32x2v w; w.x = cvt_pk_bf16(o[0], o[1]); w.y = cvt_pk_bf16(o[2], o[3]);
                        if (bad) { w.x = 0x7fc07fc0u; w.y = 0x7fc07fc0u; } *(u32x2v*)(xn + off + bj * HALF + n * 16) = w; }
                asm volatile("" ::: "memory"); }
    }
};

template <class Epi, class Sched, bool ALIGN_EPI = false, bool SP2 = false>
__device__ __forceinline__ void gemm_phase(PG8_LAS unsigned char* lds, const Gemm g, const Sched& S, const Epi& E) {
    int tid_ = threadIdx.x; asm volatile("" : "+v"(tid_)); const int tid = tid_, wid = __builtin_amdgcn_readfirstlane(tid >> 6), lane = tid & 63, wr = wid >> 2, wc = wid & 3, fr = lane & 15, fq = lane >> 4;
    const int K = g.K, nt = K / BK;
    unsigned voffA[2], voffB[2];
#pragma unroll
    for (int i = 0; i < 2; ++i) { int R, C; stage_rc(tid * 16 + i * 8192, R, C); const int Rb = Epi::PERM ? ((R & ~31) + perm32(R & 31)) : R;
        voffA[i] = (unsigned)(R * K + C) * 2u; voffB[i] = (unsigned)(Rb * K + C) * 2u; }
    const size_t kstep = (size_t)(BK * 2);
    const size_t hstep = (size_t)HALF * K * 2;
    const size_t tstep = 2 * hstep;
    const unsigned ldsw = (unsigned)wid * 1024u;
    const int aoff = lds_byte(wr * 64 + fr, fq * 8), boff = lds_byte(wc * 32 + fr, fq * 8);
#define PG8_SA(b, h) (((b) * 2 + (h)) * HTB)
#define PG8_SB(b, h) ((4 + (b) * 2 + (h)) * HTB)
#define PG8_STAGE(bufoff, gbase, voff) do { _Pragma("unroll") for (int _i = 0; _i < 2; ++_i) \
        __builtin_amdgcn_global_load_lds((const unsigned*)((const char*)(gbase) + (voff)[_i]), (PG8_LAS unsigned*)(lds + (bufoff) + ldsw + _i * 8192), 16, 0, 0); } while (0)
#define PG8_LDA(dst, b, h) do { _Pragma("unroll") for (int m = 0; m < 4; ++m) _Pragma("unroll") for (int k = 0; k < 2; ++k) dst[m][k] = *(const PG8_LAS bf16x8*)(lds + PG8_SA(b, h) + aoff + m * 2048 + k * 1024); } while (0)
#define PG8_LDB(dst, b, h) do { _Pragma("unroll") for (int n = 0; n < 2; ++n) _Pragma("unroll") for (int k = 0; k < 2; ++k) dst[n][k] = *(const PG8_LAS bf16x8*)(lds + PG8_SB(b, h) + boff + n * 2048 + k * 1024); } while (0)
#define PG8_MMA(ai, bj, At, Bt) do { __builtin_amdgcn_s_setprio(1); _Pragma("unroll") for (int m = 0; m < 4; ++m) _Pragma("unroll") for (int n = 0; n < 2; ++n) _Pragma("unroll") for (int k = 0; k < 2; ++k) \
        acc[ai][bj][m][n] = __builtin_amdgcn_mfma_f32_16x16x32_bf16(Bt[n][k], At[m][k], acc[ai][bj][m][n], 0, 0, 0); __builtin_amdgcn_s_setprio(0); } while (0)
#define PG8_WAIT_V(n) asm volatile("s_waitcnt vmcnt(" #n ")" ::: "memory")
#define PG8_WAIT_L(n) asm volatile("s_waitcnt lgkmcnt(" #n ")" ::: "memory")
#define PG8_BAR __builtin_amdgcn_s_barrier()
#define PG8_SCHED __builtin_amdgcn_sched_barrier(0)
    Unit cur, nxt; int ui = 0;
    if (!S.next(0, cur)) return;
    f32x4 acc[2][2][4][2];
#pragma unroll
    for (int a = 0; a < 2; ++a)
#pragma unroll
        for (int b = 0; b < 2; ++b)
#pragma unroll
            for (int m = 0; m < 4; ++m)
#pragma unroll
                for (int n = 0; n < 2; ++n) acc[a][b][m][n] = (f32x4){0.f, 0.f, 0.f, 0.f};
    bf16x8 At[4][2], B0[2][2], B1[2][2];
    const char* cA = (const char*)g.A + (size_t)cur.pm * tstep; const char* cB = (const char*)g.Bt + (size_t)cur.pn * tstep;
    S.a_ready(cur);
    if constexpr (SP2) {
        PG8_STAGE(PG8_SB(0, 0), cB, voffB); PG8_STAGE(PG8_SB(0, 1), cB + hstep, voffB); PG8_STAGE(PG8_SA(0, 0), cA, voffA); PG8_STAGE(PG8_SA(0, 1), cA + hstep, voffA);
        if (wr == 1) PG8_BAR;
        PG8_WAIT_V(2); PG8_BAR;
        PG8_STAGE(PG8_SB(1, 0), cB + kstep, voffB); PG8_STAGE(PG8_SA(1, 0), cA + kstep, voffA); PG8_STAGE(PG8_SB(1, 1), cB + hstep + kstep, voffB);
        PG8_WAIT_V(6); PG8_BAR;
    } else {
        PG8_STAGE(PG8_SB(0, 0), cB, voffB); PG8_STAGE(PG8_SA(0, 0), cA, voffA); PG8_STAGE(PG8_SB(0, 1), cB + hstep, voffB); PG8_STAGE(PG8_SA(0, 1), cA + hstep, voffA);
        if (wr == 1) PG8_BAR;
        PG8_WAIT_V(4); PG8_BAR;
        PG8_STAGE(PG8_SB(1, 0), cB + kstep, voffB); PG8_STAGE(PG8_SA(1, 0), cA + kstep, voffA); PG8_STAGE(PG8_SB(1, 1), cB + hstep + kstep, voffB);
        PG8_WAIT_V(6); PG8_BAR;
    }
    for (;;) {
        const bool has_next = S.next(ui + 1, nxt);
        const char* nA = has_next ? (const char*)g.A + (size_t)nxt.pm * tstep : cA; const char* nB = has_next ? (const char*)g.Bt + (size_t)nxt.pn * tstep : cB;
        for (int t = 0; t < nt; t += 2) {
            const bool last = (t == nt - 2);
            const char* a1 = cA + (size_t)(t + 1) * kstep;
            const char* a2 = last ? nA : cA + (size_t)(t + 2) * kstep; const char* b2 = last ? nB : cB + (size_t)(t + 2) * kstep;
            const char* a3 = a2 + kstep; const char* b3 = b2 + kstep;
            if (last && has_next) S.a_ready(nxt);
            if constexpr (SP2) {
            PG8_LDB(B0, 0, 0); PG8_LDB(B1, 0, 1); PG8_SCHED; PG8_LDA(At, 0, 0); PG8_STAGE(PG8_SA(1, 1), a1 + hstep, voffA);
            PG8_WAIT_V(8); PG8_WAIT_L(0); PG8_BAR; PG8_MMA(0, 0, At, B0); PG8_MMA(0, 1, At, B1); PG8_BAR; PG8_SCHED;
            PG8_LDA(At, 0, 1); PG8_STAGE(PG8_SB(0, 0), b2, voffB); PG8_STAGE(PG8_SB(0, 1), b2 + hstep, voffB); PG8_STAGE(PG8_SA(0, 0), a2, voffA);
            PG8_WAIT_V(8); PG8_WAIT_L(0); PG8_BAR; PG8_MMA(1, 0, At, B0); PG8_MMA(1, 1, At, B1); PG8_BAR; PG8_SCHED;
            PG8_LDB(B0, 1, 0); PG8_LDB(B1, 1, 1); PG8_SCHED; PG8_LDA(At, 1, 0); PG8_STAGE(PG8_SA(0, 1), a2 + hstep, voffA);
            PG8_WAIT_V(8); PG8_WAIT_L(0); PG8_BAR; PG8_MMA(0, 0, At, B0); PG8_MMA(0, 1, At, B1); PG8_BAR; PG8_SCHED;
            PG8_LDA(At, 1, 1); PG8_STAGE(PG8_SB(1, 0), b3, voffB); PG8_STAGE(PG8_SB(1, 1), b3 + hstep, voffB); PG8_STAGE(PG8_SA(1, 0), a3, voffA);
            PG8_WAIT_V(8); PG8_WAIT_L(0); PG8_BAR; PG8_MMA(1, 0, At, B0); PG8_MMA(1, 1, At, B1); PG8_BAR; PG8_SCHED;
            } else {
            PG8_LDB(B0, 0, 0); PG8_SCHED; PG8_LDA(At, 0, 0); PG8_STAGE(PG8_SA(1, 1), a1 + hstep, voffA);
            PG8_WAIT_L(8); PG8_BAR; PG8_WAIT_L(0); PG8_MMA(0, 0, At, B0); PG8_BAR; PG8_SCHED;
            PG8_LDB(B1, 0, 1); PG8_STAGE(PG8_SB(0, 0), b2, voffB);
            PG8_BAR; PG8_WAIT_L(0); PG8_MMA(0, 1, At, B1); PG8_BAR;
            PG8_LDA(At, 0, 1); PG8_STAGE(PG8_SA(0, 0), a2, voffA);
            PG8_BAR; PG8_WAIT_L(0); PG8_MMA(1, 0, At, B0); PG8_BAR; PG8_SCHED;
            PG8_STAGE(PG8_SB(0, 1), b2 + hstep, voffB);
            PG8_WAIT_V(6); PG8_BAR; PG8_MMA(1, 1, At, B1); PG8_BAR;
            PG8_LDB(B0, 1, 0); PG8_SCHED; PG8_LDA(At, 1, 0); PG8_STAGE(PG8_SA(0, 1), a2 + hstep, voffA);
            PG8_WAIT_L(8); PG8_BAR; PG8_WAIT_L(0); PG8_MMA(0, 0, At, B0); PG8_BAR; PG8_SCHED;
            PG8_LDB(B1, 1, 1); PG8_STAGE(PG8_SB(1, 0), b3, voffB);
            PG8_BAR; PG8_WAIT_L(0); PG8_MMA(0, 1, At, B1); PG8_BAR;
            PG8_LDA(At, 1, 1); PG8_STAGE(PG8_SA(1, 0), a3, voffA);
            PG8_BAR; PG8_WAIT_L(0); PG8_MMA(1, 0, At, B0); PG8_BAR; PG8_SCHED;
            PG8_STAGE(PG8_SB(1, 1), b3 + hstep, voffB);
            PG8_WAIT_V(6); PG8_BAR; PG8_MMA(1, 1, At, B1); PG8_BAR;
            }
        }
        if constexpr (ALIGN_EPI) { if (wr == 0) PG8_BAR; }
        if constexpr (!Epi::AFTER_DRAIN) { E(acc, cur, wr, wc, fr, fq); S.done(cur); }
        if (!has_next) break;
#pragma unroll
        for (int a = 0; a < 2; ++a)
#pragma unroll
            for (int b = 0; b < 2; ++b)
#pragma unroll
                for (int m = 0; m < 4; ++m)
#pragma unroll
                    for (int n = 0; n < 2; ++n) acc[a][b][m][n] = (f32x4){0.f, 0.f, 0.f, 0.f};
        cur = nxt; cA = nA; cB = nB; ++ui;
        if constexpr (ALIGN_EPI) { if (wr == 1) PG8_BAR; }
    }
    PG8_WAIT_V(0);
    if constexpr (!ALIGN_EPI) { if (wr == 0) PG8_BAR; }
    PG8_BAR;
    if constexpr (Epi::AFTER_DRAIN) { E.fused(acc, cur, wr, wc, fr, fq, lds, wid, lane); S.done(cur); }
#undef PG8_SA
#undef PG8_SB
#undef PG8_STAGE
#undef PG8_LDA
#undef PG8_LDB
#undef PG8_MMA
#undef PG8_WAIT_V
#undef PG8_WAIT_L
#undef PG8_BAR
#undef PG8_SCHED
}
}
#define XB_TMO      128
#define XB_XCNT(j)  (256  + 64 * (j))
#define XB_XSUB(j)  (1280 + 64 * (j))
#define XB_XGEN(j)  (2304 + 64 * (j))
#define XB_TOP      3328
#define XB_TOPGEN   3392
#define XCD_BAR_WORDS 3456
#define XB_SPIN_CAP (1u << 18)

__device__ __forceinline__ unsigned xb_ld(unsigned* p)              { return __hip_atomic_load(p, __ATOMIC_RELAXED, __HIP_MEMORY_SCOPE_AGENT); }
__device__ __forceinline__ unsigned xb_add(unsigned* p, unsigned v) { return __hip_atomic_fetch_add(p, v, __ATOMIC_RELAXED, __HIP_MEMORY_SCOPE_AGENT); }
__device__ __forceinline__ unsigned xb_xcc_id() { return (unsigned)__builtin_amdgcn_s_getreg((3 << 11) | 20) & 0xFu; }
#define XB_SPIN(cond, bar) do { unsigned _sp = 0; while (cond) { __builtin_amdgcn_s_sleep(1); \
    if ((++_sp & 255u) == 0u) { if (xb_ld(&(bar)[XB_TMO])) break; if (_sp > XB_SPIN_CAP) { atomicAdd(&(bar)[XB_TMO], 1u); break; } } } } while (0)

struct XcdBarrier {
    unsigned* bar; unsigned x;
    volatile LAS unsigned* st;
};

__device__ __forceinline__ XcdBarrier xcd_barrier_post(unsigned* bar, volatile LAS unsigned* st) {
    XcdBarrier b; b.bar = bar; b.x = xb_xcc_id(); b.st = st;
    if (threadIdx.x == 0) (void)xb_add(&bar[XB_XCNT(b.x)], 1u);
    return b;
}
__device__ __forceinline__ void xcd_barrier_complete(unsigned* bar, unsigned x, unsigned& nloc, unsigned& nx) {
    const unsigned G = gridDim.x * gridDim.y * gridDim.z;
    unsigned sum, cnt, mine, sp = 0u;
    for (;;) {
        sum = 0u; cnt = 0u; mine = 0u;
#pragma unroll
        for (unsigned j = 0; j < 16; ++j) { const unsigned c = xb_ld(&bar[XB_XCNT(j)]); sum += c; cnt += (c > 0u) ? 1u : 0u; mine = (j == x) ? c : mine; }
        if (sum == G) break;
        __builtin_amdgcn_s_sleep(1);
        if ((++sp & 255u) == 0u) { if (xb_ld(&bar[XB_TMO])) break; if (sp > XB_SPIN_CAP) { atomicAdd(&bar[XB_TMO], 1u); break; } }
    }
    nloc = mine > 0u ? mine : 1u; nx = cnt > 0u ? cnt : 1u;
}

__device__ __forceinline__ void xcd_barrier(const XcdBarrier& b) {
    asm volatile("s_waitcnt vmcnt(0)" ::: "memory");
    __syncthreads();
    if (threadIdx.x == 0) {
        unsigned* bar = b.bar;
        __builtin_amdgcn_s_waitcnt(0);
        unsigned nloc = b.st[0], nx = b.st[1];
        if (nloc == 0u) { xcd_barrier_complete(bar, b.x, nloc, nx); b.st[0] = nloc; b.st[1] = nx; }
        const unsigned old = xb_add(&bar[XB_XSUB(b.x)], 1u);
        const unsigned gen = old / nloc;
        if (old + 1u == (gen + 1u) * nloc) {
            __builtin_amdgcn_fence(__ATOMIC_RELEASE, "agent");
            asm volatile("s_waitcnt vmcnt(0)" ::: "memory");
            const unsigned og = xb_add(&bar[XB_TOP], 1u);
            const unsigned tg = og / nx;
            if (og + 1u == (tg + 1u) * nx) xb_add(&bar[XB_TOPGEN], 1u);
            else XB_SPIN(xb_ld(&bar[XB_TOPGEN]) == tg, bar);
            __builtin_amdgcn_fence(__ATOMIC_ACQUIRE, "agent");
            xb_add(&bar[XB_XGEN(b.x)], 1u);
            asm volatile("s_waitcnt vmcnt(0)" ::: "memory");
        } else {
            XB_SPIN(xb_ld(&bar[XB_XGEN(b.x)]) == gen, bar);
            __builtin_amdgcn_fence(__ATOMIC_ACQUIRE, "agent");
            asm volatile("s_waitcnt vmcnt(0)" ::: "memory");
        }
    }
    __syncthreads();
}

__device__ __forceinline__ void xcd_barrier_local(const XcdBarrier& b) {
    asm volatile("s_waitcnt vmcnt(0)" ::: "memory");
    __syncthreads();
    if (threadIdx.x == 0) {
        unsigned* bar = b.bar;
        __builtin_amdgcn_s_waitcnt(0);
        const unsigned nloc = b.st[0];
        const unsigned old = xb_add(&bar[XB_XSUB(b.x)], 1u);
        const unsigned gen = old / nloc;
        if (old + 1u == (gen + 1u) * nloc) xb_add(&bar[XB_XGEN(b.x)], 1u);
        else XB_SPIN(xb_ld(&bar[XB_XGEN(b.x)]) == gen, bar);
        __builtin_amdgcn_fence(__ATOMIC_ACQUIRE, "agent");
        asm volatile("s_waitcnt vmcnt(0)" ::: "memory");
    }
    __syncthreads();
}

#define XB_QSUB(q) (24576 + 64 * (q))
#define XB_QGEN(q) (28672 + 64 * (q))
__device__ __forceinline__ void quad_barrier(const XcdBarrier& b, unsigned q) {
    asm volatile("s_waitcnt vmcnt(0)" ::: "memory");
    __syncthreads();
    if (threadIdx.x == 0) {
        unsigned* bar = b.bar;
        __builtin_amdgcn_s_waitcnt(0);
        const unsigned old = xb_add(&bar[XB_QSUB(q)], 1u);
        const unsigned gen = old / 4u;
        if (old + 1u == (gen + 1u) * 4u) xb_add(&bar[XB_QGEN(q)], 1u);
        else XB_SPIN(xb_ld(&bar[XB_QGEN(q)]) == gen, bar);
        __builtin_amdgcn_fence(__ATOMIC_ACQUIRE, "agent");
        asm volatile("s_waitcnt vmcnt(0)" ::: "memory");
    }
    __syncthreads();
}

#define XB_OSUB(o) (36864 + 64 * (o))
#define XB_OGEN(o) (40960 + 64 * (o))
__device__ __forceinline__ void octet_barrier(const XcdBarrier& b, unsigned o) {
    asm volatile("s_waitcnt vmcnt(0)" ::: "memory");
    __syncthreads();
    if (threadIdx.x == 0) {
        unsigned* bar = b.bar;
        __builtin_amdgcn_s_waitcnt(0);
        const unsigned old = xb_add(&bar[XB_OSUB(o)], 1u);
        const unsigned gen = old / 8u;
        if (old + 1u == (gen + 1u) * 8u) xb_add(&bar[XB_OGEN(o)], 1u);
        else XB_SPIN(xb_ld(&bar[XB_OGEN(o)]) == gen, bar);
        __builtin_amdgcn_fence(__ATOMIC_ACQUIRE, "agent");
        asm volatile("s_waitcnt vmcnt(0)" ::: "memory");
    }
    __syncthreads();
}

#ifndef REP_GU
#define REP_GU 1
#endif
#ifndef REP_DN
#define REP_DN 1
#endif
#ifndef REP_IN
#define REP_IN 1
#endif
#ifndef REP_PRO
#define REP_PRO 1
#endif
#ifndef REP_SB
#define REP_SB 1
#endif
#ifndef REP_CONV
#define REP_CONV 1
#endif
#ifndef REP_CMP
#define REP_CMP 1
#endif
#ifndef REP_GMLP
#define REP_GMLP 1
#endif
#ifndef REP_NSA
#define REP_NSA 1
#endif
#ifndef REP_LN
#define REP_LN 1
#endif
#ifndef REP_SYNC
#define REP_SYNC 1
#endif

#ifdef XSB
#define DIS_SB(x)
#else
#define DIS_SB(x) x
#endif
#ifdef XCONV
#define DIS_CONV(x)
#else
#define DIS_CONV(x) x
#endif
#ifdef XCMP
#define DIS_CMP(x)
#else
#define DIS_CMP(x) x
#endif
#ifdef XGMLP
#define DIS_GMLP(x)
#else
#define DIS_GMLP(x) x
#endif
#ifdef XNSA
#define DIS_NSA(x)
#else
#define DIS_NSA(x) x
#endif
#ifdef XGEMM
#define DIS_GEMM(x)
#else
#define DIS_GEMM(x) x
#endif

#define LAS __attribute__((address_space(3)))
typedef unsigned short bf16_t;
typedef short bf16x8 __attribute__((ext_vector_type(8)));
typedef short s16x4 __attribute__((ext_vector_type(4)));
typedef short v4i16_t __attribute__((ext_vector_type(4)));
typedef float f32x4 __attribute__((ext_vector_type(4)));
typedef float f32x16 __attribute__((ext_vector_type(16)));
typedef unsigned u32x4 __attribute__((ext_vector_type(4)));
typedef unsigned u32x2 __attribute__((ext_vector_type(2)));

constexpr int NB = 16, SEQ = 2048, DM = 1024, MTOK = NB * SEQ;
constexpr int HW = 2560;
constexpr int FF = 2816;
constexpr float ALPHA = 1.41421356237309515f;
constexpr float LN_EPS = 1e-5f;
constexpr float LOG2E = 1.4426950408889634f;
constexpr float C2 = 0.125f * LOG2E;

constexpr size_t MiB = 1u << 20;
constexpr size_t WS_IN0 = 0 * MiB, WS_OUT0 = 6 * MiB, WS_IN1 = 8 * MiB, WS_OUT1 = 14 * MiB;
constexpr size_t WS_GU0 = 16 * MiB, WS_GU1 = 28 * MiB, WS_DN0 = 40 * MiB, WS_DN1 = 46 * MiB;
constexpr size_t WS_W1TK = 52 * MiB, WS_W1TV = 53 * MiB, WS_TRIL = 54 * MiB, WS_KCMP = 55 * MiB, WS_VCMP = 56 * MiB;
constexpr size_t WS_PT = 56 * MiB + 768 * 1024;
constexpr size_t WS_XCH = 57 * MiB, WS_CTL = 61 * MiB, CTL_BYTES = 256 * 1024;
constexpr int CW_TMO = 4096, CW_SEAM = 8192;
constexpr size_t WS_XB = 64 * MiB, WS_H = 128 * MiB, WS_MIX = 304 * MiB, WS_MB = 368 * MiB, WS_END = 432 * MiB;

constexpr int LDS_BYTES = 147456;

struct Params { const float* in[26]; float* out; unsigned char* ws; };
__device__ __forceinline__ int opaque_tid() { int t = threadIdx.x; asm volatile("" : "+v"(t)); return t; }

__device__ __forceinline__ unsigned f2bf(float f) { unsigned u = __builtin_bit_cast(unsigned, f); return (u + 0x7fffu + ((u >> 16) & 1u)) >> 16; }
__device__ __forceinline__ unsigned pk2(float lo, float hi) { return pg8::cvt_pk_bf16(lo, hi); }
__device__ __forceinline__ float bf2f(unsigned b) { return __builtin_bit_cast(float, b << 16); }
__device__ __forceinline__ float bflo(unsigned w) { return __builtin_bit_cast(float, w << 16); }
__device__ __forceinline__ float bfhi(unsigned w) { return __builtin_bit_cast(float, w & 0xffff0000u); }
__device__ __forceinline__ float wave_sum(float v) {
#pragma unroll
    for (int o = 1; o < 64; o <<= 1) v += __shfl_xor(v, o);
    return v;
}
__device__ __forceinline__ float xor32(float v) {
    const unsigned u = __builtin_bit_cast(unsigned, v);
    auto rr = __builtin_amdgcn_permlane32_swap(u, u, false, false);
    return __builtin_bit_cast(float, (threadIdx.x & 32u) ? rr[0] : rr[1]);
}
__device__ __forceinline__ float sigmoidf_(float x) { return __builtin_amdgcn_rcpf(1.f + __expf(-x)); }
__device__ __forceinline__ float siluf_(float x) { return x * __builtin_amdgcn_rcpf(1.f + __expf(-x)); }
__device__ __forceinline__ float gelu_tanh(float x) {
    const float u = 0.7978845608028654f * (x + 0.044715f * x * x * x);
    return x * __builtin_amdgcn_rcpf(1.f + __expf(-2.f * u));
}
#define LDSW() asm volatile("s_waitcnt lgkmcnt(0)" ::: "memory")
#define MFMA32(a, b, c) __builtin_amdgcn_mfma_f32_32x32x16_bf16((a), (b), (c), 0, 0, 0)
__device__ __forceinline__ int crow(int r, int hi) { return (r & 3) + 8 * (r >> 2) + 4 * hi; }

struct EpiStore {
    static constexpr bool PERM = true, AFTER_DRAIN = false;
    bf16_t* O; int ldc;
    __device__ __forceinline__ void operator()(const pg8::f32x4 (&acc)[2][2][4][2], const pg8::Unit& u, int wr, int wc, int fr, int fq) const {
        const int row0 = u.pm * 256 + wr * 64 + fr, col0 = u.pn * 256 + wc * 32 + 8 * fq;
#pragma unroll
        for (int ai = 0; ai < 2; ++ai)
#pragma unroll
            for (int m = 0; m < 4; ++m) { bf16_t* rowp = O + (size_t)(row0 + ai * 128 + m * 16) * ldc + col0;
#pragma unroll
                for (int bj = 0; bj < 2; ++bj) { const pg8::f32x4 v0 = acc[ai][bj][m][0], v1 = acc[ai][bj][m][1];
                    u32x4 w; w.x = pk2(v0[0], v0[1]); w.y = pk2(v0[2], v0[3]); w.z = pk2(v1[0], v1[1]); w.w = pk2(v1[2], v1[3]);
                    *(u32x4*)(rowp + bj * 128) = w; } }
    }
};
struct EpiResid {
    static constexpr bool PERM = true, AFTER_DRAIN = false;
    bf16_t* O; const bf16_t* X;
    __device__ __forceinline__ void operator()(const pg8::f32x4 (&acc)[2][2][4][2], const pg8::Unit& u, int wr, int wc, int fr, int fq) const {
        const int row0 = u.pm * 256 + wr * 64 + fr, col0 = u.pn * 256 + wc * 32 + 8 * fq;
#pragma unroll
        for (int ai = 0; ai < 2; ++ai)
#pragma unroll
            for (int m = 0; m < 4; ++m) { const size_t off = (size_t)(row0 + ai * 128 + m * 16) * DM + col0;
#pragma unroll
                for (int bj = 0; bj < 2; ++bj) { const pg8::f32x4 v0 = acc[ai][bj][m][0], v1 = acc[ai][bj][m][1];
                    const u32x4 xr = *(const u32x4*)(X + off + bj * 128);
                    u32x4 w; w.x = pk2(v0[0] + ALPHA * bflo(xr.x), v0[1] + ALPHA * bfhi(xr.x)); w.y = pk2(v0[2] + ALPHA * bflo(xr.y), v0[3] + ALPHA * bfhi(xr.y));
                    w.z = pk2(v1[0] + ALPHA * bflo(xr.z), v1[1] + ALPHA * bfhi(xr.z)); w.w = pk2(v1[2] + ALPHA * bflo(xr.w), v1[3] + ALPHA * bfhi(xr.w));
                    *(u32x4*)(O + off + bj * 128) = w; } }
    }
};
struct EpiSwiglu {
    static constexpr bool PERM = true, AFTER_DRAIN = false;
    bf16_t* O; int ldc;
    __device__ __forceinline__ void operator()(const pg8::f32x4 (&acc)[2][2][4][2], const pg8::Unit& u, int wr, int wc, int fr, int fq) const {
        const int row0 = u.pm * 256 + wr * 64 + fr, col0 = u.pn * 128 + wc * 16 + 4 * fq;
#pragma unroll
        for (int ai = 0; ai < 2; ++ai)
#pragma unroll
            for (int m = 0; m < 4; ++m) { bf16_t* rowp = O + (size_t)(row0 + ai * 128 + m * 16) * ldc + col0;
#pragma unroll
                for (int bj = 0; bj < 2; ++bj) { const pg8::f32x4 gv = acc[ai][bj][m][0], uv = acc[ai][bj][m][1];
                    u32x2 w; w.x = pk2(siluf_(gv[0]) * uv[0], siluf_(gv[1]) * uv[1]); w.y = pk2(siluf_(gv[2]) * uv[2], siluf_(gv[3]) * uv[3]);
                    *(u32x2*)(rowp + bj * 64) = w; } }
    }
};


struct EpiLnOut {
    static constexpr bool PERM = false, AFTER_DRAIN = true;
    const float* base; float* out; bf16_t* xb; const float* gam; const float* bet; pg8::PanelStats st;
    __device__ __forceinline__ void fused(pg8::f32x4 (&acc)[2][2][4][2], const pg8::Unit& u, int wr, int wc, int fr, int fq, PG8_LAS unsigned char* lds, int wid, int lane) const {
        typedef float f32x2v __attribute__((ext_vector_type(2)));
        const PG8_LAS f32x2v* S = (const PG8_LAS f32x2v*)(lds + 8192);
        const int col0 = u.pn * 256 + wc * 32 + 4 * fq;
#pragma unroll
        for (int ai = 0; ai < 2; ++ai)
#pragma unroll
            for (int m = 0; m < 4; ++m) { const size_t off = (size_t)(u.pm * 256 + ai * 128 + wr * 64 + m * 16 + fr) * DM + col0;
#pragma unroll
                for (int bj = 0; bj < 2; ++bj)
#pragma unroll
                    for (int n = 0; n < 2; ++n) { const pg8::f32x4 bs = *(const pg8::f32x4*)(base + off + bj * 128 + n * 16); acc[ai][bj][m][n] += bs * ALPHA; }
                asm volatile("" : "+v"(acc[ai][0][m][0]), "+v"(acc[ai][0][m][1]), "+v"(acc[ai][1][m][0]), "+v"(acc[ai][1][m][1]));
                if (m & 1) asm volatile("" ::: "memory"); }
        const bool bad = st.run(acc, u, wr, wc, fr, fq, lds, wid, lane);
        const float qnan = __builtin_nanf("");
        pg8::f32x4 gv[2][2], bv[2][2];
#pragma unroll
        for (int bj = 0; bj < 2; ++bj)
#pragma unroll
            for (int n = 0; n < 2; ++n) { gv[bj][n] = *(const pg8::f32x4*)(gam + col0 + bj * 128 + n * 16); bv[bj][n] = *(const pg8::f32x4*)(bet + col0 + bj * 128 + n * 16); }
#pragma unroll
        for (int ai = 0; ai < 2; ++ai)
#pragma unroll
            for (int m = 0; m < 4; ++m) { const int r = ai * 128 + wr * 64 + m * 16 + fr; const f32x2v sr = S[r]; const size_t off = (size_t)(u.pm * 256 + r) * DM + col0;
#pragma unroll
                for (int bj = 0; bj < 2; ++bj)
#pragma unroll
                    for (int n = 0; n < 2; ++n) {
                        pg8::f32x4 o = (acc[ai][bj][m][n] - sr.x) * sr.y * gv[bj][n] + bv[bj][n];
                        if (bad) o = (pg8::f32x4){qnan, qnan, qnan, qnan};
                        *(pg8::f32x4*)(out + off + bj * 128 + n * 16) = o; u32x2 w; w.x = pk2(o[0], o[1]); w.y = pk2(o[2], o[3]); *(u32x2*)(xb + off + bj * 128 + n * 16) = w; }
                asm volatile("" ::: "memory"); }
    }
};
struct RoundOrder {
    pg8::StaticOrder so; int round;
    __device__ __forceinline__ bool next(int i, pg8::Unit& u) const { if (i != 0) return false; return so.next(round, u); }
    __device__ __forceinline__ void a_ready(const pg8::Unit&) const {}
    __device__ __forceinline__ void done(const pg8::Unit&) const {}
};
__device__ __forceinline__ void run_gemm_ln(LAS unsigned char* lds, unsigned char* ws, const bf16_t* A, const bf16_t* Bt, int K, int inst,
                                            const float* base, float* out, bf16_t* xb, const float* gam, const float* bet) {
    pg8::Gemm g{A, Bt, MTOK, 1024, K};
    unsigned* ctl = (unsigned*)(ws + WS_CTL);
    const int nrounds = (MTOK / 256) * 4 / (int)gridDim.x;
    for (int r = 0; r < nrounds; ++r) {
        RoundOrder S; S.so.init(MTOK, 1024, (int)gridDim.x, (int)blockIdx.x); S.round = r;
        pg8::PanelStats st{(unsigned*)(ws + WS_XCH + (size_t)inst * MiB), ctl + CW_SEAM + inst * 8192, ctl + CW_TMO, 4, LN_EPS, 0x700u + (unsigned)inst};
#ifdef TEST_EXEPI
        pg8::EpiLnRes E{base, out, DM, nullptr, st, 0u};
        pg8::gemm_phase<pg8::EpiLnRes, RoundOrder, false, true>(lds, g, S, E);
#else
        EpiLnOut E{base, out, xb, gam, bet, st};
        pg8::gemm_phase<EpiLnOut, RoundOrder, false, true>(lds, g, S, E);
#endif
        __syncthreads();
    }
}

template <class Epi>
__device__ __forceinline__ void run_gemm(LAS unsigned char* lds, const bf16_t* A, const bf16_t* Bt, int N, int K, const Epi& E) {
    pg8::Gemm g{A, Bt, MTOK, N, K}; pg8::StaticOrder S; S.init(MTOK, N, (int)gridDim.x, (int)blockIdx.x);
    DIS_GEMM((pg8::gemm_phase<Epi, pg8::StaticOrder, true, true>(lds, g, S, E)));
}

__device__ __forceinline__ int map_row(int mode, int n) {
    if (mode == 0) return n;
    if (mode == 1) return (n >> 2) * 8 + (n & 3);
    if (mode == 2) return (n >> 2) * 8 + 4 + (n & 3);
    if (n < 1280) return n;
    if (n < 1304) return 2304 + (n - 1280);
    return n - 24;
}
__device__ __forceinline__ void p0_transpose_item(const float* W, int K, int N, bf16_t* WT, int mode, LAS float* scr, int item, int lane) {
    const int nblk = (N + 31) / 32, kb = item / nblk, nb = item % nblk, k0 = 64 * kb, n0 = 32 * nb;
    const int nn = n0 + (lane & 31);
    float wv[32];
#pragma unroll
    for (int i = 0; i < 32; ++i) { const int kk = 2 * i + (lane >> 5); wv[i] = (nn < N) ? W[(size_t)(k0 + kk) * N + nn] : 0.f; }
#pragma unroll
    for (int i = 0; i < 32; ++i) { const int kk = 2 * i + (lane >> 5); scr[kk * 33 + (lane & 31)] = wv[i]; }
    LDSW();
    const int c = lane & 7;
#pragma unroll
    for (int j = 0; j < 4; ++j) { const int nl = (lane >> 3) + 8 * j, n = n0 + nl; const LAS float* s = scr + (8 * c) * 33 + nl;
        u32x4 o; o.x = pk2(s[0 * 33], s[1 * 33]); o.y = pk2(s[2 * 33], s[3 * 33]); o.z = pk2(s[4 * 33], s[5 * 33]); o.w = pk2(s[6 * 33], s[7 * 33]);
        if (n < N) *(u32x4*)(WT + (size_t)map_row(mode, n) * K + k0 + 8 * c) = o; }
    LDSW();
}
__device__ __forceinline__ void p0_prologue(const Params& p, LAS unsigned char* lds) {
    const int tid = opaque_tid(), lane = tid & 63, wave = tid >> 6;
    LAS float* scr = (LAS float*)(lds + wave * 16384);
    const int gw = blockIdx.x * 8 + wave, NGW = gridDim.x * 8;
    unsigned char* ws = p.ws;
    constexpr int I_IN0 = 16 * 80, I_OUT = 16 * 32, I_IN1 = 16 * 73, I_G = 16 * 88, I_DN = 44 * 32, I_W1 = 32 * 2;
    constexpr int NITEMS = I_IN0 + 2 * I_OUT + I_IN1 + 4 * I_G + 2 * I_DN + 2 * I_W1;
    for (int it = gw; it < NITEMS; it += NGW) {
        int r = it;
        if (r < I_IN0) { p0_transpose_item(p.in[1], 1024, 2560, (bf16_t*)(ws + WS_IN0), 0, scr, r, lane); continue; } r -= I_IN0;
        if (r < I_OUT) { p0_transpose_item(p.in[6], 1024, 1024, (bf16_t*)(ws + WS_OUT0), 0, scr, r, lane); continue; } r -= I_OUT;
        if (r < I_OUT) { p0_transpose_item(p.in[18], 1024, 1024, (bf16_t*)(ws + WS_OUT1), 0, scr, r, lane); continue; } r -= I_OUT;
        if (r < I_IN1) { p0_transpose_item(p.in[7], 1024, 2328, (bf16_t*)(ws + WS_IN1), 3, scr, r, lane); continue; } r -= I_IN1;
        if (r < I_G) { p0_transpose_item(p.in[19], 1024, FF, (bf16_t*)(ws + WS_GU0), 1, scr, r, lane); continue; } r -= I_G;
        if (r < I_G) { p0_transpose_item(p.in[20], 1024, FF, (bf16_t*)(ws + WS_GU0), 2, scr, r, lane); continue; } r -= I_G;
        if (r < I_G) { p0_transpose_item(p.in[19] + (size_t)1024 * FF, 1024, FF, (bf16_t*)(ws + WS_GU1), 1, scr, r, lane); continue; } r -= I_G;
        if (r < I_G) { p0_transpose_item(p.in[20] + (size_t)1024 * FF, 1024, FF, (bf16_t*)(ws + WS_GU1), 2, scr, r, lane); continue; } r -= I_G;
        if (r < I_DN) { p0_transpose_item(p.in[21], FF, 1024, (bf16_t*)(ws + WS_DN0), 0, scr, r, lane); continue; } r -= I_DN;
        if (r < I_DN) { p0_transpose_item(p.in[21] + (size_t)FF * 1024, FF, 1024, (bf16_t*)(ws + WS_DN1), 0, scr, r, lane); continue; } r -= I_DN;
        if (r < I_W1) { p0_transpose_item(p.in[9], 2048, 64, (bf16_t*)(ws + WS_W1TK), 0, scr, r, lane); continue; } r -= I_W1;
        p0_transpose_item(p.in[12], 2048, 64, (bf16_t*)(ws + WS_W1TV), 0, scr, r, lane);
    }
    if (blockIdx.x >= gridDim.x - 16) {
        const int bq_ = (int)blockIdx.x - ((int)gridDim.x - 16), kv = bq_ >> 3, kp = bq_ & 7; const float* pos = p.in[kv ? 11 : 8]; const float* w1 = p.in[kv ? 12 : 9];
        LAS float* ptL = (LAS float*)(lds + 135168);
        const int e = tid & 63, sub = tid >> 6, k0 = kp * 256 + sub * 32;
        float pv_[32], wv_[32];
#pragma unroll
        for (int i = 0; i < 32; ++i) { pv_[i] = pos[k0 + i]; wv_[i] = w1[(size_t)(k0 + i) * 64 + e]; }
        float a0 = 0.f, a1 = 0.f, a2 = 0.f, a3 = 0.f;
#pragma unroll
        for (int i = 0; i < 32; i += 4) { a0 += pv_[i] * wv_[i]; a1 += pv_[i + 1] * wv_[i + 1]; a2 += pv_[i + 2] * wv_[i + 2]; a3 += pv_[i + 3] * wv_[i + 3]; }
        ptL[sub * 64 + e] = (a0 + a1) + (a2 + a3);
        __syncthreads();
        if (tid < 64) { float pt = 0.f;
#pragma unroll
            for (int ww = 0; ww < 8; ++ww) pt += ptL[ww * 64 + tid];
            ((float*)(ws + WS_PT))[(kv * 8 + kp) * 64 + tid] = pt; }
        __syncthreads();
    }
    const int gt = blockIdx.x * 512 + tid, NGT = gridDim.x * 512;
    { u32x4* z = (u32x4*)((bf16_t*)(ws + WS_IN1) + (size_t)2328 * 1024); const int n16 = 232 * 1024 * 2 / 16;
      for (int i = gt; i < n16; i += NGT) z[i] = (u32x4){0u, 0u, 0u, 0u}; }
    { const float* wsrc = p.in[16]; bf16_t* tr = (bf16_t*)(ws + WS_TRIL);
      for (int i = gt; i < 4 * 128 * 128; i += NGT) { const int t = (i >> 7) & 127, s = i & 127; tr[i] = (bf16_t)((s <= t) ? f2bf(wsrc[i]) : 0u); } }
    { const float* x = p.in[0]; bf16_t* xb = (bf16_t*)(ws + WS_XB);
      for (int m = gw; m < MTOK; m += 4 * NGW) {
          f32x4 v[4][4];
#pragma unroll
          for (int r = 0; r < 4; ++r) { const int mm = m + r * NGW; if (mm < MTOK) { const f32x4* xr = (const f32x4*)(x + (size_t)mm * DM) + lane;
#pragma unroll
              for (int j = 0; j < 4; ++j) v[r][j] = xr[64 * j]; } }
#pragma unroll
          for (int r = 0; r < 4; ++r) { const int mm = m + r * NGW; if (mm < MTOK) { u32x2* o8 = (u32x2*)(xb + (size_t)mm * DM) + lane;
#pragma unroll
              for (int j = 0; j < 4; ++j) { u32x2 w; w.x = pk2(v[r][j].x, v[r][j].y); w.y = pk2(v[r][j].z, v[r][j].w); o8[64 * j] = w; } } } } }
}

template <bool F32IN, bool F32OUT>
__device__ __forceinline__ void ln_phase(const float* xin, const bf16_t* xbin, const bf16_t* mb, const float* gam, const float* bet, float* xout, bf16_t* xb) {
    const int tid = opaque_tid(), lane = tid & 63, wave = tid >> 6;
    const int G_ = gridDim.x, bx_ = blockIdx.x; const bool xown = (G_ == 256);
    const int vc_ = xown ? (bx_ % 8) * 32 + bx_ / 8 : bx_;
    const int r_ = bx_ / 8, p_ = r_ & 7, qw_ = (r_ >> 3) * 8 + wave, panel0 = (bx_ % 8) * 16 + p_;
    f32x4 gv[4], bv[4];
#pragma unroll
    for (int j = 0; j < 4; ++j) { gv[j] = ((const f32x4*)gam)[64 * j + lane]; bv[j] = ((const f32x4*)bet)[64 * j + lane]; }
    const int nrows = xown ? 16 : (MTOK + G_ * 8 - 1) / (G_ * 8);
    for (int it_ = 0; it_ < nrows; ++it_) {
        const int m = xown ? (panel0 + 8 * (it_ >> 3)) * 256 + qw_ + 32 * (it_ & 7) : bx_ * 8 + wave + it_ * G_ * 8;
        if (m >= MTOK) break;
        const u32x2* mr = (const u32x2*)(mb + (size_t)m * DM) + lane;
        f32x4 v[4]; float s = 0.f;
#pragma unroll
        for (int j = 0; j < 4; ++j) { f32x4 x;
            if (F32IN) x = ((const f32x4*)(xin + (size_t)m * DM) + lane)[64 * j];
            else { const u32x2 xw = ((const u32x2*)(xbin + (size_t)m * DM) + lane)[64 * j]; x.x = bflo(xw.x); x.y = bfhi(xw.x); x.z = bflo(xw.y); x.w = bfhi(xw.y); }
            const u32x2 w = mr[64 * j];
            v[j].x = ALPHA * x.x + bflo(w.x); v[j].y = ALPHA * x.y + bfhi(w.x); v[j].z = ALPHA * x.z + bflo(w.y); v[j].w = ALPHA * x.w + bfhi(w.y);
            s += (v[j].x + v[j].y) + (v[j].z + v[j].w); }
        const float mean = wave_sum(s) * (1.f / DM); float s2 = 0.f;
#pragma unroll
        for (int j = 0; j < 4; ++j) { v[j] = v[j] - mean; s2 += (v[j].x * v[j].x + v[j].y * v[j].y) + (v[j].z * v[j].z + v[j].w * v[j].w); }
        const float rstd = rsqrtf(wave_sum(s2) * (1.f / DM) + LN_EPS);
#pragma unroll
        for (int j = 0; j < 4; ++j) { const f32x4 o = v[j] * rstd * gv[j] + bv[j];
            if (F32OUT) ((f32x4*)(xout + (size_t)m * DM) + lane)[64 * j] = o;
            else { u32x2 w; w.x = pk2(o.x, o.y); w.y = pk2(o.z, o.w); ((u32x2*)(xb + (size_t)m * DM) + lane)[64 * j] = w; } }
    }
}

constexpr int KS = 144;
constexpr int TILEB = 64 * KS;
constexpr int L_K = 0, L_V = 2 * TILEB, L_WSF = 4 * TILEB  , L_DONE = L_WSF + 1024, L_IMP = L_DONE + 256  , L_SEL = L_IMP + 4 * 64 * 33 * 4  , L_OACC = 73728;

__device__ __forceinline__ s16x4 vtr(const LAS char* p) { return __builtin_bit_cast(s16x4, __builtin_amdgcn_ds_read_tr16_b64_v4i16((LAS v4i16_t*)p)); }

__device__ __forceinline__ f32x16 qk_sub(const LAS char* kt, int sub, const bf16x8 (&qr)[4], int r32, int hi) {
    f32x16 s;
#pragma unroll
    for (int i = 0; i < 16; ++i) s[i] = 0.f;
    const LAS char* kp = kt + (32 * sub + r32) * KS + hi * 16;
#pragma unroll
    for (int d0 = 0; d0 < 4; ++d0) { const bf16x8 a = *(const LAS bf16x8*)(kp + d0 * 32); s = MFMA32(a, qr[d0], s); }
    return s;
}
__device__ __forceinline__ void pv_sub(f32x16 (&o)[2], const f32x16& p, const LAS char* vt, int sub, int lane) {
    const int hi = lane >> 5;
    const LAS char* vp = vt + (32 * sub + 4 * hi + ((lane & 15) >> 2)) * KS + (16 * ((lane >> 4) & 1) + 4 * (lane & 3)) * 2;
#pragma unroll
    for (int s = 0; s < 2; ++s) {
        u32x4 pw; pw.x = pk2(p[8 * s + 0], p[8 * s + 1]); pw.y = pk2(p[8 * s + 2], p[8 * s + 3]); pw.z = pk2(p[8 * s + 4], p[8 * s + 5]); pw.w = pk2(p[8 * s + 6], p[8 * s + 7]);
        const bf16x8 pa = __builtin_bit_cast(bf16x8, pw);
#pragma unroll
        for (int db = 0; db < 2; ++db) {
            const s16x4 lo = vtr(vp + (16 * s) * KS + db * 64), hi4 = vtr(vp + (16 * s + 8) * KS + db * 64);
            const bf16x8 vb = (bf16x8){lo[0], lo[1], lo[2], lo[3], hi4[0], hi4[1], hi4[2], hi4[3]};
            o[db] = MFMA32(pa, vb, o[db]);
        }
    }
}
__device__ __forceinline__ void bcast_rows(float (&f)[16], LAS float* wsf_w, float val, int r32, int hi) {
    LDSW();
    if (hi == 0) wsf_w[r32] = val;
    LDSW();
#pragma unroll
    for (int r = 0; r < 16; ++r) f[r] = wsf_w[crow(r, hi)];
    LDSW();
}

__device__ __forceinline__ void sb_unit(const Params& p, LAS unsigned char* lds8, int b, int hp, int qb) {
    LAS char* lds = (LAS char*)lds8;
    const int tid = opaque_tid(), lane = tid & 63, w = __builtin_amdgcn_readfirstlane(tid >> 6), r32 = lane & 31, hi = lane >> 5;
    const int hd = w >> 2, hh = 2 * hp + hd, wq = w & 3;
    const bf16_t* H0 = (const bf16_t*)(p.ws + WS_H);
    bf16_t* MIX = (bf16_t*)(p.ws + WS_MIX);
    const size_t rowbase = (size_t)b * SEQ;
    const int t = 128 * qb + 32 * wq + r32, twmax = 128 * qb + 32 * wq + 31;
    constexpr int SB_K = 0, SB_V = 4 * TILEB, SB_DONE = 8 * TILEB;
    bf16x8 qr[4];
    { const bf16_t* qp = H0 + (rowbase + t) * HW + hh * 64;
#pragma unroll
      for (int d0 = 0; d0 < 4; ++d0) qr[d0] = *(const bf16x8*)(qp + 16 * d0 + 8 * hi); }
    f32x16 o[2];
#pragma unroll
    for (int i = 0; i < 16; ++i) { o[0][i] = 0.f; o[1][i] = 0.f; }
    float R = 0.f; bool wdone = false;
    const int lrow = tid >> 3, lch = tid & 7;
    const bf16_t* kg = H0 + (rowbase + lrow) * HW + 512 + (2 * hp) * 64 + lch * 8; const bf16_t* vg = kg + 512;
    LAS unsigned* doneL = (LAS unsigned*)(lds + SB_DONE);
    int j = 2 * qb + 1;
    u32x4 k0 = *(const u32x4*)(kg + (size_t)(64 * j) * HW), k1 = *(const u32x4*)(kg + (size_t)(64 * j) * HW + 64);
    u32x4 v0 = *(const u32x4*)(vg + (size_t)(64 * j) * HW), v1 = *(const u32x4*)(vg + (size_t)(64 * j) * HW + 64);
    for (int it = 0;; ++it) {
        LAS char* kw = lds + SB_K + (it & 1) * 2 * TILEB + lrow * KS + lch * 16; LAS char* vw = lds + SB_V + (it & 1) * 2 * TILEB + lrow * KS + lch * 16;
        *(LAS u32x4*)kw = k0; *(LAS u32x4*)(kw + TILEB) = k1; *(LAS u32x4*)vw = v0; *(LAS u32x4*)(vw + TILEB) = v1;
        if (lane == 0) doneL[(it & 1) * 8 + w] = wdone ? 1u : 0u;
        __syncthreads();
        { const u32x4 d0 = *(const LAS u32x4*)(doneL + (it & 1) * 8), d1 = *(const LAS u32x4*)(doneL + (it & 1) * 8 + 4);
          const unsigned all = d0.x & d0.y & d0.z & d0.w & d1.x & d1.y & d1.z & d1.w;
          if (all) break; }
        if (j > 0) { k0 = *(const u32x4*)(kg + (size_t)(64 * (j - 1)) * HW); k1 = *(const u32x4*)(kg + (size_t)(64 * (j - 1)) * HW + 64);
                     v0 = *(const u32x4*)(vg + (size_t)(64 * (j - 1)) * HW); v1 = *(const u32x4*)(vg + (size_t)(64 * (j - 1)) * HW + 64); }
        const LAS char* kt = lds + SB_K + ((it & 1) * 2 + hd) * TILEB; const LAS char* vt = lds + SB_V + ((it & 1) * 2 + hd) * TILEB;
#pragma unroll
        for (int sb_ = 0; sb_ < 2; ++sb_) {
            const int sub = 1 - sb_;
            const int kvb = 64 * j + 32 * sub;
            if (kvb >= twmax || wdone) continue;
            const f32x16 s = qk_sub(kt, sub, qr, r32, hi);
            float lr[16], lb[16];
#pragma unroll
            for (int r = 0; r < 16; ++r) {
                const int kv = kvb + crow(r, hi); const float z = s[r] * 0.125f;
                const float sp = fmaxf(z, 0.f) + __logf(1.f + __expf(-fabsf(z)));
                const bool past = kv < t;
                lr[r] = past ? -sp : 0.f; lb[r] = z - sp;
            }
            float T[4], To[4], aft[16];
#pragma unroll
            for (int gq = 0; gq < 4; ++gq) {
                aft[4 * gq + 3] = 0.f; aft[4 * gq + 2] = lr[4 * gq + 3]; aft[4 * gq + 1] = aft[4 * gq + 2] + lr[4 * gq + 2]; aft[4 * gq + 0] = aft[4 * gq + 1] + lr[4 * gq + 1];
                T[gq] = aft[4 * gq + 0] + lr[4 * gq + 0];
            }
#pragma unroll
            for (int gq = 0; gq < 4; ++gq) To[gq] = xor32(T[gq]);
            float A = 0.f;
            f32x16 pw;
#pragma unroll
            for (int gq = 3; gq >= 0; --gq) {
                const float ga = A + (hi == 0 ? To[gq] : 0.f);
#pragma unroll
                for (int i = 0; i < 4; ++i) { const int r = 4 * gq + i; const int kv = kvb + crow(r, hi);
                    const float e = __expf(lb[r] + R + ga + aft[r]); pw[r] = (kv < t) ? e : 0.f; }
                A += T[gq] + To[gq];
            }
            R += A;
            pv_sub(o, pw, vt, sub, lane);
            wdone = __all(R < -45.f);
        }
        wdone = wdone || __all(R < -45.f);
        if (j == 0) break;
        --j;
    }
    __syncthreads();
    bf16_t* op = MIX + (rowbase + 128 * qb + 32 * wq) * DM + hh * 64 + r32;
#pragma unroll
    for (int r = 0; r < 16; ++r) { const int q = crow(r, hi);
        op[(size_t)q * DM] = (bf16_t)f2bf(o[0][r]); op[(size_t)q * DM + 32] = (bf16_t)f2bf(o[1][r]); }
}

__device__ __forceinline__ void conv_unit(const Params& p, LAS unsigned char* lds8, int b, int tile) {
    const int tid = opaque_tid(), lane = tid & 63, w = tid >> 6;
    const bf16_t* H0 = (const bf16_t*)(p.ws + WS_H);
    bf16_t* MIX = (bf16_t*)(p.ws + WS_MIX);
    LAS bf16_t* hL = (LAS bf16_t*)lds8;
    LAS float* yL = (LAS float*)(lds8 + 63488);
    const int t0 = 32 * tile;
    const float* cw = p.in[2]; const float bias = p.in[3][tid];
    float wd[31];
#pragma unroll
    for (int k = 0; k < 31; ++k) wd[k] = cw[k * 512 + tid];
    const f32x4 g0 = ((const f32x4*)p.in[4])[lane * 2], g1 = ((const f32x4*)p.in[4])[lane * 2 + 1];
    const f32x4 b0 = ((const f32x4*)p.in[5])[lane * 2], b1 = ((const f32x4*)p.in[5])[lane * 2 + 1];
    {
        u32x4 av[8], gv8[8];
#pragma unroll
        for (int i = 0; i < 8; ++i) { const int tt = w + 8 * i, tok = t0 - 30 + tt; av[i] = (u32x4){0u, 0u, 0u, 0u}; gv8[i] = (u32x4){0u, 0u, 0u, 0u};
            if (tt < 62 && tok >= 0) { const bf16_t* rp = H0 + ((size_t)b * SEQ + tok) * HW + 1536 + lane * 8; av[i] = *(const u32x4*)rp; gv8[i] = *(const u32x4*)(rp + 512); } }
#pragma unroll
        for (int i = 0; i < 8; ++i) { const int tt = w + 8 * i; const u32x4 a = av[i], g = gv8[i]; u32x4 o;
            o.x = pk2(bflo(a.x) * sigmoidf_(bflo(g.x)), bfhi(a.x) * sigmoidf_(bfhi(g.x)));
            o.y = pk2(bflo(a.y) * sigmoidf_(bflo(g.y)), bfhi(a.y) * sigmoidf_(bfhi(g.y)));
            o.z = pk2(bflo(a.z) * sigmoidf_(bflo(g.z)), bfhi(a.z) * sigmoidf_(bfhi(g.z)));
            o.w = pk2(bflo(a.w) * sigmoidf_(bflo(g.w)), bfhi(a.w) * sigmoidf_(bfhi(g.w)));
            if (tt < 62) *(LAS u32x4*)(hL + tt * 512 + lane * 8) = o; }
    }
    __syncthreads();
    {
        const int c = tid;
        float hv[62];
#pragma unroll
        for (int i = 0; i < 62; ++i) hv[i] = bf2f((unsigned)hL[i * 512 + c]);
#pragma unroll
        for (int tq = 0; tq < 32; ++tq) { float y = bias;
#pragma unroll
            for (int k = 0; k < 31; ++k) y += hv[tq + k] * wd[k];
            yL[tq * 512 + c] = y; }
    }
    __syncthreads();
    {
#pragma unroll
        for (int i = 0; i < 4; ++i) { const int tq = 4 * w + i;
            f32x4 v0 = *(const LAS f32x4*)(yL + tq * 512 + lane * 8), v1 = *(const LAS f32x4*)(yL + tq * 512 + lane * 8 + 4);
            const float mean = wave_sum((v0.x + v0.y) + (v0.z + v0.w) + (v1.x + v1.y) + (v1.z + v1.w)) * (1.f / 512.f);
            v0 = v0 - mean; v1 = v1 - mean;
            const float var = wave_sum((v0.x * v0.x + v0.y * v0.y) + (v0.z * v0.z + v0.w * v0.w) + (v1.x * v1.x + v1.y * v1.y) + (v1.z * v1.z + v1.w * v1.w)) * (1.f / 512.f);
            const float rstd = rsqrtf(var + LN_EPS);
            v0 = v0 * rstd * g0 + b0; v1 = v1 * rstd * g1 + b1;
            u32x4 o; o.x = pk2(siluf_(v0.x), siluf_(v0.y)); o.y = pk2(siluf_(v0.z), siluf_(v0.w)); o.z = pk2(siluf_(v1.x), siluf_(v1.y)); o.w = pk2(siluf_(v1.z), siluf_(v1.w));
            *(u32x4*)(MIX + ((size_t)b * SEQ + t0 + tq) * DM + 512 + lane * 8) = o; }
    }
    __syncthreads();
}

__device__ __forceinline__ void compress_unit(const Params& p, LAS unsigned char* lds8, int b, int g, int kv, int nt) {
    LAS char* lds = (LAS char*)lds8;
    const int tid = opaque_tid(), lane = tid & 63, w = __builtin_amdgcn_readfirstlane(tid >> 6), r32 = lane & 31, hi = lane >> 5;
    const bf16_t* H1 = (const bf16_t*)(p.ws + WS_H);
    const float* w2 = p.in[kv ? 13 : 10];
    const bf16_t* w1t = (const bf16_t*)(p.ws + (kv ? WS_W1TV : WS_W1TK));
    bf16_t* outp = (bf16_t*)(p.ws + (kv ? WS_VCMP : WS_KCMP)) + (size_t)((b * 2 + g) * 128 + 32 * nt) * 64;
    constexpr int L_SLAB = 0, L_PART = 76032, L_PT = 76032 + 65536;
    LAS float* partL = (LAS float*)(lds + L_PART); const float* ptg = (const float*)(p.ws + WS_PT) + kv * 512;
    const int col = 512 + kv * 128 + g * 64;
#pragma unroll
    for (int it9 = 0; it9 < 9; ++it9) { const int idx = tid + 512 * it9; if (idx >= 528 * 8) break; const int i = idx >> 3, ch = idx & 7, tok = 512 * nt + i;
        u32x4 v = (u32x4){0u, 0u, 0u, 0u};
        if (tok < SEQ) v = *(const u32x4*)(H1 + ((size_t)b * SEQ + tok) * HW + col + ch * 8);
        *(LAS u32x4*)(lds + L_SLAB + ((i & 15) * 33 + (i >> 4)) * KS + ch * 16) = v; }
    __syncthreads();
    f32x16 acc[2];
#pragma unroll
    for (int i = 0; i < 16; ++i) { acc[0][i] = 0.f; acc[1][i] = 0.f; }
#pragma unroll
    for (int li = 0; li < 4; ++li) { const int l = 4 * w + li, c = l & 15, mo = l >> 4;
        const LAS char* ap = lds + L_SLAB + (c * 33 + r32 + mo) * KS + hi * 16;
        const bf16_t* bp = w1t + (size_t)r32 * 2048 + l * 64 + 8 * hi;
#pragma unroll
        for (int d0 = 0; d0 < 4; ++d0) { const bf16x8 a = *(const LAS bf16x8*)(ap + d0 * 32);
            const bf16x8 b0 = *(const bf16x8*)(bp + 16 * d0), b1 = *(const bf16x8*)(bp + (size_t)32 * 2048 + 16 * d0);
            acc[0] = MFMA32(a, b0, acc[0]); acc[1] = MFMA32(a, b1, acc[1]); } }
#pragma unroll
    for (int r = 0; r < 16; ++r) { const int n = crow(r, hi); partL[(w * 32 + n) * 64 + r32] = acc[0][r]; partL[(w * 32 + n) * 64 + 32 + r32] = acc[1][r]; }
    __syncthreads();
    LAS float* hidL = (LAS float*)(lds + L_SLAB);
    LAS float* w2L = (LAS float*)(lds + L_SLAB + 8448);
    { const f32x4 wa = ((const f32x4*)w2)[tid], wb = ((const f32x4*)w2)[tid + 512]; *(LAS f32x4*)(w2L + tid * 4) = wa; *(LAS f32x4*)(w2L + (tid + 512) * 4) = wb; }
#pragma unroll
    for (int i = 0; i < 4; ++i) { const int idx = tid + 512 * i, n = idx >> 6, e = idx & 63; float s = 0.f;
#pragma unroll
        for (int ww = 0; ww < 8; ++ww) s += partL[(ww * 32 + n) * 64 + e];
        const float pt = ((ptg[e] + ptg[64 + e]) + (ptg[128 + e] + ptg[192 + e])) + ((ptg[256 + e] + ptg[320 + e]) + (ptg[384 + e] + ptg[448 + e]));
        hidL[n * 65 + e] = gelu_tanh(s + pt); }
    __syncthreads();
    { const int n = tid >> 4, e2 = (tid & 15) * 4; float o0 = 0.f, o1 = 0.f, o2 = 0.f, o3 = 0.f;
#pragma unroll 8
      for (int e = 0; e < 64; ++e) { const float hval = hidL[n * 65 + e]; const f32x4 wv = *(const LAS f32x4*)(w2L + e * 64 + e2);
          o0 += hval * wv.x; o1 += hval * wv.y; o2 += hval * wv.z; o3 += hval * wv.w; }
      u32x2 ov; ov.x = pk2(o0, o1); ov.y = pk2(o2, o3);
      if (32 * nt + n >= 127) { ov.x = 0u; ov.y = 0u; }
      *(u32x2*)(outp + (size_t)n * 64 + e2) = ov; }
    __syncthreads();
}

__device__ __forceinline__ void gmlp_unit(const Params& p, LAS unsigned char* lds8, int b, int ch) {
    LAS char* lds = (LAS char*)lds8;
    const int tid = opaque_tid(), lane = tid & 63, w = __builtin_amdgcn_readfirstlane(tid >> 6), r32 = lane & 31, hi = lane >> 5;
    const bf16_t* H1 = (const bf16_t*)(p.ws + WS_H);
    bf16_t* MIX = (bf16_t*)(p.ws + WS_MIX);
    const bf16_t* TR = (const bf16_t*)(p.ws + WS_TRIL);
    constexpr int VS = 1040;
    const size_t row0 = (size_t)b * SEQ + 128 * ch;
    {
        const f32x4 g0 = ((const f32x4*)p.in[14])[lane * 2], g1 = ((const f32x4*)p.in[14])[lane * 2 + 1];
        const f32x4 b0 = ((const f32x4*)p.in[15])[lane * 2], b1 = ((const f32x4*)p.in[15])[lane * 2 + 1];
        for (int tq0 = w; tq0 < 128; tq0 += 64) {
            u32x4 raw4[8];
#pragma unroll
            for (int i = 0; i < 8; ++i) raw4[i] = *(const u32x4*)(H1 + (row0 + tq0 + 8 * i) * HW + 1792 + lane * 8);
#pragma unroll
            for (int i = 0; i < 8; ++i) { const int tq = tq0 + 8 * i; const u32x4 raw = raw4[i];
            f32x4 v0, v1;
            v0.x = gelu_tanh(bflo(raw.x)); v0.y = gelu_tanh(bfhi(raw.x)); v0.z = gelu_tanh(bflo(raw.y)); v0.w = gelu_tanh(bfhi(raw.y));
            v1.x = gelu_tanh(bflo(raw.z)); v1.y = gelu_tanh(bfhi(raw.z)); v1.z = gelu_tanh(bflo(raw.w)); v1.w = gelu_tanh(bfhi(raw.w));
            const float mean = wave_sum((v0.x + v0.y) + (v0.z + v0.w) + (v1.x + v1.y) + (v1.z + v1.w)) * (1.f / 512.f);
            v0 = v0 - mean; v1 = v1 - mean;
            const float var = wave_sum((v0.x * v0.x + v0.y * v0.y) + (v0.z * v0.z + v0.w * v0.w) + (v1.x * v1.x + v1.y * v1.y) + (v1.z * v1.z + v1.w * v1.w)) * (1.f / 512.f);
            const float rstd = rsqrtf(var + LN_EPS);
            v0 = v0 * rstd * g0 + b0; v1 = v1 * rstd * g1 + b1;
            u32x4 o; o.x = pk2(v0.x, v0.y); o.y = pk2(v0.z, v0.w); o.z = pk2(v1.x, v1.y); o.w = pk2(v1.z, v1.w);
            *(LAS u32x4*)(lds + tq * VS + lane * 16) = o; }
        }
    }
    __syncthreads();
    const int gi = w >> 1, th = w & 1;
    f32x16 acc[2][4];
#pragma unroll
    for (int a = 0; a < 2; ++a)
#pragma unroll
        for (int d = 0; d < 4; ++d)
#pragma unroll
            for (int i = 0; i < 16; ++i) acc[a][d][i] = 0.f;
    const bf16_t* ap = TR + (size_t)(gi * 128 + 64 * th + r32) * 128 + 8 * hi;
    const LAS char* vp = lds + (8 * hi + ((lane & 15) >> 2)) * VS + (128 * gi + 16 * ((lane >> 4) & 1) + 4 * (lane & 3)) * 2;
    const int nks = 4 * th + 4;
    for (int ks = 0; ks < nks; ++ks) {
        const bf16x8 a0 = *(const bf16x8*)(ap + 16 * ks), a1 = *(const bf16x8*)(ap + 32 * 128 + 16 * ks);
#pragma unroll
        for (int db = 0; db < 4; ++db) {
            const s16x4 lo = vtr(vp + (16 * ks) * VS + db * 64), hi4 = vtr(vp + (16 * ks + 4) * VS + db * 64);
            const bf16x8 vb = (bf16x8){lo[0], lo[1], lo[2], lo[3], hi4[0], hi4[1], hi4[2], hi4[3]};
            acc[0][db] = MFMA32(a0, vb, acc[0][db]); acc[1][db] = MFMA32(a1, vb, acc[1][db]);
        }
    }
    __syncthreads();
    {
        const float* bs = p.in[17] + gi * 128;
        LAS float* st = (LAS float*)(lds + w * 16896);
        const int rrow = lane >> 4, c8 = (lane & 15) * 8;
#pragma unroll
        for (int tb = 0; tb < 2; ++tb) {
#pragma unroll
            for (int r = 0; r < 16; ++r) { const int q = crow(r, hi); const float bias = bs[64 * th + 32 * tb + q];
#pragma unroll
                for (int db = 0; db < 4; ++db) st[q * 132 + 32 * db + r32] = acc[tb][db][r] + bias; }
            LDSW();
#pragma unroll
            for (int i = 0; i < 8; ++i) { const int row = 4 * i + rrow, tq = 64 * th + 32 * tb + row;
                const f32x4 m0 = *(const LAS f32x4*)(st + row * 132 + c8), m1 = *(const LAS f32x4*)(st + row * 132 + c8 + 4);
                const u32x4 uu = *(const u32x4*)(H1 + (row0 + tq) * HW + 1280 + 128 * gi + c8);
                u32x4 o; o.x = pk2(gelu_tanh(bflo(uu.x)) * m0.x, gelu_tanh(bfhi(uu.x)) * m0.y); o.y = pk2(gelu_tanh(bflo(uu.y)) * m0.z, gelu_tanh(bfhi(uu.y)) * m0.w);
                o.z = pk2(gelu_tanh(bflo(uu.z)) * m1.x, gelu_tanh(bfhi(uu.z)) * m1.y); o.w = pk2(gelu_tanh(bflo(uu.w)) * m1.z, gelu_tanh(bfhi(uu.w)) * m1.w);
                *(u32x4*)(MIX + (row0 + tq) * DM + 512 + 128 * gi + c8) = o; }
            LDSW();
        }
    }
    __syncthreads();
}

template <int MODE>
__device__ __forceinline__ void nsa_tile(float& m, float& l, f32x16 (&o)[2], const LAS char* kt, const LAS char* vt, LAS float* wsf_w, const bf16x8 (&qr)[4],
                                         int j, unsigned selm, int t, int twmin, int twmax, int lane) {
    const int r32 = lane & 31, hi = lane >> 5;
    const bool selected = (MODE == 1) ? (((selm >> j) & 1u) != 0u) : true;
    if (64 * j + 63 <= twmin && (MODE == 1 || 64 * j >= twmax - 511)) {
        if (MODE == 1 && !__any(selected)) return;
        bf16x8 kf[8];
        { const LAS char* kp = kt + r32 * KS + hi * 16;
#pragma unroll
          for (int i = 0; i < 8; ++i) kf[i] = *(const LAS bf16x8*)(kp + (i >> 2) * (32 * KS) + (i & 3) * 32); }
        __builtin_amdgcn_sched_barrier(0);
        f32x16 s0, s1;
#pragma unroll
        for (int i = 0; i < 16; ++i) { s0[i] = 0.f; s1[i] = 0.f; }
#pragma unroll
        for (int d0 = 0; d0 < 4; ++d0) { s0 = MFMA32(kf[d0], qr[d0], s0); s1 = MFMA32(kf[4 + d0], qr[d0], s1); }
        s16x4 vf[16];
        { const LAS char* vp = vt + (4 * hi + ((lane & 15) >> 2)) * KS + (16 * ((lane >> 4) & 1) + 4 * (lane & 3)) * 2;
#pragma unroll
          for (int i = 0; i < 16; ++i) { const int sub = i >> 3, ss = (i >> 2) & 1, db = (i >> 1) & 1, jj = i & 1;
              vf[i] = vtr(vp + (32 * sub + 16 * ss + 8 * jj) * KS + db * 64); } }
        __builtin_amdgcn_sched_barrier(0);
        float mx = fmaxf(fmaxf(s0[0], s0[1]), fmaxf(s1[0], s1[1]));
#pragma unroll
        for (int r = 2; r < 16; r += 2) mx = fmaxf(mx, fmaxf(fmaxf(s0[r], s0[r + 1]), fmaxf(s1[r], s1[r + 1])));
        mx *= C2; mx = fmaxf(mx, xor32(mx));
        const float cand = selected ? mx : -1e30f;
        if (__any(cand > m + 8.f)) {
            const float mn = fmaxf(m, cand), f = __builtin_amdgcn_exp2f(m - mn);
            l *= f; m = mn;
            float fr[16]; bcast_rows(fr, wsf_w, f, r32, hi);
#pragma unroll
            for (int r = 0; r < 16; ++r) { o[0][r] *= fr[r]; o[1][r] *= fr[r]; }
        }
        const float nme = selected ? -m : -1e30f;
        f32x16 p0, p1; float ls0 = 0.f, ls1 = 0.f, ls2 = 0.f, ls3 = 0.f;
#pragma unroll
        for (int r = 0; r < 16; r += 2) { p0[r] = __builtin_amdgcn_exp2f(__builtin_fmaf(s0[r], C2, nme)); ls0 += p0[r]; p0[r + 1] = __builtin_amdgcn_exp2f(__builtin_fmaf(s0[r + 1], C2, nme)); ls1 += p0[r + 1];
            p1[r] = __builtin_amdgcn_exp2f(__builtin_fmaf(s1[r], C2, nme)); ls2 += p1[r]; p1[r + 1] = __builtin_amdgcn_exp2f(__builtin_fmaf(s1[r + 1], C2, nme)); ls3 += p1[r + 1]; }
        l += (ls0 + ls1) + (ls2 + ls3);
#pragma unroll
        for (int i = 0; i < 4; ++i) { const int sub = i >> 1, ss = i & 1; const f32x16& pp = sub ? p1 : p0;
            u32x4 pw; pw.x = pk2(pp[8 * ss + 0], pp[8 * ss + 1]); pw.y = pk2(pp[8 * ss + 2], pp[8 * ss + 3]); pw.z = pk2(pp[8 * ss + 4], pp[8 * ss + 5]); pw.w = pk2(pp[8 * ss + 6], pp[8 * ss + 7]);
            const bf16x8 pa = __builtin_bit_cast(bf16x8, pw);
#pragma unroll
            for (int db = 0; db < 2; ++db) { const s16x4 lo = vf[i * 4 + db * 2], h4 = vf[i * 4 + db * 2 + 1];
                const bf16x8 vb = (bf16x8){lo[0], lo[1], lo[2], lo[3], h4[0], h4[1], h4[2], h4[3]};
                o[db] = MFMA32(pa, vb, o[db]); } }
        return;
    }
#pragma unroll 1
    for (int sub = 0; sub < 2; ++sub) {
        const int kvb = 64 * j + 32 * sub;
        if (kvb > twmax) continue;
        if (MODE == 2 && kvb + 31 + 512 <= twmin) continue;
        if (MODE == 1 && !__any(selected)) continue;
        const f32x16 s = qk_sub(kt, sub, qr, r32, hi);
        const bool need_mask = (kvb + 31 > twmin) || (MODE == 2 && kvb < twmax - 511);
        f32x16 pw; float ls = 0.f;
        if (!need_mask) {
            float mx = fmaxf(fmaxf(s[0], s[1]), fmaxf(s[2], s[3]));
#pragma unroll
            for (int r = 4; r < 16; r += 4) mx = fmaxf(mx, fmaxf(fmaxf(s[r], s[r + 1]), fmaxf(s[r + 2], s[r + 3])));
            mx *= C2; mx = fmaxf(mx, xor32(mx));
            const float cand = selected ? mx : -1e30f;
            if (__any(cand > m + 8.f)) {
                const float mn = fmaxf(m, cand), f = __builtin_amdgcn_exp2f(m - mn);
                l *= f; m = mn;
                float fr[16]; bcast_rows(fr, wsf_w, f, r32, hi);
#pragma unroll
                for (int r = 0; r < 16; ++r) { o[0][r] *= fr[r]; o[1][r] *= fr[r]; }
            }
            const float nme = selected ? -m : -1e30f;
#pragma unroll
            for (int r = 0; r < 16; ++r) { pw[r] = __builtin_amdgcn_exp2f(__builtin_fmaf(s[r], C2, nme)); ls += pw[r]; }
        } else {
            float s2[16]; float mx = -1e30f;
#pragma unroll
            for (int r = 0; r < 16; ++r) { const int kv = kvb + crow(r, hi);
                const bool valid = (kv <= t) && ((MODE == 1) ? selected : (t - kv < 512));
                s2[r] = valid ? s[r] * C2 : -1e30f; mx = fmaxf(mx, s2[r]); }
            mx = fmaxf(mx, xor32(mx));
            if (__any(mx > m + 8.f)) {
                const float mn = fmaxf(m, mx), f = __builtin_amdgcn_exp2f(m - mn);
                l *= f; m = mn;
                float fr[16]; bcast_rows(fr, wsf_w, f, r32, hi);
#pragma unroll
                for (int r = 0; r < 16; ++r) { o[0][r] *= fr[r]; o[1][r] *= fr[r]; }
            }
#pragma unroll
            for (int r = 0; r < 16; ++r) { const float e = __builtin_amdgcn_exp2f(s2[r] - m); pw[r] = (s2[r] > -1e29f) ? e : 0.f; ls += pw[r]; }
        }
        l += ls;
        pv_sub(o, pw, vt, sub, lane);
    }
}
template <int MODE, bool FINAL>
__device__ __forceinline__ void nsa_branch(LAS float* accw, bf16_t* gout, LAS char* lds, const bf16_t* kg, const bf16_t* vg, unsigned todo, const bf16x8 (&qr)[4],
                                           float gate, unsigned selm, int t, int twmin, int twmax, int tid, int lane, int w) {
    const int r32 = lane & 31, hi = lane >> 5, lrow = tid >> 3, lch = tid & 7;
    LAS float* wsf_w = (LAS float*)(lds + L_WSF) + w * 32;
    float m = -1e30f, l = 0.f;
    f32x16 o[2];
#pragma unroll
    for (int i = 0; i < 16; ++i) { o[0][i] = 0.f; o[1][i] = 0.f; }
    const bf16_t* kgl = kg + (size_t)lrow * HW + lch * 8; const bf16_t* vgl = vg + (size_t)lrow * HW + lch * 8;
    LAS char* kw0 = lds + L_K + lrow * KS + lch * 16; LAS char* vw0 = lds + L_V + lrow * KS + lch * 16;
#define NSA_POP(jv) do { jv = (MODE == 1) ? __builtin_ctz(todo) : 31 - __builtin_clz(todo); todo &= ~(1u << jv); } while (0)
#define NSA_LOAD(KR, VR, jv) do { const bf16_t* kp_ = kgl + (size_t)(64 * (jv)) * HW; const bf16_t* vp_ = vgl + (size_t)(64 * (jv)) * HW; \
        asm volatile("global_load_dwordx4 %0, %2, off\n\tglobal_load_dwordx4 %1, %3, off" : "=&v"(KR), "=&v"(VR) : "v"(kp_), "v"(vp_) : "memory"); } while (0)
#define NSA_WAIT(KR, VR) asm volatile("s_waitcnt vmcnt(2)" : "+v"(KR), "+v"(VR) : : "memory")
    u32x4 kA, vA, kB, vB;
    int j0, j1, jl; bool h1;
    NSA_POP(j0); NSA_LOAD(kA, vA, j0); jl = j0;
    h1 = todo != 0u; if (h1) { NSA_POP(j1); jl = j1; } else j1 = jl;
    NSA_LOAD(kB, vB, j1);
    for (;;) {
        NSA_WAIT(kA, vA);
        *(LAS u32x4*)kw0 = kA; *(LAS u32x4*)vw0 = vA;
        __syncthreads();
        int j2; const bool h2 = h1 && todo != 0u; if (h2) { NSA_POP(j2); jl = j2; } else j2 = jl;
        NSA_LOAD(kA, vA, j2);
        nsa_tile<MODE>(m, l, o, lds + L_K, lds + L_V, wsf_w, qr, j0, selm, t, twmin, twmax, lane);
        if (!h1) break;
        NSA_WAIT(kB, vB);
        *(LAS u32x4*)(kw0 + TILEB) = kB; *(LAS u32x4*)(vw0 + TILEB) = vB;
        __syncthreads();
        int j3; const bool h3 = h2 && todo != 0u; if (h3) { NSA_POP(j3); jl = j3; } else j3 = jl;
        NSA_LOAD(kB, vB, j3);
        nsa_tile<MODE>(m, l, o, lds + L_K + TILEB, lds + L_V + TILEB, wsf_w, qr, j1, selm, t, twmin, twmax, lane);
        if (!h2) break;
        j0 = j2; j1 = j3; h1 = h3;
    }
    asm volatile("s_waitcnt vmcnt(0)" : "+v"(kA), "+v"(vA), "+v"(kB), "+v"(vB) : : "memory");
#undef NSA_POP
#undef NSA_LOAD
#undef NSA_WAIT
    __syncthreads();
    l += xor32(l);
    const float fac = (l > 0.f) ? gate / l : 0.f;
    float fr[16]; bcast_rows(fr, wsf_w, fac, r32, hi);
    if (!FINAL) {
#pragma unroll
        for (int r = 0; r < 16; ++r) { const int q = crow(r, hi); accw[q * 64 + r32] += o[0][r] * fr[r]; accw[q * 64 + 32 + r32] += o[1][r] * fr[r]; }
    } else {
#pragma unroll
        for (int r = 0; r < 16; ++r) { const int q = crow(r, hi);
            gout[(size_t)q * DM] = (bf16_t)f2bf(accw[q * 64 + r32] + o[0][r] * fr[r]); gout[(size_t)q * DM + 32] = (bf16_t)f2bf(accw[q * 64 + 32 + r32] + o[1][r] * fr[r]); }
    }
    LDSW();
}

__device__ __forceinline__ void nsa_unit(const Params& p, LAS unsigned char* lds8, int b, int g, int qb) {
    LAS char* lds = (LAS char*)lds8;
    const int tid = opaque_tid(), lane = tid & 63, w = __builtin_amdgcn_readfirstlane(tid >> 6), r32 = lane & 31, hi = lane >> 5;
    const int rh = w >> 1, tsub = w & 1;
    const bf16_t* H1 = (const bf16_t*)(p.ws + WS_H);
    bf16_t* MIX = (bf16_t*)(p.ws + WS_MIX);
    const size_t rowbase = (size_t)b * SEQ;
    const int t0 = 64 * qb, t = t0 + 32 * tsub + r32, twmin = t0 + 32 * tsub, twmax = twmin + 31;
    LAS float* wsf_w = (LAS float*)(lds + L_WSF) + w * 32;
    LAS float* impL = (LAS float*)(lds + L_IMP);
    LAS unsigned* selL = (LAS unsigned*)(lds + L_SEL);
    bf16x8 qr[4];
    float g0, g1, g2;
    { const bf16_t* qp = H1 + (rowbase + t) * HW + (g * 4 + rh) * 64;
#pragma unroll
      for (int d0 = 0; d0 < 4; ++d0) qr[d0] = *(const bf16x8*)(qp + 16 * d0 + 8 * hi);
      const bf16_t* gp = H1 + (rowbase + t) * HW + 2304 + (g * 4 + rh) * 3;
      g0 = sigmoidf_(bf2f((unsigned)gp[0])); g1 = sigmoidf_(bf2f((unsigned)gp[1])); g2 = sigmoidf_(bf2f((unsigned)gp[2])); }
    LAS float* accw = (LAS float*)(lds + L_OACC) + w * 2048;
    bf16_t* gout = MIX + (rowbase + t0 + 32 * tsub) * DM + (g * 4 + rh) * 64 + r32;
    {
        const bf16_t* kc = (const bf16_t*)(p.ws + WS_KCMP) + (size_t)(b * 2 + g) * 128 * 64;
        const bf16_t* vc = (const bf16_t*)(p.ws + WS_VCMP) + (size_t)(b * 2 + g) * 128 * 64;
#pragma unroll
        for (int i = 0; i < 2; ++i) { const int idx = tid + 512 * i, row = idx >> 3, ch = idx & 7;
            *(LAS u32x4*)(lds + L_K + row * KS + ch * 16) = *(const u32x4*)(kc + row * 64 + ch * 8);
            *(LAS u32x4*)(lds + L_V + row * KS + ch * 16) = *(const u32x4*)(vc + row * 64 + ch * 8); }
        __syncthreads();
        const int nmax = (t - 31) >> 4;
        const int nmaxw = (twmax - 31) >> 4;
        float m = -1e30f, l = 0.f;
#pragma unroll 1
        for (int sb = 0; sb < 4; ++sb) {
            if (32 * sb > nmaxw) break;
            const f32x16 s = qk_sub(lds + L_K, sb, qr, r32, hi);
            float s2[16]; float mx = m;
#pragma unroll
            for (int r = 0; r < 16; ++r) { const int n = 32 * sb + crow(r, hi); s2[r] = (n <= nmax) ? s[r] * C2 : -1e30f; mx = fmaxf(mx, s2[r]); }
            l *= __builtin_amdgcn_exp2f(m - mx); m = mx;
#pragma unroll
            for (int r = 0; r < 16; ++r) { const float e = __builtin_amdgcn_exp2f(s2[r] - m); l += (s2[r] > -1e29f) ? e : 0.f; }
        }
        { const float mt = fmaxf(m, xor32(m)); l *= __builtin_amdgcn_exp2f(m - mt); m = mt; l += xor32(l); }
        const float inv = (l > 0.f) ? 1.f / l : 0.f;
        f32x16 o[2];
#pragma unroll
        for (int i = 0; i < 16; ++i) { o[0][i] = 0.f; o[1][i] = 0.f; }
        LAS float* ip = impL + ((rh * 64) + 32 * tsub + r32) * 33 + hi; float lprev = 0.f;
#pragma unroll 1
        for (int sb = 0; sb < 4; ++sb) {
            if (32 * sb > nmaxw) {
#pragma unroll
                for (int gq = 0; gq < 4; ++gq) ip[2 * (4 * sb + gq)] = (hi == 0 && gq == 0) ? lprev : 0.f;
                lprev = 0.f; continue; }
            const f32x16 s = qk_sub(lds + L_K, sb, qr, r32, hi);
            f32x16 pw;
#pragma unroll
            for (int r = 0; r < 16; ++r) { const int n = 32 * sb + crow(r, hi); const float e = __builtin_amdgcn_exp2f(s[r] * C2 - m) * inv; pw[r] = (n <= nmax) ? e : 0.f; }
#pragma unroll
            for (int gq = 0; gq < 4; ++gq) {
                const float Gv = (pw[4 * gq] + pw[4 * gq + 1]) + (pw[4 * gq + 2] + pw[4 * gq + 3]);
                const float lcur = xor32(pw[4 * gq + 3]);
                ip[2 * (4 * sb + gq)] = Gv + (hi ? lcur : lprev); lprev = lcur; }
            pv_sub(o, pw, lds + L_V, sb, lane);
        }
        float fr[16]; bcast_rows(fr, wsf_w, g0, r32, hi);
#pragma unroll
        for (int r = 0; r < 16; ++r) { const int q = crow(r, hi); accw[q * 64 + r32] = o[0][r] * fr[r]; accw[q * 64 + 32 + r32] = o[1][r] * fr[r]; }
    }
    __syncthreads();
#ifndef XTOPK
    { const int tok = tid >> 3, j0 = (tid & 7) * 4;
#pragma unroll
      for (int jj = 0; jj < 4; ++jj) { LAS float* q0 = impL + tok * 33 + j0 + jj; q0[0] = ((q0[0] + q0[64 * 33]) + q0[2 * 64 * 33]) + q0[3 * 64 * 33]; } }
    __syncthreads();
    if (w == 0) {
        float sc[32];
#pragma unroll
        for (int jj = 0; jj < 32; ++jj) { const float v = impL[lane * 33 + jj];
            const bool forced = (jj == 0) || (jj == qb) || (jj == qb - 1);
            sc[jj] = (jj <= qb) ? v + (forced ? 1000.f : 0.f) : -1e30f; }
        unsigned mask = 0u;
        if (qb < 8) mask = (2u << qb) - 1u;
        else {
#pragma unroll 1
            for (int k = 0; k < 8; ++k) { float best = -3e38f; int bj = 0;
#pragma unroll
                for (int jj = 0; jj < 32; ++jj) { const float v = ((mask >> jj) & 1u) ? -3e38f : sc[jj]; if (v > best) { best = v; bj = jj; } }
                mask |= 1u << bj; }
        }
        selL[lane] = mask;
        unsigned un = mask;
#pragma unroll
        for (int o = 1; o < 64; o <<= 1) un |= (unsigned)__shfl_xor((int)un, o);
        if (lane == 0) selL[64] = un;
    }
#endif
    __syncthreads();
    const unsigned selm = selL[32 * tsub + r32], uni = selL[64];
#ifndef XSEL
    { const unsigned vmask = (qb >= 31) ? 0xffffffffu : ((2u << qb) - 1u);
      nsa_branch<1, false>(accw, gout, lds, H1 + rowbase * HW + 768 + g * 64, H1 + rowbase * HW + 896 + g * 64, (uni & vmask) | 1u, qr, g1, selm, t, twmin, twmax, tid, lane, w);
#ifdef PROBE_SEL
      nsa_branch<1, false>(accw, gout, lds, H1 + rowbase * HW + 768 + g * 64, H1 + rowbase * HW + 896 + g * 64, (uni & vmask) | 1u, qr, 0.f, selm, t, twmin, twmax, tid, lane, w);
#endif
    }
#endif
#ifndef XWIN
    { const int lo = qb > 8 ? qb - 8 : 0; const unsigned vmask = (qb >= 31) ? 0xffffffffu : ((2u << qb) - 1u); const unsigned todo = vmask & ~((1u << lo) - 1u);
#ifdef PROBE_WIN
      nsa_branch<2, false>(accw, gout, lds, H1 + rowbase * HW + 1024 + g * 64, H1 + rowbase * HW + 1152 + g * 64, todo, qr, 0.f, 0u, t, twmin, twmax, tid, lane, w);
#endif
      nsa_branch<2, true>(accw, gout, lds, H1 + rowbase * HW + 1024 + g * 64, H1 + rowbase * HW + 1152 + g * 64, todo, qr, g2, 0u, t, twmin, twmax, tid, lane, w); }
#endif
}

__global__ void __launch_bounds__(512, 2) fwd_megakernel(Params p) {
    extern __shared__ __attribute__((aligned(16))) unsigned char lds_raw[];
    LAS unsigned char* lds = (LAS unsigned char*)lds_raw;
    cg::grid_group grid = cg::this_grid();
    unsigned char* ws = p.ws;
    bf16_t* XB = (bf16_t*)(ws + WS_XB); bf16_t* HB = (bf16_t*)(ws + WS_H); bf16_t* MIX = (bf16_t*)(ws + WS_MIX); bf16_t* MB = (bf16_t*)(ws + WS_MB);
    const int G = gridDim.x, bx = blockIdx.x;
    const int vcu = (G % 8 == 0) ? (bx % 8) * (G / 8) + bx / 8 : bx;
    LAS unsigned* misc = (LAS unsigned*)(lds + LDS_BYTES - 64);
    if (threadIdx.x < 16) misc[threadIdx.x] = 0u;
    __syncthreads();
    XcdBarrier bar = xcd_barrier_post((unsigned*)(ws + WS_CTL), (volatile LAS unsigned*)misc);
    if (G == 0x7fffffff) grid.sync();
#define GSYNC() do { for (int rep_ = 0; rep_ < REP_SYNC; ++rep_) xcd_barrier(bar); } while (0)
#define LSYNC() do { if (loc_ok) xcd_barrier_local(bar); else xcd_barrier(bar); } while (0)
#define QSYNC() do { if (loc_ok) quad_barrier(bar, (unsigned)((bx & 7) * 8 + ((bx >> 3) & 7))); else xcd_barrier(bar); } while (0)
    unsigned* xcctab = (unsigned*)(ws + WS_CTL) + 16384; unsigned* xccflag = (unsigned*)(ws + WS_CTL) + 20480;
    if (threadIdx.x == 0) __hip_atomic_store(&xcctab[bx], bar.x + 1u, __ATOMIC_RELAXED, __HIP_MEMORY_SCOPE_AGENT);

    for (int rep = 0; rep < REP_PRO; ++rep) p0_prologue(p, lds);
    GSYNC();
    int bad_ = (G != 256) ? 1 : 0;
    if (G == 256 && threadIdx.x < 256) { const unsigned a_ = xb_ld(&xcctab[threadIdx.x]), r_ = xb_ld(&xcctab[threadIdx.x & 7]); bad_ = (a_ != r_ || a_ == 0u) ? 1 : 0; }
    const bool loc_ok = (__syncthreads_or(bad_) == 0);
    for (int rep = 0; rep < REP_IN; ++rep) run_gemm(lds, XB, (const bf16_t*)(ws + WS_IN0), 2560, 1024, EpiStore{HB, HW});
    LSYNC();
    for (int rep = 0; rep < REP_SB; ++rep)
    for (int u = vcu; u < 1024; u += G) { const int i = u >> 8, c = u & 255, bhp = c >> 2, s = c & 3;
        const int qb = (i == 0) ? s : (i == 1) ? 7 - s : (i == 2) ? 8 + s : 15 - s;
        sb_unit(p, lds, bhp >> 2, bhp & 3, qb); }
    for (int rep = 0; rep < REP_CONV; ++rep)
    if (G == 256) { for (int i = 0; i < 4; ++i) { const int lu = (vcu & 31) + 32 * i; conv_unit(p, lds, 2 * (vcu >> 5) + (lu >> 6), lu & 63); } }
    else for (int u = bx; u < 1024; u += G) conv_unit(p, lds, u >> 6, u & 63);
    LSYNC();
    run_gemm(lds, MIX, (const bf16_t*)(ws + WS_OUT0), 1024, 1024, EpiStore{MB, DM});
    QSYNC();
    for (int rep = 0; rep < REP_LN; ++rep) ln_phase<true, false>(p.in[0], XB, MB, p.in[22], p.in[23], p.out, XB);
    QSYNC();
    for (int rep = 0; rep < REP_GU; ++rep) run_gemm(lds, XB, (const bf16_t*)(ws + WS_GU0), 2 * FF, 1024, EpiSwiglu{HB, FF});
    QSYNC();
    for (int rep = 0; rep < REP_DN; ++rep) run_gemm(lds, HB, (const bf16_t*)(ws + WS_DN0), 1024, FF, EpiStore{MB, DM});
    QSYNC();
    ln_phase<false, false>(p.in[0], XB, MB, p.in[24], p.in[25], p.out, XB);
    QSYNC();
    run_gemm(lds, XB, (const bf16_t*)(ws + WS_IN1), 2560, 1024, EpiStore{HB, HW});
    LSYNC();
    for (int u = vcu; u < 256; u += G) compress_unit(p, lds, u >> 4, (u >> 3) & 1, (u >> 2) & 1, u & 3);
    if (loc_ok && G == 256) octet_barrier(bar, (unsigned)(vcu >> 3)); else xcd_barrier(bar);
    for (int u = vcu; u < 1024; u += G) { const int i = u >> 8, c = u & 255, bg = c >> 3, s = c & 7;
        const unsigned pk = (s == 0) ? 0x1F160A01u : (s == 1) ? 0x1D1A0B00u : (s == 2) ? 0x19131102u : (s == 3) ? 0x1B180803u
                          : (s == 4) ? 0x1E0F0D04u : (s == 5) ? 0x15120E06u : (s == 6) ? 0x17140907u : 0x1C100C05u;
        const int qb = (int)((pk >> (8 * i)) & 0xffu);
        nsa_unit(p, lds, bg >> 1, bg & 1, qb); }
    for (int u = vcu; u < 256; u += G) gmlp_unit(p, lds, u >> 4, u & 15);
    LSYNC();
    run_gemm(lds, MIX, (const bf16_t*)(ws + WS_OUT1), 1024, 1024, EpiStore{MB, DM});
    QSYNC();
    ln_phase<false, false>(p.in[0], XB, MB, p.in[22] + DM, p.in[23] + DM, p.out, XB);
    QSYNC();
    run_gemm(lds, XB, (const bf16_t*)(ws + WS_GU1), 2 * FF, 1024, EpiSwiglu{HB, FF});
    QSYNC();
    run_gemm(lds, HB, (const bf16_t*)(ws + WS_DN1), 1024, FF, EpiStore{MB, DM});
    QSYNC();
    ln_phase<false, true>(p.in[0], XB, MB, p.in[24] + DM, p.in[25] + DM, p.out, XB);
}

extern "C" void kernel_launch(void* const* d_in, const int* in_sizes, int n_in, void* d_out, int out_size, void* d_ws, size_t ws_size, hipStream_t stream) {
    static int grid = 0;
    if (grid == 0) {
        if (n_in != 26 || out_size != MTOK * DM || ws_size < WS_END) { fprintf(stderr, "kernel_launch: unexpected problem shape (n_in %d, out %d, ws %zu)\n", n_in, out_size, ws_size); grid = -1; return; }
        int dev = 0, cus = 0, per_cu = 0;
        hipGetDevice(&dev); hipDeviceGetAttribute(&cus, hipDeviceAttributeMultiprocessorCount, dev);
        hipFuncSetAttribute((const void*)fwd_megakernel, hipFuncAttributeMaxDynamicSharedMemorySize, LDS_BYTES);
        hipOccupancyMaxActiveBlocksPerMultiprocessor(&per_cu, (const void*)fwd_megakernel, 512, LDS_BYTES);
        (void)hipGetLastError();
        if (per_cu < 1) { fprintf(stderr, "kernel_launch: occupancy query says %d blocks per CU\n", per_cu); per_cu = 1; }
        grid = cus;
    }
    if (grid < 0) return;
    if (hipMemsetAsync((char*)d_ws + WS_CTL, 0, CTL_BYTES, stream) != hipSuccess) { fprintf(stderr, "kernel_launch: memset failed\n"); return; }
    Params prm{};
    for (int i = 0; i < 26; ++i) prm.in[i] = (const float*)d_in[i];
    prm.out = (float*)d_out; prm.ws = (unsigned char*)d_ws;
    void* args[] = {&prm};
    hipError_t e = hipLaunchCooperativeKernel((const void*)fwd_megakernel, dim3(grid), dim3(512), args, LDS_BYTES, stream);
    if (e != hipSuccess) fprintf(stderr, "cooperative launch failed: %s (grid %d)\n", hipGetErrorString(e), grid);
}
```

```cpp
#include <hip/hip_runtime.h>
#include <hip/hip_cooperative_groups.h>
#include <cstdio>
#include <cstdint>
namespace cg = cooperative_groups;
#define LAS __attribute__((address_space(3)))
namespace pg8 {
#define PG8_LAS __attribute__((address_space(3)))
typedef unsigned short bf16_t;
typedef short bf16x8 __attribute__((ext_vector_type(8)));
typedef float f32x4 __attribute__((ext_vector_type(4)));
typedef unsigned u32x4 __attribute__((ext_vector_type(4)));
constexpr int BM = 256, BK = 64, HALF = 128, HTB = HALF * BK * 2  , STAGE_BYTES = 8 * HTB, NXCD = 8, WGM = 8;

__host__ __device__ __forceinline__ int lds_byte(int r, int c) { const int st = (r >> 4) * 2 + (c >> 5), rr = r & 15, cc = c & 31, ob = rr * 64 + cc * 2; return st * 1024 + (ob ^ (((ob >> 9) & 1) << 5)); }
__host__ __device__ __forceinline__ void stage_rc(int b, int& R, int& C) { const int st = b / 1024, sb = b % 1024, swz = sb ^ (((sb >> 9) & 1) << 5); R = (st >> 1) * 16 + swz / 64; C = (st & 1) * 32 + (swz % 64) / 2; }
__host__ __device__ __forceinline__ int perm32(int rho) { const int n = rho >> 4, i = rho & 15; return 8 * (i >> 2) + 4 * n + (i & 3); }

struct Unit { int pm, pn; };
struct Gemm { const bf16_t* A; const bf16_t* Bt; int M, N, K; };

struct StaticOrder {
    int nM, nN, nwg, G, c;
    __host__ __device__ void init(int M, int N, int G_, int c_) { nM = M / BM; nN = N / BM; nwg = nM * nN; G = G_; c = c_; }
    __host__ __device__ bool next(int i, Unit& u) const {
        const long L = (long)i * G + c; if (L >= nwg) return false;
        int wgid = (int)L; { const int q = nwg / NXCD, r = nwg % NXCD, xcd = wgid % NXCD, off = wgid / NXCD; wgid = (xcd < r ? xcd * (q + 1) : r * (q + 1) + (xcd - r) * q) + off; }
        const int nig = WGM * nN, gid = wgid / nig, fm = gid * WGM, gsz = (nM - fm) < WGM ? (nM - fm) : WGM;
        u.pm = fm + ((wgid % nig) % gsz); u.pn = (wgid % nig) / gsz; return true;
    }
    __device__ __forceinline__ void a_ready(const Unit&) const {}
    __device__ __forceinline__ void done(const Unit&) const {}
};

__device__ __forceinline__ unsigned cvt_pk_bf16(float lo, float hi) { unsigned r; asm volatile("v_cvt_pk_bf16_f32 %0, %1, %2" : "=v"(r) : "v"(lo), "v"(hi)); return r; }
typedef float f32x2 __attribute__((ext_vector_type(2)));
__device__ __forceinline__ f32x2 gelu_pk(f32x2 v) {
    const f32x2 av = __builtin_elementwise_abs(v), d = av * 0.2316418882f + 1.0f;
    f32x2 t; t.x = __builtin_amdgcn_rcpf(d.x); t.y = __builtin_amdgcn_rcpf(d.y);
    f32x2 q = t * 0.5307027145f + (-0.7265760135f); q = q * t + 0.7107068705f; q = q * t + (-0.142248368f); q = q * t + 0.127414796f; q = q * t;
    const f32x2 s = (v * v) * (-0.72134752044f);
    f32x2 e; e.x = __builtin_amdgcn_exp2f(s.x); e.y = __builtin_amdgcn_exp2f(s.y);
    const f32x2 m = v * (q * e), r = v - m;
    f32x2 o; o.x = v.x < 0.f ? m.x : r.x; o.y = v.y < 0.f ? m.y : r.y; return o;
}

template <int ACT  > struct EpiBf16 {
    static constexpr bool PERM = true, AFTER_DRAIN = false; static_assert(ACT == 0 || ACT == 1, "EpiBf16: ACT is 0 (none) or 1 (gelu_pk)");
    bf16_t* O; int ldc; const float* bias; int split_cols; size_t split_stride; float scale0;
    __device__ __forceinline__ void operator()(const f32x4 (&acc)[2][2][4][2], const Unit& u, int wr, int wc, int fr, int fq) const {
        const int row0 = u.pm * BM + wr * 64 + fr; int colt = u.pn * BM; bf16_t* base = O;
        float sc = 1.f; if (split_cols) { const int t = colt / split_cols; base += (size_t)t * split_stride; colt -= t * split_cols; if (t == 0) sc = scale0; }
        const int col0 = colt + wc * 32 + 8 * fq, bcol0 = u.pn * BM + wc * 32 + 8 * fq;
        f32x4 bv[2][2];
#pragma unroll
        for (int bj = 0; bj < 2; ++bj)
#pragma unroll
            for (int n = 0; n < 2; ++n) bv[bj][n] = bias ? *(const f32x4*)(bias + bcol0 + bj * HALF + 4 * n) : (f32x4){0.f, 0.f, 0.f, 0.f};
#pragma unroll
        for (int ai = 0; ai < 2; ++ai)
#pragma unroll
            for (int m = 0; m < 4; ++m) { bf16_t* rowp = base + (size_t)(row0 + ai * HALF + m * 16) * ldc + col0;
#pragma unroll
                for (int bj = 0; bj < 2; ++bj) { f32x4 v0 = acc[ai][bj][m][0] + bv[bj][0], v1 = acc[ai][bj][m][1] + bv[bj][1];
                    if (ACT == 1) { f32x2 a = gelu_pk((f32x2){v0[0], v0[1]}), b = gelu_pk((f32x2){v0[2], v0[3]}), c = gelu_pk((f32x2){v1[0], v1[1]}), d = gelu_pk((f32x2){v1[2], v1[3]});
                        v0 = (f32x4){a.x, a.y, b.x, b.y}; v1 = (f32x4){c.x, c.y, d.x, d.y}; }
                    v0 = v0 * sc; v1 = v1 * sc; u32x4 w; w.x = cvt_pk_bf16(v0[0], v0[1]); w.y = cvt_pk_bf16(v0[2], v0[3]); w.z = cvt_pk_bf16(v1[0], v1[1]); w.w = cvt_pk_bf16(v1[2], v1[3]);
                    *(u32x4*)(rowp + bj * HALF) = w; } }
    }
};

struct PanelStats {
    unsigned* xbuf;
    unsigned* cnt;
    unsigned* tmo;
    int ntn; float eps;
    unsigned code;
    __device__ __forceinline__ bool run(const f32x4 (&v)[2][2][4][2], const Unit& u, int wr, int wc, int fr, int fq, PG8_LAS unsigned char* lds, int wid, int lane) const {
        typedef float f32x2v __attribute__((ext_vector_type(2)));
        PG8_LAS f32x2v* P = (PG8_LAS f32x2v*)lds;
        PG8_LAS f32x2v* S = (PG8_LAS f32x2v*)(lds + 8192);
        PG8_LAS unsigned* flag = (PG8_LAS unsigned*)(lds + 8192 + 2048);
#pragma unroll
        for (int ai = 0; ai < 2; ++ai)
#pragma unroll
            for (int m = 0; m < 4; ++m) {
                float s = 0.f;
#pragma unroll
                for (int bj = 0; bj < 2; ++bj)
#pragma unroll
                    for (int n = 0; n < 2; ++n) { const f32x4 x = v[ai][bj][m][n]; s += (x[0] + x[1]) + (x[2] + x[3]); }
                s += __shfl_xor(s, 16); s += __shfl_xor(s, 32);
                const float mw = s * (1.0f / 64.0f); float q = 0.f;
#pragma unroll
                for (int bj = 0; bj < 2; ++bj)
#pragma unroll
                    for (int n = 0; n < 2; ++n) { const f32x4 d = v[ai][bj][m][n] - mw; q += (d[0] * d[0] + d[1] * d[1]) + (d[2] * d[2] + d[3] * d[3]); }
                q += __shfl_xor(q, 16); q += __shfl_xor(q, 32);
                if (fq == 0) P[(ai * HALF + wr * 64 + m * 16 + fr) * 4 + wc] = (f32x2v){mw, q};
            }
        asm volatile("s_waitcnt lgkmcnt(0)" ::: "memory"); __builtin_amdgcn_s_barrier(); asm volatile("" ::: "memory");
#if defined(BROKEN_EXCHANGE_NO_WAIT)
#warning BROKEN CONTROL BUILD: the row-statistics exchange does not wait; results are wrong by design
        if (blockIdx.x >= 64) { const long long t0_ = clock64(); while (clock64() - t0_ < 60000) __builtin_amdgcn_s_sleep(8); }
#endif
        const int row = wid * 32 + (lane & 31);
        if (lane < 32) {
            const f32x2v a = P[row * 4 + 0], b = P[row * 4 + 1], c = P[row * 4 + 2], d = P[row * 4 + 3];
            const float mt = (a.x + b.x + c.x + d.x) * 0.25f;
            const float da = a.x - mt, db = b.x - mt, dc = c.x - mt, dd = d.x - mt;
            const float m2 = (a.y + b.y) + (c.y + d.y) + 64.0f * ((da * da + db * db) + (dc * dc + dd * dd));
            unsigned long long* slot = (unsigned long long*)xbuf + ((size_t)(u.pm * BM + row) * 4 + u.pn);
            __hip_atomic_store(slot, ((unsigned long long)__float_as_uint(m2) << 32) | __float_as_uint(mt), __ATOMIC_RELAXED, __HIP_MEMORY_SCOPE_AGENT);
        }
        asm volatile("s_waitcnt vmcnt(0)" ::: "memory");
        if (lane == 0) __hip_atomic_fetch_add(cnt + 64 * u.pm, 1u, __ATOMIC_RELAXED, __HIP_MEMORY_SCOPE_AGENT);
        if (wid == 0) {
            bool dead = false; const unsigned long long t0 = __builtin_amdgcn_s_memrealtime(); const unsigned want = 8u * (unsigned)ntn;
            for (;;) {
#if defined(BROKEN_EXCHANGE_NO_WAIT)
                break;
#endif
                if ((unsigned)__builtin_amdgcn_readfirstlane(__hip_atomic_load(cnt + 64 * u.pm, __ATOMIC_RELAXED, __HIP_MEMORY_SCOPE_AGENT)) >= want) break;
                if (__builtin_amdgcn_s_memrealtime() - t0 > 2000000ull) {
                    if (lane == 0) { unsigned expect = 0u; __hip_atomic_compare_exchange_strong(tmo + 1, &expect, code | (unsigned)(u.pm & 0xff), __ATOMIC_RELAXED, __ATOMIC_RELAXED, __HIP_MEMORY_SCOPE_AGENT);
                                     __hip_atomic_store(tmo, 1u, __ATOMIC_RELAXED, __HIP_MEMORY_SCOPE_AGENT); }
                    dead = true; break; }
                __builtin_amdgcn_s_sleep(2);
            }
            __builtin_amdgcn_fence(__ATOMIC_ACQUIRE, "agent");
            if (lane == 0) flag[0] = dead ? 1u : 0u;
        }
        asm volatile("s_waitcnt vmcnt(0) lgkmcnt(0)" ::: "memory"); __builtin_amdgcn_s_barrier(); asm volatile("" ::: "memory");
        const bool bad = flag[0] != 0u;
        if (lane < 32) {
            const unsigned long long* slot = (const unsigned long long*)xbuf + (size_t)(u.pm * BM + row) * 4; float mt[4], m2[4]; float ms = 0.f;
#pragma unroll
            for (int t = 0; t < 4; ++t) { if (t < ntn) { const unsigned long long w = __hip_atomic_load(slot + t, __ATOMIC_RELAXED, __HIP_MEMORY_SCOPE_AGENT); mt[t] = __uint_as_float((unsigned)w); m2[t] = __uint_as_float((unsigned)(w >> 32)); } else { mt[t] = 0.f; m2[t] = 0.f; } ms += mt[t]; }
            const float mean = ms / (float)ntn; float q = 0.f;
#pragma unroll
            for (int t = 0; t < 4; ++t) if (t < ntn) { const float dm = mt[t] - mean; q += m2[t] + 256.0f * dm * dm; }
            S[row] = (f32x2v){mean, 1.0f / sqrtf(q / (256.0f * (float)ntn) + eps)};
        }
        asm volatile("s_waitcnt lgkmcnt(0)" ::: "memory"); __builtin_amdgcn_s_barrier(); asm volatile("" ::: "memory");
        return bad;
    }
};
struct EpiLnRes {
    static constexpr bool PERM = false, AFTER_DRAIN = true;
    const float* base; float* out; int ldc; const float* bias; PanelStats st; unsigned poison;
    __device__ __forceinline__ void fused(f32x4 (&acc)[2][2][4][2], const Unit& u, int wr, int wc, int fr, int fq, PG8_LAS unsigned char* lds, int wid, int lane) const {
        typedef float f32x2v __attribute__((ext_vector_type(2)));
        const PG8_LAS f32x2v* S = (const PG8_LAS f32x2v*)(lds + 8192);
        const int col0 = u.pn * BM + wc * 32 + 4 * fq;
#pragma unroll
        for (int bj = 0; bj < 2; ++bj)
#pragma unroll
            for (int n = 0; n < 2; ++n) { const f32x4 bv = bias ? *(const f32x4*)(bias + col0 + bj * HALF + n * 16) : (f32x4){0.f, 0.f, 0.f, 0.f};
#pragma unroll
                for (int ai = 0; ai < 2; ++ai)
#pragma unroll
                    for (int m = 0; m < 4; ++m) acc[ai][bj][m][n] += bv; }
        f32x4 pre[4][2][2];
#pragma unroll
        for (int m = 0; m < 4; ++m) { const size_t off = (size_t)(u.pm * BM + wr * 64 + m * 16 + fr) * ldc + col0;
#pragma unroll
            for (int bj = 0; bj < 2; ++bj)
#pragma unroll
                for (int n = 0; n < 2; ++n) pre[m][bj][n] = *(const f32x4*)(base + off + bj * HALF + n * 16); }
        const bool bad = st.run(acc, u, wr, wc, fr, fq, lds, wid, lane) || poison != 0u;
        const float qnan = __builtin_nanf("");
#pragma unroll
        for (int ai = 0; ai < 2; ++ai)
#pragma unroll
            for (int m = 0; m < 4; ++m) { const int r = ai * HALF + wr * 64 + m * 16 + fr; const f32x2v sr = S[r]; const size_t off = (size_t)(u.pm * BM + r) * ldc + col0;
#pragma unroll
                for (int bj = 0; bj < 2; ++bj)
#pragma unroll
                    for (int n = 0; n < 2; ++n) { const f32x4 bs = ai == 0 ? pre[m][bj][n] : *(const f32x4*)(base + off + bj * HALF + n * 16); f32x4 o = bs + (acc[ai][bj][m][n] - sr.x) * sr.y;
                        if (bad) o = (f32x4){qnan, qnan, qnan, qnan}; *(f32x4*)(out + off + bj * HALF + n * 16) = o; }
                if (m & 1) asm volatile("" ::: "memory"); }
    }
};
struct EpiLnResLn {
    static constexpr bool PERM = false, AFTER_DRAIN = true;
    const float* base; float* out; bf16_t* xn; int ldc; const float* bias; PanelStats st1, st2; unsigned poison;
    __device__ __forceinline__ void fused(f32x4 (&acc)[2][2][4][2], const Unit& u, int wr, int wc, int fr, int fq, PG8_LAS unsigned char* lds, int wid, int lane) const {
        typedef float f32x2v __attribute__((ext_vector_type(2))); typedef unsigned u32x2v __attribute__((ext_vector_type(2)));
        const PG8_LAS f32x2v* S = (const PG8_LAS f32x2v*)(lds + 8192);
        const int col0 = u.pn * BM + wc * 32 + 4 * fq;
#pragma unroll
        for (int bj = 0; bj < 2; ++bj)
#pragma unroll
            for (int n = 0; n < 2; ++n) { const f32x4 bv = bias ? *(const f32x4*)(bias + col0 + bj * HALF + n * 16) : (f32x4){0.f, 0.f, 0.f, 0.f};
#pragma unroll
                for (int ai = 0; ai < 2; ++ai)
#pragma unroll
                    for (int m = 0; m < 4; ++m) acc[ai][bj][m][n] += bv; }
        bool bad = st1.run(acc, u, wr, wc, fr, fq, lds, wid, lane) || poison != 0u;
        const float qnan = __builtin_nanf("");
#pragma unroll
        for (int ai = 0; ai < 2; ++ai)
#pragma unroll
            for (int m = 0; m < 4; ++m) { const int r = ai * HALF + wr * 64 + m * 16 + fr; const f32x2v sr = S[r]; const size_t off = (size_t)(u.pm * BM + r) * ldc + col0;
#pragma unroll
                for (int bj = 0; bj < 2; ++bj)
#pragma unroll
                    for (int n = 0; n < 2; ++n) { const f32x4 bs = *(const f32x4*)(base + off + bj * HALF + n * 16); acc[ai][bj][m][n] = bs + (acc[ai][bj][m][n] - sr.x) * sr.y; }
                asm volatile("" : "+v"(acc[ai][0][m][0]), "+v"(acc[ai][0][m][1]), "+v"(acc[ai][1][m][0]), "+v"(acc[ai][1][m][1]));
                if (m & 1) asm volatile("" ::: "memory"); }
        const bool bad1 = bad;
        bad = st2.run(acc, u, wr, wc, fr, fq, lds, wid, lane) || bad;
#pragma unroll
        for (int ai = 0; ai < 2; ++ai)
#pragma unroll
            for (int m = 0; m < 4; ++m) { const int r = ai * HALF + wr * 64 + m * 16 + fr; const f32x2v sr = S[r]; const size_t off = (size_t)(u.pm * BM + r) * ldc + col0;
#pragma unroll
                for (int bj = 0; bj < 2; ++bj)
#pragma unroll
                    for (int n = 0; n < 2; ++n) { const f32x4 x1 = acc[ai][bj][m][n]; *(f32x4*)(out + off + bj * HALF + n * 16) = bad1 ? (f32x4){qnan, qnan, qnan, qnan} : x1;
                        const f32x4 o = (x1 - sr.x) * sr.y; u32x2v w; w.x = cvt_pk_bf16(o[0], o[1]); w.y = cvt_pk_bf16(o[2], o[3]);
                        if (bad) { w.x = 0x7fc07fc0u; w.y = 0x7fc07fc0u; } *(u32x2v*)(xn + off + bj * HALF + n * 16) = w; }
                asm volatile("" ::: "memory"); }
    }
};

template <class Epi, class Sched, bool ALIGN_EPI = false, bool SP2 = false>
__device__ __forceinline__ void gemm_phase(PG8_LAS unsigned char* lds, const Gemm g, const Sched& S, const Epi& E) {
    int tid_ = threadIdx.x; asm volatile("" : "+v"(tid_)); const int tid = tid_, wid = __builtin_amdgcn_readfirstlane(tid >> 6), lane = tid & 63, wr = wid >> 2, wc = wid & 3, fr = lane & 15, fq = lane >> 4;
    const int K = g.K, nt = K / BK;
    unsigned voffA[2], voffB[2];
#pragma unroll
    for (int i = 0; i < 2; ++i) { int R, C; stage_rc(tid * 16 + i * 8192, R, C); const int Rb = Epi::PERM ? ((R & ~31) + perm32(R & 31)) : R;
        voffA[i] = (unsigned)(R * K + C) * 2u; voffB[i] = (unsigned)(Rb * K + C) * 2u; }
    const size_t kstep = (size_t)(BK * 2);
    const size_t hstep = (size_t)HALF * K * 2;
    const size_t tstep = 2 * hstep;
    const unsigned ldsw = (unsigned)wid * 1024u;
    const int aoff = lds_byte(wr * 64 + fr, fq * 8), boff = lds_byte(wc * 32 + fr, fq * 8);
#define PG8_SA(b, h) (((b) * 2 + (h)) * HTB)
#define PG8_SB(b, h) ((4 + (b) * 2 + (h)) * HTB)
#define PG8_STAGE(bufoff, gbase, voff) do { _Pragma("unroll") for (int _i = 0; _i < 2; ++_i) \
        __builtin_amdgcn_global_load_lds((const unsigned*)((const char*)(gbase) + (voff)[_i]), (PG8_LAS unsigned*)(lds + (bufoff) + ldsw + _i * 8192), 16, 0, 0); } while (0)
#define PG8_LDA(dst, b, h) do { _Pragma("unroll") for (int m = 0; m < 4; ++m) _Pragma("unroll") for (int k = 0; k < 2; ++k) dst[m][k] = *(const PG8_LAS bf16x8*)(lds + PG8_SA(b, h) + aoff + m * 2048 + k * 1024); } while (0)
#define PG8_LDB(dst, b, h) do { _Pragma("unroll") for (int n = 0; n < 2; ++n) _Pragma("unroll") for (int k = 0; k < 2; ++k) dst[n][k] = *(const PG8_LAS bf16x8*)(lds + PG8_SB(b, h) + boff + n * 2048 + k * 1024); } while (0)
#define PG8_MMA(ai, bj, At, Bt) do { __builtin_amdgcn_s_setprio(1); _Pragma("unroll") for (int m = 0; m < 4; ++m) _Pragma("unroll") for (int n = 0; n < 2; ++n) _Pragma("unroll") for (int k = 0; k < 2; ++k) \
        acc[ai][bj][m][n] = __builtin_amdgcn_mfma_f32_16x16x32_bf16(Bt[n][k], At[m][k], acc[ai][bj][m][n], 0, 0, 0); __builtin_amdgcn_s_setprio(0); } while (0)
#define PG8_WAIT_V(n) asm volatile("s_waitcnt vmcnt(" #n ")" ::: "memory")
#define PG8_WAIT_L(n) asm volatile("s_waitcnt lgkmcnt(" #n ")" ::: "memory")
#define PG8_BAR __builtin_amdgcn_s_barrier()
#define PG8_SCHED __builtin_amdgcn_sched_barrier(0)
    Unit cur, nxt; int ui = 0;
    if (!S.next(0, cur)) return;
    f32x4 acc[2][2][4][2];
#pragma unroll
    for (int a = 0; a < 2; ++a)
#pragma unroll
        for (int b = 0; b < 2; ++b)
#pragma unroll
            for (int m = 0; m < 4; ++m)
#pragma unroll
                for (int n = 0; n < 2; ++n) acc[a][b][m][n] = (f32x4){0.f, 0.f, 0.f, 0.f};
    bf16x8 At[4][2], B0[2][2], B1[2][2];
    const char* cA = (const char*)g.A + (size_t)cur.pm * tstep; const char* cB = (const char*)g.Bt + (size_t)cur.pn * tstep;
    S.a_ready(cur);
    if constexpr (SP2) {
        PG8_STAGE(PG8_SB(0, 0), cB, voffB); PG8_STAGE(PG8_SB(0, 1), cB + hstep, voffB); PG8_STAGE(PG8_SA(0, 0), cA, voffA); PG8_STAGE(PG8_SA(0, 1), cA + hstep, voffA);
        if (wr == 1) PG8_BAR;
        PG8_WAIT_V(2); PG8_BAR;
        PG8_STAGE(PG8_SB(1, 0), cB + kstep, voffB); PG8_STAGE(PG8_SA(1, 0), cA + kstep, voffA); PG8_STAGE(PG8_SB(1, 1), cB + hstep + kstep, voffB);
        PG8_WAIT_V(6); PG8_BAR;
    } else {
        PG8_STAGE(PG8_SB(0, 0), cB, voffB); PG8_STAGE(PG8_SA(0, 0), cA, voffA); PG8_STAGE(PG8_SB(0, 1), cB + hstep, voffB); PG8_STAGE(PG8_SA(0, 1), cA + hstep, voffA);
        if (wr == 1) PG8_BAR;
        PG8_WAIT_V(4); PG8_BAR;
        PG8_STAGE(PG8_SB(1, 0), cB + kstep, voffB); PG8_STAGE(PG8_SA(1, 0), cA + kstep, voffA); PG8_STAGE(PG8_SB(1, 1), cB + hstep + kstep, voffB);
        PG8_WAIT_V(6); PG8_BAR;
    }
    for (;;) {
        const bool has_next = S.next(ui + 1, nxt);
        const char* nA = has_next ? (const char*)g.A + (size_t)nxt.pm * tstep : cA; const char* nB = has_next ? (const char*)g.Bt + (size_t)nxt.pn * tstep : cB;
        for (int t = 0; t < nt; t += 2) {
            const bool last = (t == nt - 2);
            const char* a1 = cA + (size_t)(t + 1) * kstep;
            const char* a2 = last ? nA : cA + (size_t)(t + 2) * kstep; const char* b2 = last ? nB : cB + (size_t)(t + 2) * kstep;
            const char* a3 = a2 + kstep; const char* b3 = b2 + kstep;
            if (last && has_next) S.a_ready(nxt);
            if constexpr (SP2) {
            PG8_LDB(B0, 0, 0); PG8_LDB(B1, 0, 1); PG8_SCHED; PG8_LDA(At, 0, 0); PG8_STAGE(PG8_SA(1, 1), a1 + hstep, voffA);
            PG8_WAIT_V(8); PG8_WAIT_L(0); PG8_BAR; PG8_MMA(0, 0, At, B0); PG8_MMA(0, 1, At, B1); PG8_BAR; PG8_SCHED;
            PG8_LDA(At, 0, 1); PG8_STAGE(PG8_SB(0, 0), b2, voffB); PG8_STAGE(PG8_SB(0, 1), b2 + hstep, voffB); PG8_STAGE(PG8_SA(0, 0), a2, voffA);
            PG8_WAIT_V(8); PG8_WAIT_L(0); PG8_BAR; PG8_MMA(1, 0, At, B0); PG8_MMA(1, 1, At, B1); PG8_BAR; PG8_SCHED;
            PG8_LDB(B0, 1, 0); PG8_LDB(B1, 1, 1); PG8_SCHED; PG8_LDA(At, 1, 0); PG8_STAGE(PG8_SA(0, 1), a2 + hstep, voffA);
            PG8_WAIT_V(8); PG8_WAIT_L(0); PG8_BAR; PG8_MMA(0, 0, At, B0); PG8_MMA(0, 1, At, B1); PG8_BAR; PG8_SCHED;
            PG8_LDA(At, 1, 1); PG8_STAGE(PG8_SB(1, 0), b3, voffB); PG8_STAGE(PG8_SB(1, 1), b3 + hstep, voffB); PG8_STAGE(PG8_SA(1, 0), a3, voffA);
            PG8_WAIT_V(8); PG8_WAIT_L(0); PG8_BAR; PG8_MMA(1, 0, At, B0); PG8_MMA(1, 1, At, B1); PG8_BAR; PG8_SCHED;
            } else {
            PG8_LDB(B0, 0, 0); PG8_SCHED; PG8_LDA(At, 0, 0); PG8_STAGE(PG8_SA(1, 1), a1 + hstep, voffA);
            PG8_WAIT_L(8); PG8_BAR; PG8_WAIT_L(0); PG8_MMA(0, 0, At, B0); PG8_BAR; PG8_SCHED;
            PG8_LDB(B1, 0, 1); PG8_STAGE(PG8_SB(0, 0), b2, voffB);
            PG8_BAR; PG8_WAIT_L(0); PG8_MMA(0, 1, At, B1); PG8_BAR;
            PG8_LDA(At, 0, 1); PG8_STAGE(PG8_SA(0, 0), a2, voffA);
            PG8_BAR; PG8_WAIT_L(0); PG8_MMA(1, 0, At, B0); PG8_BAR; PG8_SCHED;
            PG8_STAGE(PG8_SB(0, 1), b2 + hstep, voffB);
            PG8_WAIT_V(6); PG8_BAR; PG8_MMA(1, 1, At, B1); PG8_BAR;
            PG8_LDB(B0, 1, 0); PG8_SCHED; PG8_LDA(At, 1, 0); PG8_STAGE(PG8_SA(0, 1), a2 + hstep, voffA);
            PG8_WAIT_L(8); PG8_BAR; PG8_WAIT_L(0); PG8_MMA(0, 0, At, B0); PG8_BAR; PG8_SCHED;
            PG8_LDB(B1, 1, 1); PG8_STAGE(PG8_SB(1, 0), b3, voffB);
            PG8_BAR; PG8_WAIT_L(0); PG8_MMA(0, 1, At, B1); PG8_BAR;
            PG8_LDA(At, 1, 1); PG8_STAGE(PG8_SA(1, 0), a3, voffA);
            PG8_BAR; PG8_WAIT_L(0); PG8_MMA(1, 0, At, B0); PG8_BAR; PG8_SCHED;
            PG8_STAGE(PG8_SB(1, 1), b3 + hstep, voffB);
            PG8_WAIT_V(6); PG8_BAR; PG8_MMA(1, 1, At, B1); PG8_BAR;
            }
        }
        if constexpr (ALIGN_EPI) { if (wr == 0) PG8_BAR; }
        if constexpr (!Epi::AFTER_DRAIN) { E(acc, cur, wr, wc, fr, fq); S.done(cur); }
        if (!has_next) break;
#pragma unroll
        for (int a = 0; a < 2; ++a)
#pragma unroll
            for (int b = 0; b < 2; ++b)
#pragma unroll
                for (int m = 0; m < 4; ++m)
#pragma unroll
                    for (int n = 0; n < 2; ++n) acc[a][b][m][n] = (f32x4){0.f, 0.f, 0.f, 0.f};
        cur = nxt; cA = nA; cB = nB; ++ui;
        if constexpr (ALIGN_EPI) { if (wr == 1) PG8_BAR; }
    }
    PG8_WAIT_V(0);
    if constexpr (!ALIGN_EPI) { if (wr == 0) PG8_BAR; }
    PG8_BAR;
    if constexpr (Epi::AFTER_DRAIN) { E.fused(acc, cur, wr, wc, fr, fq, lds, wid, lane); S.done(cur); }
#undef PG8_SA
#undef PG8_SB
#undef PG8_STAGE
#undef PG8_LDA
#undef PG8_LDB
#undef PG8_MMA
#undef PG8_WAIT_V
#undef PG8_WAIT_L
#undef PG8_BAR
#undef PG8_SCHED
}
}
#define XB_TMO      128
#define XB_XCNT(j)  (256  + 64 * (j))
#define XB_XSUB(j)  (1280 + 64 * (j))
#define XB_XGEN(j)  (2304 + 64 * (j))
#define XB_TOP      3328
#define XB_TOPGEN   3392
#define XCD_BAR_WORDS 3456
#define XB_SPIN_CAP (1u << 18)

__device__ __forceinline__ unsigned xb_ld(unsigned* p)              { return __hip_atomic_load(p, __ATOMIC_RELAXED, __HIP_MEMORY_SCOPE_AGENT); }
__device__ __forceinline__ unsigned xb_add(unsigned* p, unsigned v) { return __hip_atomic_fetch_add(p, v, __ATOMIC_RELAXED, __HIP_MEMORY_SCOPE_AGENT); }
__device__ __forceinline__ unsigned xb_xcc_id() { return (unsigned)__builtin_amdgcn_s_getreg((3 << 11) | 20) & 0xFu; }
#define XB_SPIN(cond, bar) do { unsigned _sp = 0; while (cond) { __builtin_amdgcn_s_sleep(1); \
    if ((++_sp & 255u) == 0u) { if (xb_ld(&(bar)[XB_TMO])) break; if (_sp > XB_SPIN_CAP) { atomicAdd(&(bar)[XB_TMO], 1u); break; } } } } while (0)

struct XcdBarrier {
    unsigned* bar; unsigned x;
    volatile LAS unsigned* st;
};

__device__ __forceinline__ XcdBarrier xcd_barrier_post(unsigned* bar, volatile LAS unsigned* st) {
    XcdBarrier b; b.bar = bar; b.x = xb_xcc_id(); b.st = st;
    if (threadIdx.x == 0) (void)xb_add(&bar[XB_XCNT(b.x)], 1u);
    return b;
}
__device__ __forceinline__ void xcd_barrier_complete(unsigned* bar, unsigned x, unsigned& nloc, unsigned& nx) {
    const unsigned G = gridDim.x * gridDim.y * gridDim.z;
    unsigned sum, cnt, mine, sp = 0u;
    for (;;) {
        sum = 0u; cnt = 0u; mine = 0u;
#pragma unroll
        for (unsigned j = 0; j < 16; ++j) { const unsigned c = xb_ld(&bar[XB_XCNT(j)]); sum += c; cnt += (c > 0u) ? 1u : 0u; mine = (j == x) ? c : mine; }
        if (sum == G) break;
        __builtin_amdgcn_s_sleep(1);
        if ((++sp & 255u) == 0u) { if (xb_ld(&bar[XB_TMO])) break; if (sp > XB_SPIN_CAP) { atomicAdd(&bar[XB_TMO], 1u); break; } }
    }
    nloc = mine > 0u ? mine : 1u; nx = cnt > 0u ? cnt : 1u;
}

__device__ __forceinline__ void xcd_barrier(const XcdBarrier& b) {
    asm volatile("s_waitcnt vmcnt(0)" ::: "memory");
    __syncthreads();
    if (threadIdx.x == 0) {
        unsigned* bar = b.bar;
        __builtin_amdgcn_s_waitcnt(0);
        unsigned nloc = b.st[0], nx = b.st[1];
        if (nloc == 0u) { xcd_barrier_complete(bar, b.x, nloc, nx); b.st[0] = nloc; b.st[1] = nx; }
        const unsigned old = xb_add(&bar[XB_XSUB(b.x)], 1u);
        const unsigned gen = old / nloc;
        if (old + 1u == (gen + 1u) * nloc) {
            __builtin_amdgcn_fence(__ATOMIC_RELEASE, "agent");
            asm volatile("s_waitcnt vmcnt(0)" ::: "memory");
            const unsigned og = xb_add(&bar[XB_TOP], 1u);
            const unsigned tg = og / nx;
            if (og + 1u == (tg + 1u) * nx) xb_add(&bar[XB_TOPGEN], 1u);
            else XB_SPIN(xb_ld(&bar[XB_TOPGEN]) == tg, bar);
            __builtin_amdgcn_fence(__ATOMIC_ACQUIRE, "agent");
            xb_add(&bar[XB_XGEN(b.x)], 1u);
            asm volatile("s_waitcnt vmcnt(0)" ::: "memory");
        } else {
            XB_SPIN(xb_ld(&bar[XB_XGEN(b.x)]) == gen, bar);
            __builtin_amdgcn_fence(__ATOMIC_ACQUIRE, "agent");
            asm volatile("s_waitcnt vmcnt(0)" ::: "memory");
        }
    }
    __syncthreads();
}

__device__ __forceinline__ void xcd_barrier_local(const XcdBarrier& b) {
    asm volatile("s_waitcnt vmcnt(0)" ::: "memory");
    __syncthreads();
    if (threadIdx.x == 0) {
        unsigned* bar = b.bar;
        __builtin_amdgcn_s_waitcnt(0);
        const unsigned nloc = b.st[0];
        const unsigned old = xb_add(&bar[XB_XSUB(b.x)], 1u);
        const unsigned gen = old / nloc;
        if (old + 1u == (gen + 1u) * nloc) xb_add(&bar[XB_XGEN(b.x)], 1u);
        else XB_SPIN(xb_ld(&bar[XB_XGEN(b.x)]) == gen, bar);
        __builtin_amdgcn_fence(__ATOMIC_ACQUIRE, "agent");
        asm volatile("s_waitcnt vmcnt(0)" ::: "memory");
    }
    __syncthreads();
}

#define XB_QSUB(q) (24576 + 64 * (q))
#define XB_QGEN(q) (28672 + 64 * (q))
__device__ __forceinline__ void quad_barrier(const XcdBarrier& b, unsigned q) {
    asm volatile("s_waitcnt vmcnt(0)" ::: "memory");
    __syncthreads();
    if (threadIdx.x == 0) {
        unsigned* bar = b.bar;
        __builtin_amdgcn_s_waitcnt(0);
        const unsigned old = xb_add(&bar[XB_QSUB(q)], 1u);
        const unsigned gen = old / 4u;
        if (old + 1u == (gen + 1u) * 4u) xb_add(&bar[XB_QGEN(q)], 1u);
        else XB_SPIN(xb_ld(&bar[XB_QGEN(q)]) == gen, bar);
        __builtin_amdgcn_fence(__ATOMIC_ACQUIRE, "agent");
        asm volatile("s_waitcnt vmcnt(0)" ::: "memory");
    }
    __syncthreads();
}

#define XB_OSUB(o) (36864 + 64 * (o))
#define XB_OGEN(o) (40960 + 64 * (o))
__device__ __forceinline__ void octet_barrier(const XcdBarrier& b, unsigned o) {
    asm volatile("s_waitcnt vmcnt(0)" ::: "memory");
    __syncthreads();
    if (threadIdx.x == 0) {
        unsigned* bar = b.bar;
        __builtin_amdgcn_s_waitcnt(0);
        const unsigned old = xb_add(&bar[XB_OSUB(o)], 1u);
        const unsigned gen = old / 8u;
        if (old + 1u == (gen + 1u) * 8u) xb_add(&bar[XB_OGEN(o)], 1u);
        else XB_SPIN(xb_ld(&bar[XB_OGEN(o)]) == gen, bar);
        __builtin_amdgcn_fence(__ATOMIC_ACQUIRE, "agent");
        asm volatile("s_waitcnt vmcnt(0)" ::: "memory");
    }
    __syncthreads();
}

#ifndef REP_GU
#define REP_GU 1
#endif
#ifndef REP_DN
#define REP_DN 1
#endif
#ifndef REP_IN
#define REP_IN 1
#endif
#ifndef REP_PRO
#define REP_PRO 1
#endif
#ifndef REP_SB
#define REP_SB 1
#endif
#ifndef REP_CONV
#define REP_CONV 1
#endif
#ifndef REP_CMP
#define REP_CMP 1
#endif
#ifndef REP_GMLP
#define REP_GMLP 1
#endif
#ifndef REP_NSA
#define REP_NSA 1
#endif
#ifndef REP_LN
#define REP_LN 1
#endif
#ifndef REP_SYNC
#define REP_SYNC 1
#endif

#ifdef XSB
#define DIS_SB(x)
#else
#define DIS_SB(x) x
#endif
#ifdef XCONV
#define DIS_CONV(x)
#else
#define DIS_CONV(x) x
#endif
#ifdef XCMP
#define DIS_CMP(x)
#else
#define DIS_CMP(x) x
#endif
#ifdef XGMLP
#define DIS_GMLP(x)
#else
#define DIS_GMLP(x) x
#endif
#ifdef XNSA
#define DIS_NSA(x)
#else
#define DIS_NSA(x) x
#endif
#ifdef XGEMM
#define DIS_GEMM(x)
#else
#define DIS_GEMM(x) x
#endif

#define LAS __attribute__((address_space(3)))
typedef unsigned short bf16_t;
typedef short bf16x8 __attribute__((ext_vector_type(8)));
typedef short s16x4 __attribute__((ext_vector_type(4)));
typedef short v4i16_t __attribute__((ext_vector_type(4)));
typedef float f32x4 __attribute__((ext_vector_type(4)));
typedef float f32x16 __attribute__((ext_vector_type(16)));
typedef unsigned u32x4 __attribute__((ext_vector_type(4)));
typedef unsigned u32x2 __attribute__((ext_vector_type(2)));

constexpr int NB = 16, SEQ = 2048, DM = 1024, MTOK = NB * SEQ;
constexpr int HW = 2560;
constexpr int FF = 2816;
constexpr float ALPHA = 1.41421356237309515f;
constexpr float LN_EPS = 1e-5f;
constexpr float LOG2E = 1.4426950408889634f;
constexpr float C2 = 0.125f * LOG2E;

constexpr size_t MiB = 1u << 20;
constexpr size_t WS_IN0 = 0 * MiB, WS_OUT0 = 6 * MiB, WS_IN1 = 8 * MiB, WS_OUT1 = 14 * MiB;
constexpr size_t WS_GU0 = 16 * MiB, WS_GU1 = 28 * MiB, WS_DN0 = 40 * MiB, WS_DN1 = 46 * MiB;
constexpr size_t WS_W1TK = 52 * MiB, WS_W1TV = 53 * MiB, WS_TRIL = 54 * MiB, WS_KCMP = 55 * MiB, WS_VCMP = 56 * MiB;
constexpr size_t WS_PT = 56 * MiB + 768 * 1024;
constexpr size_t WS_XCH = 57 * MiB, WS_CTL = 61 * MiB, CTL_BYTES = 256 * 1024;
constexpr int CW_TMO = 4096, CW_SEAM = 8192;
constexpr size_t WS_XB = 64 * MiB, WS_H = 128 * MiB, WS_MIX = 304 * MiB, WS_MB = 368 * MiB, WS_END = 432 * MiB;

constexpr int LDS_BYTES = 147456;

struct Params { const float* in[26]; float* out; unsigned char* ws; };
__device__ __forceinline__ int opaque_tid() { int t = threadIdx.x; asm volatile("" : "+v"(t)); return t; }

__device__ __forceinline__ unsigned f2bf(float f) { unsigned u = __builtin_bit_cast(unsigned, f); return (u + 0x7fffu + ((u >> 16) & 1u)) >> 16; }
__device__ __forceinline__ unsigned pk2(float lo, float hi) { return pg8::cvt_pk_bf16(lo, hi); }
__device__ __forceinline__ float bf2f(unsigned b) { return __builtin_bit_cast(float, b << 16); }
__device__ __forceinline__ float bflo(unsigned w) { return __builtin_bit_cast(float, w << 16); }
__device__ __forceinline__ float bfhi(unsigned w) { return __builtin_bit_cast(float, w & 0xffff0000u); }
__device__ __forceinline__ float wave_sum(float v) {
#pragma unroll
    for (int o = 1; o < 64; o <<= 1) v += __shfl_xor(v, o);
    return v;
}
__device__ __forceinline__ float xor32(float v) {
    const unsigned u = __builtin_bit_cast(unsigned, v);
    auto rr = __builtin_amdgcn_permlane32_swap(u, u, false, false);
    return __builtin_bit_cast(float, (threadIdx.x & 32u) ? rr[0] : rr[1]);
}
__device__ __forceinline__ float sigmoidf_(float x) { return __builtin_amdgcn_rcpf(1.f + __expf(-x)); }
__device__ __forceinline__ float siluf_(float x) { return x * __builtin_amdgcn_rcpf(1.f + __expf(-x)); }
__device__ __forceinline__ float gelu_tanh(float x) {
    const float u = 0.7978845608028654f * (x + 0.044715f * x * x * x);
    return x * __builtin_amdgcn_rcpf(1.f + __expf(-2.f * u));
}
#define LDSW() asm volatile("s_waitcnt lgkmcnt(0)" ::: "memory")
#define MFMA32(a, b, c) __builtin_amdgcn_mfma_f32_32x32x16_bf16((a), (b), (c), 0, 0, 0)
__device__ __forceinline__ int crow(int r, int hi) { return (r & 3) + 8 * (r >> 2) + 4 * hi; }

struct EpiStore {
    static constexpr bool PERM = true, AFTER_DRAIN = false;
    bf16_t* O; int ldc;
    __device__ __forceinline__ void operator()(const pg8::f32x4 (&acc)[2][2][4][2], const pg8::Unit& u, int wr, int wc, int fr, int fq) const {
        const int row0 = u.pm * 256 + wr * 64 + fr, col0 = u.pn * 256 + wc * 32 + 8 * fq;
#pragma unroll
        for (int ai = 0; ai < 2; ++ai)
#pragma unroll
            for (int m = 0; m < 4; ++m) { bf16_t* rowp = O + (size_t)(row0 + ai * 128 + m * 16) * ldc + col0;
#pragma unroll
                for (int bj = 0; bj < 2; ++bj) { const pg8::f32x4 v0 = acc[ai][bj][m][0], v1 = acc[ai][bj][m][1];
                    u32x4 w; w.x = pk2(v0[0], v0[1]); w.y = pk2(v0[2], v0[3]); w.z = pk2(v1[0], v1[1]); w.w = pk2(v1[2], v1[3]);
                    *(u32x4*)(rowp + bj * 128) = w; } }
    }
};
struct EpiResid {
    static constexpr bool PERM = true, AFTER_DRAIN = false;
    bf16_t* O; const bf16_t* X;
    __device__ __forceinline__ void operator()(const pg8::f32x4 (&acc)[2][2][4][2], const pg8::Unit& u, int wr, int wc, int fr, int fq) const {
        const int row0 = u.pm * 256 + wr * 64 + fr, col0 = u.pn * 256 + wc * 32 + 8 * fq;
#pragma unroll
        for (int ai = 0; ai < 2; ++ai)
#pragma unroll
            for (int m = 0; m < 4; ++m) { const size_t off = (size_t)(row0 + ai * 128 + m * 16) * DM + col0;
#pragma unroll
                for (int bj = 0; bj < 2; ++bj) { const pg8::f32x4 v0 = acc[ai][bj][m][0], v1 = acc[ai][bj][m][1];
                    const u32x4 xr = *(const u32x4*)(X + off + bj * 128);
                    u32x4 w; w.x = pk2(v0[0] + ALPHA * bflo(xr.x), v0[1] + ALPHA * bfhi(xr.x)); w.y = pk2(v0[2] + ALPHA * bflo(xr.y), v0[3] + ALPHA * bfhi(xr.y));
                    w.z = pk2(v1[0] + ALPHA * bflo(xr.z), v1[1] + ALPHA * bfhi(xr.z)); w.w = pk2(v1[2] + ALPHA * bflo(xr.w), v1[3] + ALPHA * bfhi(xr.w));
                    *(u32x4*)(O + off + bj * 128) = w; } }
    }
};
struct EpiSwiglu {
    static constexpr bool PERM = true, AFTER_DRAIN = false;
    bf16_t* O; int ldc;
    __device__ __forceinline__ void operator()(const pg8::f32x4 (&acc)[2][2][4][2], const pg8::Unit& u, int wr, int wc, int fr, int fq) const {
        const int row0 = u.pm * 256 + wr * 64 + fr, col0 = u.pn * 128 + wc * 16 + 4 * fq;
#pragma unroll
        for (int ai = 0; ai < 2; ++ai)
#pragma unroll
            for (int m = 0; m < 4; ++m) { bf16_t* rowp = O + (size_t)(row0 + ai * 128 + m * 16) * ldc + col0;
#pragma unroll
                for (int bj = 0; bj < 2; ++bj) { const pg8::f32x4 gv = acc[ai][bj][m][0], uv = acc[ai][bj][m][1];
                    u32x2 w; w.x = pk2(siluf_(gv[0]) * uv[0], siluf_(gv[1]) * uv[1]); w.y = pk2(siluf_(gv[2]) * uv[2], siluf_(gv[3]) * uv[3]);
                    *(u32x2*)(rowp + bj * 64) = w; } }
    }
};


struct EpiLnOut {
    static constexpr bool PERM = false, AFTER_DRAIN = true;
    const float* base; float* out; bf16_t* xb; const float* gam; const float* bet; pg8::PanelStats st;
    __device__ __forceinline__ void fused(pg8::f32x4 (&acc)[2][2][4][2], const pg8::Unit& u, int wr, int wc, int fr, int fq, PG8_LAS unsigned char* lds, int wid, int lane) const {
        typedef float f32x2v __attribute__((ext_vector_type(2)));
        const PG8_LAS f32x2v* S = (const PG8_LAS f32x2v*)(lds + 8192);
        const int col0 = u.pn * 256 + wc * 32 + 4 * fq;
#pragma unroll
        for (int ai = 0; ai < 2; ++ai)
#pragma unroll
            for (int m = 0; m < 4; ++m) { const size_t off = (size_t)(u.pm * 256 + ai * 128 + wr * 64 + m * 16 + fr) * DM + col0;
#pragma unroll
                for (int bj = 0; bj < 2; ++bj)
#pragma unroll
                    for (int n = 0; n < 2; ++n) { const pg8::f32x4 bs = *(const pg8::f32x4*)(base + off + bj * 128 + n * 16); acc[ai][bj][m][n] += bs * ALPHA; }
                asm volatile("" : "+v"(acc[ai][0][m][0]), "+v"(acc[ai][0][m][1]), "+v"(acc[ai][1][m][0]), "+v"(acc[ai][1][m][1]));
                if (m & 1) asm volatile("" ::: "memory"); }
        const bool bad = st.run(acc, u, wr, wc, fr, fq, lds, wid, lane);
        const float qnan = __builtin_nanf("");
        pg8::f32x4 gv[2][2], bv[2][2];
#pragma unroll
        for (int bj = 0; bj < 2; ++bj)
#pragma unroll
            for (int n = 0; n < 2; ++n) { gv[bj][n] = *(const pg8::f32x4*)(gam + col0 + bj * 128 + n * 16); bv[bj][n] = *(const pg8::f32x4*)(bet + col0 + bj * 128 + n * 16); }
#pragma unroll
        for (int ai = 0; ai < 2; ++ai)
#pragma unroll
            for (int m = 0; m < 4; ++m) { const int r = ai * 128 + wr * 64 + m * 16 + fr; const f32x2v sr = S[r]; const size_t off = (size_t)(u.pm * 256 + r) * DM + col0;
#pragma unroll
                for (int bj = 0; bj < 2; ++bj)
#pragma unroll
                    for (int n = 0; n < 2; ++n) {
                        pg8::f32x4 o = (acc[ai][bj][m][n] - sr.x) * sr.y * gv[bj][n] + bv[bj][n];
                        if (bad) o = (pg8::f32x4){qnan, qnan, qnan, qnan};
                        *(pg8::f32x4*)(out + off + bj * 128 + n * 16) = o; u32x2 w; w.x = pk2(o[0], o[1]); w.y = pk2(o[2], o[3]); *(u32x2*)(xb + off + bj * 128 + n * 16) = w; }
                asm volatile("" ::: "memory"); }
    }
};
struct RoundOrder {
    pg8::StaticOrder so; int round;
    __device__ __forceinline__ bool next(int i, pg8::Unit& u) const { if (i != 0) return false; return so.next(round, u); }
    __device__ __forceinline__ void a_ready(const pg8::Unit&) const {}
    __device__ __forceinline__ void done(const pg8::Unit&) const {}
};
__device__ __forceinline__ void run_gemm_ln(LAS unsigned char* lds, unsigned char* ws, const bf16_t* A, const bf16_t* Bt, int K, int inst,
                                            const float* base, float* out, bf16_t* xb, const float* gam, const float* bet) {
    pg8::Gemm g{A, Bt, MTOK, 1024, K};
    unsigned* ctl = (unsigned*)(ws + WS_CTL);
    const int nrounds = (MTOK / 256) * 4 / (int)gridDim.x;
    for (int r = 0; r < nrounds; ++r) {
        RoundOrder S; S.so.init(MTOK, 1024, (int)gridDim.x, (int)blockIdx.x); S.round = r;
        pg8::PanelStats st{(unsigned*)(ws + WS_XCH + (size_t)inst * MiB), ctl + CW_SEAM + inst * 8192, ctl + CW_TMO, 4, LN_EPS, 0x700u + (unsigned)inst};
#ifdef TEST_EXEPI
        pg8::EpiLnRes E{base, out, DM, nullptr, st, 0u};
        pg8::gemm_phase<pg8::EpiLnRes, RoundOrder, false, true>(lds, g, S, E);
#else
        EpiLnOut E{base, out, xb, gam, bet, st};
        pg8::gemm_phase<EpiLnOut, RoundOrder, false, true>(lds, g, S, E);
#endif
        __syncthreads();
    }
}

template <class Epi>
__device__ __forceinline__ void run_gemm(LAS unsigned char* lds, const bf16_t* A, const bf16_t* Bt, int N, int K, const Epi& E) {
    pg8::Gemm g{A, Bt, MTOK, N, K}; pg8::StaticOrder S; S.init(MTOK, N, (int)gridDim.x, (int)blockIdx.x);
    DIS_GEMM((pg8::gemm_phase<Epi, pg8::StaticOrder, true, true>(lds, g, S, E)));
}

__device__ __forceinline__ int map_row(int mode, int n) {
    if (mode == 0) return n;
    if (mode == 1) return (n >> 2) * 8 + (n & 3);
    if (mode == 2) return (n >> 2) * 8 + 4 + (n & 3);
    if (n < 1280) return n;
    if (n < 1304) return 2304 + (n - 1280);
    return n - 24;
}
__device__ __forceinline__ void p0_transpose_item(const float* W, int K, int N, bf16_t* WT, int mode, LAS float* scr, int item, int lane) {
    const int nblk = (N + 31) / 32, kb = item / nblk, nb = item % nblk, k0 = 64 * kb, n0 = 32 * nb;
    const int nn = n0 + (lane & 31);
    float wv[32];
#pragma unroll
    for (int i = 0; i < 32; ++i) { const int kk = 2 * i + (lane >> 5); wv[i] = (nn < N) ? W[(size_t)(k0 + kk) * N + nn] : 0.f; }
#pragma unroll
    for (int i = 0; i < 32; ++i) { const int kk = 2 * i + (lane >> 5); scr[kk * 33 + (lane & 31)] = wv[i]; }
    LDSW();
    const int c = lane & 7;
#pragma unroll
    for (int j = 0; j < 4; ++j) { const int nl = (lane >> 3) + 8 * j, n = n0 + nl; const LAS float* s = scr + (8 * c) * 33 + nl;
        u32x4 o; o.x = pk2(s[0 * 33], s[1 * 33]); o.y = pk2(s[2 * 33], s[3 * 33]); o.z = pk2(s[4 * 33], s[5 * 33]); o.w = pk2(s[6 * 33], s[7 * 33]);
        if (n < N) *(u32x4*)(WT + (size_t)map_row(mode, n) * K + k0 + 8 * c) = o; }
    LDSW();
}
__device__ __forceinline__ void p0_prologue(const Params& p, LAS unsigned char* lds) {
    const int tid = opaque_tid(), lane = tid & 63, wave = tid >> 6;
    LAS float* scr = (LAS float*)(lds + wave * 16384);
    const int gw = blockIdx.x * 8 + wave, NGW = gridDim.x * 8;
    unsigned char* ws = p.ws;
    constexpr int I_IN0 = 16 * 80, I_OUT = 16 * 32, I_IN1 = 16 * 73, I_G = 16 * 88, I_DN = 44 * 32, I_W1 = 32 * 2;
    constexpr int NITEMS = I_IN0 + 2 * I_OUT + I_IN1 + 4 * I_G + 2 * I_DN + 2 * I_W1;
    for (int it = gw; it < NITEMS; it += NGW) {
        int r = it;
        if (r < I_IN0) { p0_transpose_item(p.in[1], 1024, 2560, (bf16_t*)(ws + WS_IN0), 0, scr, r, lane); continue; } r -= I_IN0;
        if (r < I_OUT) { p0_transpose_item(p.in[6], 1024, 1024, (bf16_t*)(ws + WS_OUT0), 0, scr, r, lane); continue; } r -= I_OUT;
        if (r < I_OUT) { p0_transpose_item(p.in[18], 1024, 1024, (bf16_t*)(ws + WS_OUT1), 0, scr, r, lane); continue; } r -= I_OUT;
        if (r < I_IN1) { p0_transpose_item(p.in[7], 1024, 2328, (bf16_t*)(ws + WS_IN1), 3, scr, r, lane); continue; } r -= I_IN1;
        if (r < I_G) { p0_transpose_item(p.in[19], 1024, FF, (bf16_t*)(ws + WS_GU0), 1, scr, r, lane); continue; } r -= I_G;
        if (r < I_G) { p0_transpose_item(p.in[20], 1024, FF, (bf16_t*)(ws + WS_GU0), 2, scr, r, lane); continue; } r -= I_G;
        if (r < I_G) { p0_transpose_item(p.in[19] + (size_t)1024 * FF, 1024, FF, (bf16_t*)(ws + WS_GU1), 1, scr, r, lane); continue; } r -= I_G;
        if (r < I_G) { p0_transpose_item(p.in[20] + (size_t)1024 * FF, 1024, FF, (bf16_t*)(ws + WS_GU1), 2, scr, r, lane); continue; } r -= I_G;
        if (r < I_DN) { p0_transpose_item(p.in[21], FF, 1024, (bf16_t*)(ws + WS_DN0), 0, scr, r, lane); continue; } r -= I_DN;
        if (r < I_DN) { p0_transpose_item(p.in[21] + (size_t)FF * 1024, FF, 1024, (bf16_t*)(ws + WS_DN1), 0, scr, r, lane); continue; } r -= I_DN;
        if (r < I_W1) { p0_transpose_item(p.in[9], 2048, 64, (bf16_t*)(ws + WS_W1TK), 0, scr, r, lane); continue; } r -= I_W1;
        p0_transpose_item(p.in[12], 2048, 64, (bf16_t*)(ws + WS_W1TV), 0, scr, r, lane);
    }
    if (blockIdx.x >= gridDim.x - 16) {
        const int bq_ = (int)blockIdx.x - ((int)gridDim.x - 16), kv = bq_ >> 3, kp = bq_ & 7; const float* pos = p.in[kv ? 11 : 8]; const float* w1 = p.in[kv ? 12 : 9];
        LAS float* ptL = (LAS float*)(lds + 135168);
        const int e = tid & 63, sub = tid >> 6, k0 = kp * 256 + sub * 32;
        float pv_[32], wv_[32];
#pragma unroll
        for (int i = 0; i < 32; ++i) { pv_[i] = pos[k0 + i]; wv_[i] = w1[(size_t)(k0 + i) * 64 + e]; }
        float a0 = 0.f, a1 = 0.f, a2 = 0.f, a3 = 0.f;
#pragma unroll
        for (int i = 0; i < 32; i += 4) { a0 += pv_[i] * wv_[i]; a1 += pv_[i + 1] * wv_[i + 1]; a2 += pv_[i + 2] * wv_[i + 2]; a3 += pv_[i + 3] * wv_[i + 3]; }
        ptL[sub * 64 + e] = (a0 + a1) + (a2 + a3);
        __syncthreads();
        if (tid < 64) { float pt = 0.f;
#pragma unroll
            for (int ww = 0; ww < 8; ++ww) pt += ptL[ww * 64 + tid];
            ((float*)(ws + WS_PT))[(kv * 8 + kp) * 64 + tid] = pt; }
        __syncthreads();
    }
    const int gt = blockIdx.x * 512 + tid, NGT = gridDim.x * 512;
    { u32x4* z = (u32x4*)((bf16_t*)(ws + WS_IN1) + (size_t)2328 * 1024); const int n16 = 232 * 1024 * 2 / 16;
      for (int i = gt; i < n16; i += NGT) z[i] = (u32x4){0u, 0u, 0u, 0u}; }
    { const float* wsrc = p.in[16]; bf16_t* tr = (bf16_t*)(ws + WS_TRIL);
      for (int i = gt; i < 4 * 128 * 128; i += NGT) { const int t = (i >> 7) & 127, s = i & 127; tr[i] = (bf16_t)((s <= t) ? f2bf(wsrc[i]) : 0u); } }
    { const float* x = p.in[0]; bf16_t* xb = (bf16_t*)(ws + WS_XB);
      for (int m = gw; m < MTOK; m += 4 * NGW) {
          f32x4 v[4][4];
#pragma unroll
          for (int r = 0; r < 4; ++r) { const int mm = m + r * NGW; if (mm < MTOK) { const f32x4* xr = (const f32x4*)(x + (size_t)mm * DM) + lane;
#pragma unroll
              for (int j = 0; j < 4; ++j) v[r][j] = xr[64 * j]; } }
#pragma unroll
          for (int r = 0; r < 4; ++r) { const int mm = m + r * NGW; if (mm < MTOK) { u32x2* o8 = (u32x2*)(xb + (size_t)mm * DM) + lane;
#pragma unroll
              for (int j = 0; j < 4; ++j) { u32x2 w; w.x = pk2(v[r][j].x, v[r][j].y); w.y = pk2(v[r][j].z, v[r][j].w); o8[64 * j] = w; } } } } }
}

template <bool F32IN, bool F32OUT>
__device__ __forceinline__ void ln_phase(const float* xin, const bf16_t* xbin, const bf16_t* mb, const float* gam, const float* bet, float* xout, bf16_t* xb) {
    const int tid = opaque_tid(), lane = tid & 63, wave = tid >> 6;
    const int G_ = gridDim.x, bx_ = blockIdx.x; const bool xown = (G_ == 256);
    const int vc_ = xown ? (bx_ % 8) * 32 + bx_ / 8 : bx_;
    const int r_ = bx_ / 8, p_ = r_ & 7, qw_ = (r_ >> 3) * 8 + wave, panel0 = (bx_ % 8) * 16 + p_;
    f32x4 gv[4], bv[4];
#pragma unroll
    for (int j = 0; j < 4; ++j) { gv[j] = ((const f32x4*)gam)[64 * j + lane]; bv[j] = ((const f32x4*)bet)[64 * j + lane]; }
    const int nrows = xown ? 16 : (MTOK + G_ * 8 - 1) / (G_ * 8);
    for (int it_ = 0; it_ < nrows; ++it_) {
        const int m = xown ? (panel0 + 8 * (it_ >> 3)) * 256 + qw_ + 32 * (it_ & 7) : bx_ * 8 + wave + it_ * G_ * 8;
        if (m >= MTOK) break;
        const u32x2* mr = (const u32x2*)(mb + (size_t)m * DM) + lane;
        f32x4 v[4]; float s = 0.f;
#pragma unroll
        for (int j = 0; j < 4; ++j) { f32x4 x;
            if (F32IN) x = ((const f32x4*)(xin + (size_t)m * DM) + lane)[64 * j];
            else { const u32x2 xw = ((const u32x2*)(xbin + (size_t)m * DM) + lane)[64 * j]; x.x = bflo(xw.x); x.y = bfhi(xw.x); x.z = bflo(xw.y); x.w = bfhi(xw.y); }
            const u32x2 w = mr[64 * j];
            v[j].x = ALPHA * x.x + bflo(w.x); v[j].y = ALPHA * x.y + bfhi(w.x); v[j].z = ALPHA * x.z + bflo(w.y); v[j].w = ALPHA * x.w + bfhi(w.y);
            s += (v[j].x + v[j].y) + (v[j].z + v[j].w); }
        const float mean = wave_sum(s) * (1.f / DM); float s2 = 0.f;
#pragma unroll
        for (int j = 0; j < 4; ++j) { v[j] = v[j] - mean; s2 += (v[j].x * v[j].x + v[j].y * v[j].y) + (v[j].z * v[j].z + v[j].w * v[j].w); }
        const float rstd = rsqrtf(wave_sum(s2) * (1.f / DM) + LN_EPS);
#pragma unroll
        for (int j = 0; j < 4; ++j) { const f32x4 o = v[j] * rstd * gv[j] + bv[j];
            if (F32OUT) ((f32x4*)(xout + (size_t)m * DM) + lane)[64 * j] = o;
            else { u32x2 w; w.x = pk2(o.x, o.y); w.y = pk2(o.z, o.w); ((u32x2*)(xb + (size_t)m * DM) + lane)[64 * j] = w; } }
    }
}

constexpr int KS = 144;
constexpr int TILEB = 64 * KS;
constexpr int L_K = 0, L_V = 2 * TILEB, L_WSF = 4 * TILEB  , L_DONE = L_WSF + 1024, L_IMP = L_DONE + 256  , L_SEL = L_IMP + 4 * 64 * 33 * 4  , L_OACC = 73728;

__device__ __forceinline__ s16x4 vtr(const LAS char* p) { return __builtin_bit_cast(s16x4, __builtin_amdgcn_ds_read_tr16_b64_v4i16((LAS v4i16_t*)p)); }

__device__ __forceinline__ f32x16 qk_sub(const LAS char* kt, int sub, const bf16x8 (&qr)[4], int r32, int hi) {
    f32x16 s;
#pragma unroll
    for (int i = 0; i < 16; ++i) s[i] = 0.f;
    const LAS char* kp = kt + (32 * sub + r32) * KS + hi * 16;
#pragma unroll
    for (int d0 = 0; d0 < 4; ++d0) { const bf16x8 a = *(const LAS bf16x8*)(kp + d0 * 32); s = MFMA32(a, qr[d0], s); }
    return s;
}
__device__ __forceinline__ void pv_sub(f32x16 (&o)[2], const f32x16& p, const LAS char* vt, int sub, int lane) {
    const int hi = lane >> 5;
    const LAS char* vp = vt + (32 * sub + 4 * hi + ((lane & 15) >> 2)) * KS + (16 * ((lane >> 4) & 1) + 4 * (lane & 3)) * 2;
#pragma unroll
    for (int s = 0; s < 2; ++s) {
        u32x4 pw; pw.x = pk2(p[8 * s + 0], p[8 * s + 1]); pw.y = pk2(p[8 * s + 2], p[8 * s + 3]); pw.z = pk2(p[8 * s + 4], p[8 * s + 5]); pw.w = pk2(p[8 * s + 6], p[8 * s + 7]);
        const bf16x8 pa = __builtin_bit_cast(bf16x8, pw);
#pragma unroll
        for (int db = 0; db < 2; ++db) {
            const s16x4 lo = vtr(vp + (16 * s) * KS + db * 64), hi4 = vtr(vp + (16 * s + 8) * KS + db * 64);
            const bf16x8 vb = (bf16x8){lo[0], lo[1], lo[2], lo[3], hi4[0], hi4[1], hi4[2], hi4[3]};
            o[db] = MFMA32(pa, vb, o[db]);
        }
    }
}
__device__ __forceinline__ void bcast_rows(float (&f)[16], LAS float* wsf_w, float val, int r32, int hi) {
    LDSW();
    if (hi == 0) wsf_w[r32] = val;
    LDSW();
#pragma unroll
    for (int r = 0; r < 16; ++r) f[r] = wsf_w[crow(r, hi)];
    LDSW();
}

__device__ __forceinline__ void sb_unit(const Params& p, LAS unsigned char* lds8, int b, int hp, int qb) {
    LAS char* lds = (LAS char*)lds8;
    const int tid = opaque_tid(), lane = tid & 63, w = __builtin_amdgcn_readfirstlane(tid >> 6), r32 = lane & 31, hi = lane >> 5;
    const int hd = w >> 2, hh = 2 * hp + hd, wq = w & 3;
    const bf16_t* H0 = (const bf16_t*)(p.ws + WS_H);
    bf16_t* MIX = (bf16_t*)(p.ws + WS_MIX);
    const size_t rowbase = (size_t)b * SEQ;
    const int t = 128 * qb + 32 * wq + r32, twmax = 128 * qb + 32 * wq + 31;
    constexpr int SB_K = 0, SB_V = 4 * TILEB, SB_DONE = 8 * TILEB;
    bf16x8 qr[4];
    { const bf16_t* qp = H0 + (rowbase + t) * HW + hh * 64;
#pragma unroll
      for (int d0 = 0; d0 < 4; ++d0) qr[d0] = *(const bf16x8*)(qp + 16 * d0 + 8 * hi); }
    f32x16 o[2];
#pragma unroll
    for (int i = 0; i < 16; ++i) { o[0][i] = 0.f; o[1][i] = 0.f; }
    float R = 0.f; bool wdone = false;
    const int lrow = tid >> 3, lch = tid & 7;
    const bf16_t* kg = H0 + (rowbase + lrow) * HW + 512 + (2 * hp) * 64 + lch * 8; const bf16_t* vg = kg + 512;
    LAS unsigned* doneL = (LAS unsigned*)(lds + SB_DONE);
    int j = 2 * qb + 1;
    u32x4 k0 = *(const u32x4*)(kg + (size_t)(64 * j) * HW), k1 = *(const u32x4*)(kg + (size_t)(64 * j) * HW + 64);
    u32x4 v0 = *(const u32x4*)(vg + (size_t)(64 * j) * HW), v1 = *(const u32x4*)(vg + (size_t)(64 * j) * HW + 64);
    for (int it = 0;; ++it) {
        LAS char* kw = lds + SB_K + (it & 1) * 2 * TILEB + lrow * KS + lch * 16; LAS char* vw = lds + SB_V + (it & 1) * 2 * TILEB + lrow * KS + lch * 16;
        *(LAS u32x4*)kw = k0; *(LAS u32x4*)(kw + TILEB) = k1; *(LAS u32x4*)vw = v0; *(LAS u32x4*)(vw + TILEB) = v1;
        if (lane == 0) doneL[(it & 1) * 8 + w] = wdone ? 1u : 0u;
        __syncthreads();
        { const u32x4 d0 = *(const LAS u32x4*)(doneL + (it & 1) * 8), d1 = *(const LAS u32x4*)(doneL + (it & 1) * 8 + 4);
          const unsigned all = d0.x & d0.y & d0.z & d0.w & d1.x & d1.y & d1.z & d1.w;
          if (all) break; }
        if (j > 0) { k0 = *(const u32x4*)(kg + (size_t)(64 * (j - 1)) * HW); k1 = *(const u32x4*)(kg + (size_t)(64 * (j - 1)) * HW + 64);
                     v0 = *(const u32x4*)(vg + (size_t)(64 * (j - 1)) * HW); v1 = *(const u32x4*)(vg + (size_t)(64 * (j - 1)) * HW + 64); }
        const LAS char* kt = lds + SB_K + ((it & 1) * 2 + hd) * TILEB; const LAS char* vt = lds + SB_V + ((it & 1) * 2 + hd) * TILEB;
#pragma unroll
        for (int sb_ = 0; sb_ < 2; ++sb_) {
            const int sub = 1 - sb_;
            const int kvb = 64 * j + 32 * sub;
            if (kvb >= twmax || wdone) continue;
            const f32x16 s = qk_sub(kt, sub, qr, r32, hi);
            float lr[16], lb[16];
#pragma unroll
            for (int r = 0; r < 16; ++r) {
                const int kv = kvb + crow(r, hi); const float z = s[r] * 0.125f;
                const float sp = fmaxf(z, 0.f) + __logf(1.f + __expf(-fabsf(z)));
                const bool past = kv < t;
                lr[r] = past ? -sp : 0.f; lb[r] = z - sp;
            }
            float T[4], To[4], aft[16];
#pragma unroll
            for (int gq = 0; gq < 4; ++gq) {
                aft[4 * gq + 3] = 0.f; aft[4 * gq + 2] = lr[4 * gq + 3]; aft[4 * gq + 1] = aft[4 * gq + 2] + lr[4 * gq + 2]; aft[4 * gq + 0] = aft[4 * gq + 1] + lr[4 * gq + 1];
                T[gq] = aft[4 * gq + 0] + lr[4 * gq + 0];
            }
#pragma unroll
            for (int gq = 0; gq < 4; ++gq) To[gq] = xor32(T[gq]);
            float A = 0.f;
            f32x16 pw;
#pragma unroll
            for (int gq = 3; gq >= 0; --gq) {
                const float ga = A + (hi == 0 ? To[gq] : 0.f);
#pragma unroll
                for (int i = 0; i < 4; ++i) { const int r = 4 * gq + i; const int kv = kvb + crow(r, hi);
                    const float e = __expf(lb[r] + R + ga + aft[r]); pw[r] = (kv < t) ? e : 0.f; }
                A += T[gq] + To[gq];
            }
            R += A;
            pv_sub(o, pw, vt, sub, lane);
            wdone = __all(R < -45.f);
        }
        wdone = wdone || __all(R < -45.f);
        if (j == 0) break;
        --j;
    }
    __syncthreads();
    bf16_t* op = MIX + (rowbase + 128 * qb + 32 * wq) * DM + hh * 64 + r32;
#pragma unroll
    for (int r = 0; r < 16; ++r) { const int q = crow(r, hi);
        op[(size_t)q * DM] = (bf16_t)f2bf(o[0][r]); op[(size_t)q * DM + 32] = (bf16_t)f2bf(o[1][r]); }
}

__device__ __forceinline__ void conv_unit(const Params& p, LAS unsigned char* lds8, int b, int tile) {
    const int tid = opaque_tid(), lane = tid & 63, w = tid >> 6;
    const bf16_t* H0 = (const bf16_t*)(p.ws + WS_H);
    bf16_t* MIX = (bf16_t*)(p.ws + WS_MIX);
    LAS bf16_t* hL = (LAS bf16_t*)lds8;
    LAS float* yL = (LAS float*)(lds8 + 63488);
    const int t0 = 32 * tile;
    const float* cw = p.in[2]; const float bias = p.in[3][tid];
    float wd[31];
#pragma unroll
    for (int k = 0; k < 31; ++k) wd[k] = cw[k * 512 + tid];
    const f32x4 g0 = ((const f32x4*)p.in[4])[lane * 2], g1 = ((const f32x4*)p.in[4])[lane * 2 + 1];
    const f32x4 b0 = ((const f32x4*)p.in[5])[lane * 2], b1 = ((const f32x4*)p.in[5])[lane * 2 + 1];
    {
        u32x4 av[8], gv8[8];
#pragma unroll
        for (int i = 0; i < 8; ++i) { const int tt = w + 8 * i, tok = t0 - 30 + tt; av[i] = (u32x4){0u, 0u, 0u, 0u}; gv8[i] = (u32x4){0u, 0u, 0u, 0u};
            if (tt < 62 && tok >= 0) { const bf16_t* rp = H0 + ((size_t)b * SEQ + tok) * HW + 1536 + lane * 8; av[i] = *(const u32x4*)rp; gv8[i] = *(const u32x4*)(rp + 512); } }
#pragma unroll
        for (int i = 0; i < 8; ++i) { const int tt = w + 8 * i; const u32x4 a = av[i], g = gv8[i]; u32x4 o;
            o.x = pk2(bflo(a.x) * sigmoidf_(bflo(g.x)), bfhi(a.x) * sigmoidf_(bfhi(g.x)));
            o.y = pk2(bflo(a.y) * sigmoidf_(bflo(g.y)), bfhi(a.y) * sigmoidf_(bfhi(g.y)));
            o.z = pk2(bflo(a.z) * sigmoidf_(bflo(g.z)), bfhi(a.z) * sigmoidf_(bfhi(g.z)));
            o.w = pk2(bflo(a.w) * sigmoidf_(bflo(g.w)), bfhi(a.w) * sigmoidf_(bfhi(g.w)));
            if (tt < 62) *(LAS u32x4*)(hL + tt * 512 + lane * 8) = o; }
    }
    __syncthreads();
    {
        const int c = tid;
        float hv[62];
#pragma unroll
        for (int i = 0; i < 62; ++i) hv[i] = bf2f((unsigned)hL[i * 512 + c]);
#pragma unroll
        for (int tq = 0; tq < 32; ++tq) { float y = bias;
#pragma unroll
            for (int k = 0; k < 31; ++k) y += hv[tq + k] * wd[k];
            yL[tq * 512 + c] = y; }
    }
    __syncthreads();
    {
#pragma unroll
        for (int i = 0; i < 4; ++i) { const int tq = 4 * w + i;
            f32x4 v0 = *(const LAS f32x4*)(yL + tq * 512 + lane * 8), v1 = *(const LAS f32x4*)(yL + tq * 512 + lane * 8 + 4);
            const float mean = wave_sum((v0.x + v0.y) + (v0.z + v0.w) + (v1.x + v1.y) + (v1.z + v1.w)) * (1.f / 512.f);
            v0 = v0 - mean; v1 = v1 - mean;
            const float var = wave_sum((v0.x * v0.x + v0.y * v0.y) + (v0.z * v0.z + v0.w * v0.w) + (v1.x * v1.x + v1.y * v1.y) + (v1.z * v1.z + v1.w * v1.w)) * (1.f / 512.f);
            const float rstd = rsqrtf(var + LN_EPS);
            v0 = v0 * rstd * g0 + b0; v1 = v1 * rstd * g1 + b1;
            u32x4 o; o.x = pk2(siluf_(v0.x), siluf_(v0.y)); o.y = pk2(siluf_(v0.z), siluf_(v0.w)); o.z = pk2(siluf_(v1.x), siluf_(v1.y)); o.w = pk2(siluf_(v1.z), siluf_(v1.w));
            *(u32x4*)(MIX + ((size_t)b * SEQ + t0 + tq) * DM + 512 + lane * 8) = o; }
    }
    __syncthreads();
}

__device__ __forceinline__ void compress_unit(const Params& p, LAS unsigned char* lds8, int b, int g, int kv, int nt) {
    LAS char* lds = (LAS char*)lds8;
    const int tid = opaque_tid(), lane = tid & 63, w = __builtin_amdgcn_readfirstlane(tid >> 6), r32 = lane & 31, hi = lane >> 5;
    const bf16_t* H1 = (const bf16_t*)(p.ws + WS_H);
    const float* w2 = p.in[kv ? 13 : 10];
    const bf16_t* w1t = (const bf16_t*)(p.ws + (kv ? WS_W1TV : WS_W1TK));
    bf16_t* outp = (bf16_t*)(p.ws + (kv ? WS_VCMP : WS_KCMP)) + (size_t)((b * 2 + g) * 128 + 32 * nt) * 64;
    constexpr int L_SLAB = 0, L_PART = 76032, L_PT = 76032 + 65536;
    LAS float* partL = (LAS float*)(lds + L_PART); const float* ptg = (const float*)(p.ws + WS_PT) + kv * 512;
    const int col = 512 + kv * 128 + g * 64;
#pragma unroll
    for (int it9 = 0; it9 < 9; ++it9) { const int idx = tid + 512 * it9; if (idx >= 528 * 8) break; const int i = idx >> 3, ch = idx & 7, tok = 512 * nt + i;
        u32x4 v = (u32x4){0u, 0u, 0u, 0u};
        if (tok < SEQ) v = *(const u32x4*)(H1 + ((size_t)b * SEQ + tok) * HW + col + ch * 8);
        *(LAS u32x4*)(lds + L_SLAB + ((i & 15) * 33 + (i >> 4)) * KS + ch * 16) = v; }
    __syncthreads();
    f32x16 acc[2];
#pragma unroll
    for (int i = 0; i < 16; ++i) { acc[0][i] = 0.f; acc[1][i] = 0.f; }
#pragma unroll
    for (int li = 0; li < 4; ++li) { const int l = 4 * w + li, c = l & 15, mo = l >> 4;
        const LAS char* ap = lds + L_SLAB + (c * 33 + r32 + mo) * KS + hi * 16;
        const bf16_t* bp = w1t + (size_t)r32 * 2048 + l * 64 + 8 * hi;
#pragma unroll
        for (int d0 = 0; d0 < 4; ++d0) { const bf16x8 a = *(const LAS bf16x8*)(ap + d0 * 32);
            const bf16x8 b0 = *(const bf16x8*)(bp + 16 * d0), b1 = *(const bf16x8*)(bp + (size_t)32 * 2048 + 16 * d0);
            acc[0] = MFMA32(a, b0, acc[0]); acc[1] = MFMA32(a, b1, acc[1]); } }
#pragma unroll
    for (int r = 0; r < 16; ++r) { const int n = crow(r, hi); partL[(w * 32 + n) * 64 + r32] = acc[0][r]; partL[(w * 32 + n) * 64 + 32 + r32] = acc[1][r]; }
    __syncthreads();
    LAS float* hidL = (LAS float*)(lds + L_SLAB);
    LAS float* w2L = (LAS float*)(lds + L_SLAB + 8448);
    { const f32x4 wa = ((const f32x4*)w2)[tid], wb = ((const f32x4*)w2)[tid + 512]; *(LAS f32x4*)(w2L + tid * 4) = wa; *(LAS f32x4*)(w2L + (tid + 512) * 4) = wb; }
#pragma unroll
    for (int i = 0; i < 4; ++i) { const int idx = tid + 512 * i, n = idx >> 6, e = idx & 63; float s = 0.f;
#pragma unroll
        for (int ww = 0; ww < 8; ++ww) s += partL[(ww * 32 + n) * 64 + e];
        const float pt = ((ptg[e] + ptg[64 + e]) + (ptg[128 + e] + ptg[192 + e])) + ((ptg[256 + e] + ptg[320 + e]) + (ptg[384 + e] + ptg[448 + e]));
        hidL[n * 65 + e] = gelu_tanh(s + pt); }
    __syncthreads();
    { const int n = tid >> 4, e2 = (tid & 15) * 4; float o0 = 0.f, o1 = 0.f, o2 = 0.f, o3 = 0.f;
#pragma unroll 8
      for (int e = 0; e < 64; ++e) { const float hval = hidL[n * 65 + e]; const f32x4 wv = *(const LAS f32x4*)(w2L + e * 64 + e2);
          o0 += hval * wv.x; o1 += hval * wv.y; o2 += hval * wv.z; o3 += hval * wv.w; }
      u32x2 ov; ov.x = pk2(o0, o1); ov.y = pk2(o2, o3);
      if (32 * nt + n >= 127) { ov.x = 0u; ov.y = 0u; }
      *(u32x2*)(outp + (size_t)n * 64 + e2) = ov; }
    __syncthreads();
}

__device__ __forceinline__ void gmlp_unit(const Params& p, LAS unsigned char* lds8, int b, int ch) {
    LAS char* lds = (LAS char*)lds8;
    const int tid = opaque_tid(), lane = tid & 63, w = __builtin_amdgcn_readfirstlane(tid >> 6), r32 = lane & 31, hi = lane >> 5;
    const bf16_t* H1 = (const bf16_t*)(p.ws + WS_H);
    bf16_t* MIX = (bf16_t*)(p.ws + WS_MIX);
    const bf16_t* TR = (const bf16_t*)(p.ws + WS_TRIL);
    constexpr int VS = 1040;
    const size_t row0 = (size_t)b * SEQ + 128 * ch;
    {
        const f32x4 g0 = ((const f32x4*)p.in[14])[lane * 2], g1 = ((const f32x4*)p.in[14])[lane * 2 + 1];
        const f32x4 b0 = ((const f32x4*)p.in[15])[lane * 2], b1 = ((const f32x4*)p.in[15])[lane * 2 + 1];
        for (int tq0 = w; tq0 < 128; tq0 += 64) {
            u32x4 raw4[8];
#pragma unroll
            for (int i = 0; i < 8; ++i) raw4[i] = *(const u32x4*)(H1 + (row0 + tq0 + 8 * i) * HW + 1792 + lane * 8);
#pragma unroll
            for (int i = 0; i < 8; ++i) { const int tq = tq0 + 8 * i; const u32x4 raw = raw4[i];
            f32x4 v0, v1;
            v0.x = gelu_tanh(bflo(raw.x)); v0.y = gelu_tanh(bfhi(raw.x)); v0.z = gelu_tanh(bflo(raw.y)); v0.w = gelu_tanh(bfhi(raw.y));
            v1.x = gelu_tanh(bflo(raw.z)); v1.y = gelu_tanh(bfhi(raw.z)); v1.z = gelu_tanh(bflo(raw.w)); v1.w = gelu_tanh(bfhi(raw.w));
            const float mean = wave_sum((v0.x + v0.y) + (v0.z + v0.w) + (v1.x + v1.y) + (v1.z + v1.w)) * (1.f / 512.f);
            v0 = v0 - mean; v1 = v1 - mean;
            const float var = wave_sum((v0.x * v0.x + v0.y * v0.y) + (v0.z * v0.z + v0.w * v0.w) + (v1.x * v1.x + v1.y * v1.y) + (v1.z * v1.z + v1.w * v1.w)) * (1.f / 512.f);
            const float rstd = rsqrtf(var + LN_EPS);
            v0 = v0 * rstd * g0 + b0; v1 = v1 * rstd * g1 + b1;
            u32x4 o; o.x = pk2(v0.x, v0.y); o.y = pk2(v0.z, v0.w); o.z = pk2(v1.x, v1.y); o.w = pk2(v1.z, v1.w);
            *(LAS u32x4*)(lds + tq * VS + lane * 16) = o; }
        }
    }
    __syncthreads();
    const int gi = w >> 1, th = w & 1;
    f32x16 acc[2][4];
#pragma unroll
    for (int a = 0; a < 2; ++a)
#pragma unroll
        for (int d = 0; d < 4; ++d)
#pragma unroll
            for (int i = 0; i < 16; ++i) acc[a][d][i] = 0.f;
    const bf16_t* ap = TR + (size_t)(gi * 128 + 64 * th + r32) * 128 + 8 * hi;
    const LAS char* vp = lds + (8 * hi + ((lane & 15) >> 2)) * VS + (128 * gi + 16 * ((lane >> 4) & 1) + 4 * (lane & 3)) * 2;
    const int nks = 4 * th + 4;
    for (int ks = 0; ks < nks; ++ks) {
        const bf16x8 a0 = *(const bf16x8*)(ap + 16 * ks), a1 = *(const bf16x8*)(ap + 32 * 128 + 16 * ks);
#pragma unroll
        for (int db = 0; db < 4; ++db) {
            const s16x4 lo = vtr(vp + (16 * ks) * VS + db * 64), hi4 = vtr(vp + (16 * ks + 4) * VS + db * 64);
            const bf16x8 vb = (bf16x8){lo[0], lo[1], lo[2], lo[3], hi4[0], hi4[1], hi4[2], hi4[3]};
            acc[0][db] = MFMA32(a0, vb, acc[0][db]); acc[1][db] = MFMA32(a1, vb, acc[1][db]);
        }
    }
    __syncthreads();
    {
        const float* bs = p.in[17] + gi * 128;
        LAS float* st = (LAS float*)(lds + w * 16896);
        const int rrow = lane >> 4, c8 = (lane & 15) * 8;
#pragma unroll
        for (int tb = 0; tb < 2; ++tb) {
#pragma unroll
            for (int r = 0; r < 16; ++r) { const int q = crow(r, hi); const float bias = bs[64 * th + 32 * tb + q];
#pragma unroll
                for (int db = 0; db < 4; ++db) st[q * 132 + 32 * db + r32] = acc[tb][db][r] + bias; }
            LDSW();
#pragma unroll
            for (int i = 0; i < 8; ++i) { const int row = 4 * i + rrow, tq = 64 * th + 32 * tb + row;
                const f32x4 m0 = *(const LAS f32x4*)(st + row * 132 + c8), m1 = *(const LAS f32x4*)(st + row * 132 + c8 + 4);
                const u32x4 uu = *(const u32x4*)(H1 + (row0 + tq) * HW + 1280 + 128 * gi + c8);
                u32x4 o; o.x = pk2(gelu_tanh(bflo(uu.x)) * m0.x, gelu_tanh(bfhi(uu.x)) * m0.y); o.y = pk2(gelu_tanh(bflo(uu.y)) * m0.z, gelu_tanh(bfhi(uu.y)) * m0.w);
                o.z = pk2(gelu_tanh(bflo(uu.z)) * m1.x, gelu_tanh(bfhi(uu.z)) * m1.y); o.w = pk2(gelu_tanh(bflo(uu.w)) * m1.z, gelu_tanh(bfhi(uu.w)) * m1.w);
                *(u32x4*)(MIX + (row0 + tq) * DM + 512 + 128 * gi + c8) = o; }
            LDSW();
        }
    }
    __syncthreads();
}

template <int MODE>
__device__ __forceinline__ void nsa_tile(float& m, float& l, f32x16 (&o)[2], const LAS char* kt, const LAS char* vt, LAS float* wsf_w, const bf16x8 (&qr)[4],
                                         int j, unsigned selm, int t, int twmin, int twmax, int lane) {
    const int r32 = lane & 31, hi = lane >> 5;
    const bool selected = (MODE == 1) ? (((selm >> j) & 1u) != 0u) : true;
    if (64 * j + 63 <= twmin && (MODE == 1 || 64 * j >= twmax - 511)) {
        if (MODE == 1 && !__any(selected)) return;
        bf16x8 kf[8];
        { const LAS char* kp = kt + r32 * KS + hi * 16;
#pragma unroll
          for (int i = 0; i < 8; ++i) kf[i] = *(const LAS bf16x8*)(kp + (i >> 2) * (32 * KS) + (i & 3) * 32); }
        __builtin_amdgcn_sched_barrier(0);
        f32x16 s0, s1;
#pragma unroll
        for (int i = 0; i < 16; ++i) { s0[i] = 0.f; s1[i] = 0.f; }
#pragma unroll
        for (int d0 = 0; d0 < 4; ++d0) { s0 = MFMA32(kf[d0], qr[d0], s0); s1 = MFMA32(kf[4 + d0], qr[d0], s1); }
        s16x4 vf[16];
        { const LAS char* vp = vt + (4 * hi + ((lane & 15) >> 2)) * KS + (16 * ((lane >> 4) & 1) + 4 * (lane & 3)) * 2;
#pragma unroll
          for (int i = 0; i < 16; ++i) { const int sub = i >> 3, ss = (i >> 2) & 1, db = (i >> 1) & 1, jj = i & 1;
              vf[i] = vtr(vp + (32 * sub + 16 * ss + 8 * jj) * KS + db * 64); } }
        __builtin_amdgcn_sched_barrier(0);
        float mx = fmaxf(fmaxf(s0[0], s0[1]), fmaxf(s1[0], s1[1]));
#pragma unroll
        for (int r = 2; r < 16; r += 2) mx = fmaxf(mx, fmaxf(fmaxf(s0[r], s0[r + 1]), fmaxf(s1[r], s1[r + 1])));
        mx *= C2; mx = fmaxf(mx, xor32(mx));
        const float cand = selected ? mx : -1e30f;
        if (__any(cand > m + 8.f)) {
            const float mn = fmaxf(m, cand), f = __builtin_amdgcn_exp2f(m - mn);
            l *= f; m = mn;
            float fr[16]; bcast_rows(fr, wsf_w, f, r32, hi);
#pragma unroll
            for (int r = 0; r < 16; ++r) { o[0][r] *= fr[r]; o[1][r] *= fr[r]; }
        }
        const float nme = selected ? -m : -1e30f;
        f32x16 p0, p1; float ls0 = 0.f, ls1 = 0.f, ls2 = 0.f, ls3 = 0.f;
#pragma unroll
        for (int r = 0; r < 16; r += 2) { p0[r] = __builtin_amdgcn_exp2f(__builtin_fmaf(s0[r], C2, nme)); ls0 += p0[r]; p0[r + 1] = __builtin_amdgcn_exp2f(__builtin_fmaf(s0[r + 1], C2, nme)); ls1 += p0[r + 1];
            p1[r] = __builtin_amdgcn_exp2f(__builtin_fmaf(s1[r], C2, nme)); ls2 += p1[r]; p1[r + 1] = __builtin_amdgcn_exp2f(__builtin_fmaf(s1[r + 1], C2, nme)); ls3 += p1[r + 1]; }
        l += (ls0 + ls1) + (ls2 + ls3);
#pragma unroll
        for (int i = 0; i < 4; ++i) { const int sub = i >> 1, ss = i & 1; const f32x16& pp = sub ? p1 : p0;
            u32x4 pw; pw.x = pk2(pp[8 * ss + 0], pp[8 * ss + 1]); pw.y = pk2(pp[8 * ss + 2], pp[8 * ss + 3]); pw.z = pk2(pp[8 * ss + 4], pp[8 * ss + 5]); pw.w = pk2(pp[8 * ss + 6], pp[8 * ss + 7]);
            const bf16x8 pa = __builtin_bit_cast(bf16x8, pw);
#pragma unroll
            for (int db = 0; db < 2; ++db) { const s16x4 lo = vf[i * 4 + db * 2], h4 = vf[i * 4 + db * 2 + 1];
                const bf16x8 vb = (bf16x8){lo[0], lo[1], lo[2], lo[3], h4[0], h4[1], h4[2], h4[3]};
                o[db] = MFMA32(pa, vb, o[db]); } }
        return;
    }
#pragma unroll 1
    for (int sub = 0; sub < 2; ++sub) {
        const int kvb = 64 * j + 32 * sub;
        if (kvb > twmax) continue;
        if (MODE == 2 && kvb + 31 + 512 <= twmin) continue;
        if (MODE == 1 && !__any(selected)) continue;
        const f32x16 s = qk_sub(kt, sub, qr, r32, hi);
        const bool need_mask = (kvb + 31 > twmin) || (MODE == 2 && kvb < twmax - 511);
        f32x16 pw; float ls = 0.f;
        if (!need_mask) {
            float mx = fmaxf(fmaxf(s[0], s[1]), fmaxf(s[2], s[3]));
#pragma unroll
            for (int r = 4; r < 16; r += 4) mx = fmaxf(mx, fmaxf(fmaxf(s[r], s[r + 1]), fmaxf(s[r + 2], s[r + 3])));
            mx *= C2; mx = fmaxf(mx, xor32(mx));
            const float cand = selected ? mx : -1e30f;
            if (__any(cand > m + 8.f)) {
                const float mn = fmaxf(m, cand), f = __builtin_amdgcn_exp2f(m - mn);
                l *= f; m = mn;
                float fr[16]; bcast_rows(fr, wsf_w, f, r32, hi);
#pragma unroll
                for (int r = 0; r < 16; ++r) { o[0][r] *= fr[r]; o[1][r] *= fr[r]; }
            }
            const float nme = selected ? -m : -1e30f;
#pragma unroll
            for (int r = 0; r < 16; ++r) { pw[r] = __builtin_amdgcn_exp2f(__builtin_fmaf(s[r], C2, nme)); ls += pw[r]; }
        } else {
            float s2[16]; float mx = -1e30f;
#pragma unroll
            for (int r = 0; r < 16; ++r) { const int kv = kvb + crow(r, hi);
                const bool valid = (kv <= t) && ((MODE == 1) ? selected : (t - kv < 512));
                s2[r] = valid ? s[r] * C2 : -1e30f; mx = fmaxf(mx, s2[r]); }
            mx = fmaxf(mx, xor32(mx));
            if (__any(mx > m + 8.f)) {
                const float mn = fmaxf(m, mx), f = __builtin_amdgcn_exp2f(m - mn);
                l *= f; m = mn;
                float fr[16]; bcast_rows(fr, wsf_w, f, r32, hi);
#pragma unroll
                for (int r = 0; r < 16; ++r) { o[0][r] *= fr[r]; o[1][r] *= fr[r]; }
            }
#pragma unroll
            for (int r = 0; r < 16; ++r) { const float e = __builtin_amdgcn_exp2f(s2[r] - m); pw[r] = (s2[r] > -1e29f) ? e : 0.f; ls += pw[r]; }
        }
        l += ls;
        pv_sub(o, pw, vt, sub, lane);
    }
}
template <int MODE, bool FINAL>
__device__ __forceinline__ void nsa_branch(LAS float* accw, bf16_t* gout, LAS char* lds, const bf16_t* kg, const bf16_t* vg, unsigned todo, const bf16x8 (&qr)[4],
                                           float gate, unsigned selm, int t, int twmin, int twmax, int tid, int lane, int w) {
    const int r32 = lane & 31, hi = lane >> 5, lrow = tid >> 3, lch = tid & 7;
    LAS float* wsf_w = (LAS float*)(lds + L_WSF) + w * 32;
    float m = -1e30f, l = 0.f;
    f32x16 o[2];
#pragma unroll
    for (int i = 0; i < 16; ++i) { o[0][i] = 0.f; o[1][i] = 0.f; }
    const bf16_t* kgl = kg + (size_t)lrow * HW + lch * 8; const bf16_t* vgl = vg + (size_t)lrow * HW + lch * 8;
    LAS char* kw0 = lds + L_K + lrow * KS + lch * 16; LAS char* vw0 = lds + L_V + lrow * KS + lch * 16;
#define NSA_POP(jv) do { jv = (MODE == 1) ? __builtin_ctz(todo) : 31 - __builtin_clz(todo); todo &= ~(1u << jv); } while (0)
#define NSA_LOAD(KR, VR, jv) do { const bf16_t* kp_ = kgl + (size_t)(64 * (jv)) * HW; const bf16_t* vp_ = vgl + (size_t)(64 * (jv)) * HW; \
        asm volatile("global_load_dwordx4 %0, %2, off\n\tglobal_load_dwordx4 %1, %3, off" : "=&v"(KR), "=&v"(VR) : "v"(kp_), "v"(vp_) : "memory"); } while (0)
#define NSA_WAIT(KR, VR) asm volatile("s_waitcnt vmcnt(2)" : "+v"(KR), "+v"(VR) : : "memory")
    u32x4 kA, vA, kB, vB;
    int j0, j1, jl; bool h1;
    NSA_POP(j0); NSA_LOAD(kA, vA, j0); jl = j0;
    h1 = todo != 0u; if (h1) { NSA_POP(j1); jl = j1; } else j1 = jl;
    NSA_LOAD(kB, vB, j1);
    for (;;) {
        NSA_WAIT(kA, vA);
        *(LAS u32x4*)kw0 = kA; *(LAS u32x4*)vw0 = vA;
        __syncthreads();
        int j2; const bool h2 = h1 && todo != 0u; if (h2) { NSA_POP(j2); jl = j2; } else j2 = jl;
        NSA_LOAD(kA, vA, j2);
        nsa_tile<MODE>(m, l, o, lds + L_K, lds + L_V, wsf_w, qr, j0, selm, t, twmin, twmax, lane);
        if (!h1) break;
        NSA_WAIT(kB, vB);
        *(LAS u32x4*)(kw0 + TILEB) = kB; *(LAS u32x4*)(vw0 + TILEB) = vB;
        __syncthreads();
        int j3; const bool h3 = h2 && todo != 0u; if (h3) { NSA_POP(j3); jl = j3; } else j3 = jl;
        NSA_LOAD(kB, vB, j3);
        nsa_tile<MODE>(m, l, o, lds + L_K + TILEB, lds + L_V + TILEB, wsf_w, qr, j1, selm, t, twmin, twmax, lane);
        if (!h2) break;
        j0 = j2; j1 = j3; h1 = h3;
    }
    asm volatile("s_waitcnt vmcnt(0)" : "+v"(kA), "+v"(vA), "+v"(kB), "+v"(vB) : : "memory");
#undef NSA_POP
#undef NSA_LOAD
#undef NSA_WAIT
    __syncthreads();
    l += xor32(l);
    const float fac = (l > 0.f) ? gate / l : 0.f;
    float fr[16]; bcast_rows(fr, wsf_w, fac, r32, hi);
    if (!FINAL) {
#pragma unroll
        for (int r = 0; r < 16; ++r) { const int q = crow(r, hi); accw[q * 64 + r32] += o[0][r] * fr[r]; accw[q * 64 + 32 + r32] += o[1][r] * fr[r]; }
    } else {
#pragma unroll
        for (int r = 0; r < 16; ++r) { const int q = crow(r, hi); bf16_t* gq_ = gout + (size_t)(q & 7) * DM + (q >> 3) * 64;
            gq_[0] = (bf16_t)f2bf(accw[q * 64 + r32] + o[0][r] * fr[r]); gq_[32] = (bf16_t)f2bf(accw[q * 64 + 32 + r32] + o[1][r] * fr[r]); }
    }
    LDSW();
}

__device__ __forceinline__ void nsa_unit(const Params& p, LAS unsigned char* lds8, int b, int g, int qb) {
    LAS char* lds = (LAS char*)lds8;
    const int tid = opaque_tid(), lane = tid & 63, w = __builtin_amdgcn_readfirstlane(tid >> 6), r32 = lane & 31, hi = lane >> 5;
    const int rh = r32 >> 3, tl = 8 * w + (r32 & 7);
    const bf16_t* H1 = (const bf16_t*)(p.ws + WS_H);
    bf16_t* MIX = (bf16_t*)(p.ws + WS_MIX);
    const size_t rowbase = (size_t)b * SEQ;
    const int t0 = 64 * qb, t = t0 + tl, twmin = t0 + 8 * w, twmax = twmin + 7;
    LAS float* wsf_w = (LAS float*)(lds + L_WSF) + w * 32;
    LAS float* impL = (LAS float*)(lds + L_IMP);
    LAS unsigned* selL = (LAS unsigned*)(lds + L_SEL);
    bf16x8 qr[4];
    float g0, g1, g2;
    { const bf16_t* qp = H1 + (rowbase + t) * HW + (g * 4 + rh) * 64;
#pragma unroll
      for (int d0 = 0; d0 < 4; ++d0) qr[d0] = *(const bf16x8*)(qp + 16 * d0 + 8 * hi);
      const bf16_t* gp = H1 + (rowbase + t) * HW + 2304 + (g * 4 + rh) * 3;
      g0 = sigmoidf_(bf2f((unsigned)gp[0])); g1 = sigmoidf_(bf2f((unsigned)gp[1])); g2 = sigmoidf_(bf2f((unsigned)gp[2])); }
    LAS float* accw = (LAS float*)(lds + L_OACC) + w * 2048;
    bf16_t* gout = MIX + (rowbase + t0 + 8 * w) * DM + (g * 4) * 64 + r32;
    {
        const bf16_t* kc = (const bf16_t*)(p.ws + WS_KCMP) + (size_t)(b * 2 + g) * 128 * 64;
        const bf16_t* vc = (const bf16_t*)(p.ws + WS_VCMP) + (size_t)(b * 2 + g) * 128 * 64;
#pragma unroll
        for (int i = 0; i < 2; ++i) { const int idx = tid + 512 * i, row = idx >> 3, ch = idx & 7;
            *(LAS u32x4*)(lds + L_K + row * KS + ch * 16) = *(const u32x4*)(kc + row * 64 + ch * 8);
            *(LAS u32x4*)(lds + L_V + row * KS + ch * 16) = *(const u32x4*)(vc + row * 64 + ch * 8); }
        __syncthreads();
        const int nmax = (t - 31) >> 4;
        const int nmaxw = (twmax - 31) >> 4;
        float m = -1e30f, l = 0.f;
#pragma unroll 1
        for (int sb = 0; sb < 4; ++sb) {
            if (32 * sb > nmaxw) break;
            const f32x16 s = qk_sub(lds + L_K, sb, qr, r32, hi);
            float s2[16]; float mx = m;
#pragma unroll
            for (int r = 0; r < 16; ++r) { const int n = 32 * sb + crow(r, hi); s2[r] = (n <= nmax) ? s[r] * C2 : -1e30f; mx = fmaxf(mx, s2[r]); }
            l *= __builtin_amdgcn_exp2f(m - mx); m = mx;
#pragma unroll
            for (int r = 0; r < 16; ++r) { const float e = __builtin_amdgcn_exp2f(s2[r] - m); l += (s2[r] > -1e29f) ? e : 0.f; }
        }
        { const float mt = fmaxf(m, xor32(m)); l *= __builtin_amdgcn_exp2f(m - mt); m = mt; l += xor32(l); }
        const float inv = (l > 0.f) ? 1.f / l : 0.f;
        f32x16 o[2];
#pragma unroll
        for (int i = 0; i < 16; ++i) { o[0][i] = 0.f; o[1][i] = 0.f; }
        LAS float* ip = impL + ((rh * 64) + tl) * 33 + hi; float lprev = 0.f;
#pragma unroll 1
        for (int sb = 0; sb < 4; ++sb) {
            if (32 * sb > nmaxw) {
#pragma unroll
                for (int gq = 0; gq < 4; ++gq) ip[2 * (4 * sb + gq)] = (hi == 0 && gq == 0) ? lprev : 0.f;
                lprev = 0.f; continue; }
            const f32x16 s = qk_sub(lds + L_K, sb, qr, r32, hi);
            f32x16 pw;
#pragma unroll
            for (int r = 0; r < 16; ++r) { const int n = 32 * sb + crow(r, hi); const float e = __builtin_amdgcn_exp2f(s[r] * C2 - m) * inv; pw[r] = (n <= nmax) ? e : 0.f; }
#pragma unroll
            for (int gq = 0; gq < 4; ++gq) {
                const float Gv = (pw[4 * gq] + pw[4 * gq + 1]) + (pw[4 * gq + 2] + pw[4 * gq + 3]);
                const float lcur = xor32(pw[4 * gq + 3]);
                ip[2 * (4 * sb + gq)] = Gv + (hi ? lcur : lprev); lprev = lcur; }
            pv_sub(o, pw, lds + L_V, sb, lane);
        }
        float fr[16]; bcast_rows(fr, wsf_w, g0, r32, hi);
#pragma unroll
        for (int r = 0; r < 16; ++r) { const int q = crow(r, hi); accw[q * 64 + r32] = o[0][r] * fr[r]; accw[q * 64 + 32 + r32] = o[1][r] * fr[r]; }
    }
    __syncthreads();
#ifndef XTOPK
    { const int tok = tid >> 3, j0 = (tid & 7) * 4;
#pragma unroll
      for (int jj = 0; jj < 4; ++jj) { LAS float* q0 = impL + tok * 33 + j0 + jj; q0[0] = ((q0[0] + q0[64 * 33]) + q0[2 * 64 * 33]) + q0[3 * 64 * 33]; } }
    __syncthreads();
    if (w == 0) {
        float sc[32];
#pragma unroll
        for (int jj = 0; jj < 32; ++jj) { const float v = impL[lane * 33 + jj];
            const bool forced = (jj == 0) || (jj == qb) || (jj == qb - 1);
            sc[jj] = (jj <= qb) ? v + (forced ? 1000.f : 0.f) : -1e30f; }
        unsigned mask = 0u;
        if (qb < 8) mask = (2u << qb) - 1u;
        else {
#pragma unroll 1
            for (int k = 0; k < 8; ++k) { float best = -3e38f; int bj = 0;
#pragma unroll
                for (int jj = 0; jj < 32; ++jj) { const float v = ((mask >> jj) & 1u) ? -3e38f : sc[jj]; if (v > best) { best = v; bj = jj; } }
                mask |= 1u << bj; }
        }
        selL[lane] = mask;
        unsigned un = mask;
#pragma unroll
        for (int o = 1; o < 64; o <<= 1) un |= (unsigned)__shfl_xor((int)un, o);
        if (lane == 0) selL[64] = un;
    }
#endif
    __syncthreads();
    const unsigned selm = selL[tl], uni = selL[64];
#ifndef XSEL
    { const unsigned vmask = (qb >= 31) ? 0xffffffffu : ((2u << qb) - 1u);
      nsa_branch<1, false>(accw, gout, lds, H1 + rowbase * HW + 768 + g * 64, H1 + rowbase * HW + 896 + g * 64, (uni & vmask) | 1u, qr, g1, selm, t, twmin, twmax, tid, lane, w);
#ifdef PROBE_SEL
      nsa_branch<1, false>(accw, gout, lds, H1 + rowbase * HW + 768 + g * 64, H1 + rowbase * HW + 896 + g * 64, (uni & vmask) | 1u, qr, 0.f, selm, t, twmin, twmax, tid, lane, w);
#endif
    }
#endif
#ifndef XWIN
    { const int lo = qb > 8 ? qb - 8 : 0; const unsigned vmask = (qb >= 31) ? 0xffffffffu : ((2u << qb) - 1u); const unsigned todo = vmask & ~((1u << lo) - 1u);
#ifdef PROBE_WIN
      nsa_branch<2, false>(accw, gout, lds, H1 + rowbase * HW + 1024 + g * 64, H1 + rowbase * HW + 1152 + g * 64, todo, qr, 0.f, 0u, t, twmin, twmax, tid, lane, w);
#endif
      nsa_branch<2, true>(accw, gout, lds, H1 + rowbase * HW + 1024 + g * 64, H1 + rowbase * HW + 1152 + g * 64, todo, qr, g2, 0u, t, twmin, twmax, tid, lane, w); }
#endif
}

__global__ void __launch_bounds__(512, 2) fwd_megakernel(Params p) {
    extern __shared__ __attribute__((aligned(16))) unsigned char lds_raw[];
    LAS unsigned char* lds = (LAS unsigned char*)lds_raw;
    cg::grid_group grid = cg::this_grid();
    unsigned char* ws = p.ws;
    bf16_t* XB = (bf16_t*)(ws + WS_XB); bf16_t* HB = (bf16_t*)(ws + WS_H); bf16_t* MIX = (bf16_t*)(ws + WS_MIX); bf16_t* MB = (bf16_t*)(ws + WS_MB);
    const int G = gridDim.x, bx = blockIdx.x;
    const int vcu = (G % 8 == 0) ? (bx % 8) * (G / 8) + bx / 8 : bx;
    LAS unsigned* misc = (LAS unsigned*)(lds + LDS_BYTES - 64);
    if (threadIdx.x < 16) misc[threadIdx.x] = 0u;
    __syncthreads();
    XcdBarrier bar = xcd_barrier_post((unsigned*)(ws + WS_CTL), (volatile LAS unsigned*)misc);
    if (G == 0x7fffffff) grid.sync();
#define GSYNC() do { for (int rep_ = 0; rep_ < REP_SYNC; ++rep_) xcd_barrier(bar); } while (0)
#define LSYNC() do { if (loc_ok) xcd_barrier_local(bar); else xcd_barrier(bar); } while (0)
#define QSYNC() do { if (loc_ok) quad_barrier(bar, (unsigned)((bx & 7) * 8 + ((bx >> 3) & 7))); else xcd_barrier(bar); } while (0)
    unsigned* xcctab = (unsigned*)(ws + WS_CTL) + 16384; unsigned* xccflag = (unsigned*)(ws + WS_CTL) + 20480;
    if (threadIdx.x == 0) __hip_atomic_store(&xcctab[bx], bar.x + 1u, __ATOMIC_RELAXED, __HIP_MEMORY_SCOPE_AGENT);

    for (int rep = 0; rep < REP_PRO; ++rep) p0_prologue(p, lds);
    GSYNC();
    int bad_ = (G != 256) ? 1 : 0;
    if (G == 256 && threadIdx.x < 256) { const unsigned a_ = xb_ld(&xcctab[threadIdx.x]), r_ = xb_ld(&xcctab[threadIdx.x & 7]); bad_ = (a_ != r_ || a_ == 0u) ? 1 : 0; }
    const bool loc_ok = (__syncthreads_or(bad_) == 0);
    for (int rep = 0; rep < REP_IN; ++rep) run_gemm(lds, XB, (const bf16_t*)(ws + WS_IN0), 2560, 1024, EpiStore{HB, HW});
    LSYNC();
    for (int rep = 0; rep < REP_SB; ++rep)
    for (int u = vcu; u < 1024; u += G) { const int i = u >> 8, c = u & 255, bhp = c >> 2, s = c & 3;
        const int qb = (i == 0) ? s : (i == 1) ? 7 - s : (i == 2) ? 8 + s : 15 - s;
        sb_unit(p, lds, bhp >> 2, bhp & 3, qb); }
    for (int rep = 0; rep < REP_CONV; ++rep)
    if (G == 256) { for (int i = 0; i < 4; ++i) { const int lu = (vcu & 31) + 32 * i; conv_unit(p, lds, 2 * (vcu >> 5) + (lu >> 6), lu & 63); } }
    else for (int u = bx; u < 1024; u += G) conv_unit(p, lds, u >> 6, u & 63);
    LSYNC();
    run_gemm(lds, MIX, (const bf16_t*)(ws + WS_OUT0), 1024, 1024, EpiStore{MB, DM});
    QSYNC();
    for (int rep = 0; rep < REP_LN; ++rep) ln_phase<true, false>(p.in[0], XB, MB, p.in[22], p.in[23], p.out, XB);
    QSYNC();
    for (int rep = 0; rep < REP_GU; ++rep) run_gemm(lds, XB, (const bf16_t*)(ws + WS_GU0), 2 * FF, 1024, EpiSwiglu{HB, FF});
    QSYNC();
    for (int rep = 0; rep < REP_DN; ++rep) run_gemm(lds, HB, (const bf16_t*)(ws + WS_DN0), 1024, FF, EpiStore{MB, DM});
    QSYNC();
    ln_phase<false, false>(p.in[0], XB, MB, p.in[24], p.in[25], p.out, XB);
    QSYNC();
    run_gemm(lds, XB, (const bf16_t*)(ws + WS_IN1), 2560, 1024, EpiStore{HB, HW});
    LSYNC();
    for (int u = vcu; u < 256; u += G) compress_unit(p, lds, u >> 4, (u >> 3) & 1, (u >> 2) & 1, u & 3);
    if (loc_ok && G == 256) octet_barrier(bar, (unsigned)(vcu >> 3)); else xcd_barrier(bar);
    for (int u = vcu; u < 1024; u += G) { const int i = u >> 8, c = u & 255, bg = c >> 3, s = c & 7;
        const unsigned pk = (s == 0) ? 0x1F160A01u : (s == 1) ? 0x1D1A0B00u : (s == 2) ? 0x19131102u : (s == 3) ? 0x1B180803u
                          : (s == 4) ? 0x1E0F0D04u : (s == 5) ? 0x15120E06u : (s == 6) ? 0x17140907u : 0x1C100C05u;
        const int qb = (int)((pk >> (8 * i)) & 0xffu);
        nsa_unit(p, lds, bg >> 1, bg & 1, qb); }
    for (int u = vcu; u < 256; u += G) gmlp_unit(p, lds, u >> 4, u & 15);
    LSYNC();
    run_gemm(lds, MIX, (const bf16_t*)(ws + WS_OUT1), 1024, 1024, EpiStore{MB, DM});
    QSYNC();
    ln_phase<false, false>(p.in[0], XB, MB, p.in[22] + DM, p.in[23] + DM, p.out, XB);
    QSYNC();
    run_gemm(lds, XB, (const bf16_t*)(ws + WS_GU1), 2 * FF, 1024, EpiSwiglu{HB, FF});
    QSYNC();
    run_gemm(lds, HB, (const bf16_t*)(ws + WS_DN1), 1024, FF, EpiStore{MB, DM});
    QSYNC();
    ln_phase<false, true>(p.in[0], XB, MB, p.in[24] + DM, p.in[25] + DM, p.out, XB);
}

extern "C" void kernel_launch(void* const* d_in, const int* in_sizes, int n_in, void* d_out, int out_size, void* d_ws, size_t ws_size, hipStream_t stream) {
    static int grid = 0;
    if (grid == 0) {
        if (n_in != 26 || out_size != MTOK * DM || ws_size < WS_END) { fprintf(stderr, "kernel_launch: unexpected problem shape (n_in %d, out %d, ws %zu)\n", n_in, out_size, ws_size); grid = -1; return; }
        int dev = 0, cus = 0, per_cu = 0;
        hipGetDevice(&dev); hipDeviceGetAttribute(&cus, hipDeviceAttributeMultiprocessorCount, dev);
        hipFuncSetAttribute((const void*)fwd_megakernel, hipFuncAttributeMaxDynamicSharedMemorySize, LDS_BYTES);
        hipOccupancyMaxActiveBlocksPerMultiprocessor(&per_cu, (const void*)fwd_megakernel, 512, LDS_BYTES);
        (void)hipGetLastError();
        if (per_cu < 1) { fprintf(stderr, "kernel_launch: occupancy query says %d blocks per CU\n", per_cu); per_cu = 1; }
        grid = cus;
    }
    if (grid < 0) return;
    if (hipMemsetAsync((char*)d_ws + WS_CTL, 0, CTL_BYTES, stream) != hipSuccess) { fprintf(stderr, "kernel_launch: memset failed\n"); return; }
    Params prm{};
    for (int i = 0; i < 26; ++i) prm.in[i] = (const float*)d_in[i];
    prm.out = (float*)d_out; prm.ws = (unsigned char*)d_ws;
    void* args[] = {&prm};
    hipError_t e = hipLaunchCooperativeKernel((const void*)fwd_megakernel, dim3(grid), dim3(512), args, LDS_BYTES, stream);
    if (e != hipSuccess) fprintf(stderr, "cooperative launch failed: %s (grid %d)\n", hipGetErrorString(e), grid);
}
```

```cpp
#include <hip/hip_runtime.h>
#include <hip/hip_cooperative_groups.h>
#include <cstdio>
#include <cstdint>
namespace cg = cooperative_groups;
#define LAS __attribute__((address_space(3)))
namespace pg8 {
#define PG8_LAS __attribute__((address_space(3)))
typedef unsigned short bf16_t;
typedef short bf16x8 __attribute__((ext_vector_type(8)));
typedef float f32x4 __attribute__((ext_vector_type(4)));
typedef unsigned u32x4 __attribute__((ext_vector_type(4)));
constexpr int BM = 256, BK = 64, HALF = 128, HTB = HALF * BK * 2  , STAGE_BYTES = 8 * HTB, NXCD = 8, WGM = 8;

__host__ __device__ __forceinline__ int lds_byte(int r, int c) { const int st = (r >> 4) * 2 + (c >> 5), rr = r & 15, cc = c & 31, ob = rr * 64 + cc * 2; return st * 1024 + (ob ^ (((ob >> 9) & 1) << 5)); }
__host__ __device__ __forceinline__ void stage_rc(int b, int& R, int& C) { const int st = b / 1024, sb = b % 1024, swz = sb ^ (((sb >> 9) & 1) << 5); R = (st >> 1) * 16 + swz / 64; C = (st & 1) * 32 + (swz % 64) / 2; }
__host__ __device__ __forceinline__ int perm32(int rho) { const int n = rho >> 4, i = rho & 15; return 8 * (i >> 2) + 4 * n + (i & 3); }

struct Unit { int pm, pn; };
struct Gemm { const bf16_t* A; const bf16_t* Bt; int M, N, K; };

struct StaticOrder {
    int nM, nN, nwg, G, c;
    __host__ __device__ void init(int M, int N, int G_, int c_) { nM = M / BM; nN = N / BM; nwg = nM * nN; G = G_; c = c_; }
    __host__ __device__ bool next(int i, Unit& u) const {
        const long L = (long)i * G + c; if (L >= nwg) return false;
        int wgid = (int)L; { const int q = nwg / NXCD, r = nwg % NXCD, xcd = wgid % NXCD, off = wgid / NXCD; wgid = (xcd < r ? xcd * (q + 1) : r * (q + 1) + (xcd - r) * q) + off; }
        const int nig = WGM * nN, gid = wgid / nig, fm = gid * WGM, gsz = (nM - fm) < WGM ? (nM - fm) : WGM;
        u.pm = fm + ((wgid % nig) % gsz); u.pn = (wgid % nig) / gsz; return true;
    }
    __device__ __forceinline__ void a_ready(const Unit&) const {}
    __device__ __forceinline__ void done(const Unit&) const {}
};

__device__ __forceinline__ unsigned cvt_pk_bf16(float lo, float hi) { unsigned r; asm volatile("v_cvt_pk_bf16_f32 %0, %1, %2" : "=v"(r) : "v"(lo), "v"(hi)); return r; }
typedef float f32x2 __attribute__((ext_vector_type(2)));
__device__ __forceinline__ f32x2 gelu_pk(f32x2 v) {
    const f32x2 av = __builtin_elementwise_abs(v), d = av * 0.2316418882f + 1.0f;
    f32x2 t; t.x = __builtin_amdgcn_rcpf(d.x); t.y = __builtin_amdgcn_rcpf(d.y);
    f32x2 q = t * 0.5307027145f + (-0.7265760135f); q = q * t + 0.7107068705f; q = q * t + (-0.142248368f); q = q * t + 0.127414796f; q = q * t;
    const f32x2 s = (v * v) * (-0.72134752044f);
    f32x2 e; e.x = __builtin_amdgcn_exp2f(s.x); e.y = __builtin_amdgcn_exp2f(s.y);
    const f32x2 m = v * (q * e), r = v - m;
    f32x2 o; o.x = v.x < 0.f ? m.x : r.x; o.y = v.y < 0.f ? m.y : r.y; return o;
}

template <int ACT  > struct EpiBf16 {
    static constexpr bool PERM = true, AFTER_DRAIN = false; static_assert(ACT == 0 || ACT == 1, "EpiBf16: ACT is 0 (none) or 1 (gelu_pk)");
    bf16_t* O; int ldc; const float* bias; int split_cols; size_t split_stride; float scale0;
    __device__ __forceinline__ void operator()(const f32x4 (&acc)[2][2][4][2], const Unit& u, int wr, int wc, int fr, int fq) const {
        const int row0 = u.pm * BM + wr * 64 + fr; int colt = u.pn * BM; bf16_t* base = O;
        float sc = 1.f; if (split_cols) { const int t = colt / split_cols; base += (size_t)t * split_stride; colt -= t * split_cols; if (t == 0) sc = scale0; }
        const int col0 = colt + wc * 32 + 8 * fq, bcol0 = u.pn * BM + wc * 32 + 8 * fq;
        f32x4 bv[2][2];
#pragma unroll
        for (int bj = 0; bj < 2; ++bj)
#pragma unroll
            for (int n = 0; n < 2; ++n) bv[bj][n] = bias ? *(const f32x4*)(bias + bcol0 + bj * HALF + 4 * n) : (f32x4){0.f, 0.f, 0.f, 0.f};
#pragma unroll
        for (int ai = 0; ai < 2; ++ai)
#pragma unroll
            for (int m = 0; m < 4; ++m) { bf16_t* rowp = base + (size_t)(row0 + ai * HALF + m * 16) * ldc + col0;
#pragma unroll
                for (int bj = 0; bj < 2; ++bj) { f32x4 v0 = acc[ai][bj][m][0] + bv[bj][0], v1 = acc[ai][bj][m][1] + bv[bj][1];
                    if (ACT == 1) { f32x2 a = gelu_pk((f32x2){v0[0], v0[1]}), b = gelu_pk((f32x2){v0[2], v0[3]}), c = gelu_pk((f32x2){v1[0], v1[1]}), d = gelu_pk((f32x2){v1[2], v1[3]});
                        v0 = (f32x4){a.x, a.y, b.x, b.y}; v1 = (f32x4){c.x, c.y, d.x, d.y}; }
                    v0 = v0 * sc; v1 = v1 * sc; u32x4 w; w.x = cvt_pk_bf16(v0[0], v0[1]); w.y = cvt_pk_bf16(v0[2], v0[3]); w.z = cvt_pk_bf16(v1[0], v1[1]); w.w = cvt_pk_bf16(v1[2], v1[3]);
                    *(u32x4*)(rowp + bj * HALF) = w; } }
    }
};

struct PanelStats {
    unsigned* xbuf;
    unsigned* cnt;
    unsigned* tmo;
    int ntn; float eps;
    unsigned code;
    __device__ __forceinline__ bool run(const f32x4 (&v)[2][2][4][2], const Unit& u, int wr, int wc, int fr, int fq, PG8_LAS unsigned char* lds, int wid, int lane) const {
        typedef float f32x2v __attribute__((ext_vector_type(2)));
        PG8_LAS f32x2v* P = (PG8_LAS f32x2v*)lds;
        PG8_LAS f32x2v* S = (PG8_LAS f32x2v*)(lds + 8192);
        PG8_LAS unsigned* flag = (PG8_LAS unsigned*)(lds + 8192 + 2048);
#pragma unroll
        for (int ai = 0; ai < 2; ++ai)
#pragma unroll
            for (int m = 0; m < 4; ++m) {
                float s = 0.f;
#pragma unroll
                for (int bj = 0; bj < 2; ++bj)
#pragma unroll
                    for (int n = 0; n < 2; ++n) { const f32x4 x = v[ai][bj][m][n]; s += (x[0] + x[1]) + (x[2] + x[3]); }
                s += __shfl_xor(s, 16); s += __shfl_xor(s, 32);
                const float mw = s * (1.0f / 64.0f); float q = 0.f;
#pragma unroll
                for (int bj = 0; bj < 2; ++bj)
#pragma unroll
                    for (int n = 0; n < 2; ++n) { const f32x4 d = v[ai][bj][m][n] - mw; q += (d[0] * d[0] + d[1] * d[1]) + (d[2] * d[2] + d[3] * d[3]); }
                q += __shfl_xor(q, 16); q += __shfl_xor(q, 32);
                if (fq == 0) P[(ai * HALF + wr * 64 + m * 16 + fr) * 4 + wc] = (f32x2v){mw, q};
            }
        asm volatile("s_waitcnt lgkmcnt(0)" ::: "memory"); __builtin_amdgcn_s_barrier(); asm volatile("" ::: "memory");
#if defined(BROKEN_EXCHANGE_NO_WAIT)
#warning BROKEN CONTROL BUILD: the row-statistics exchange does not wait; results are wrong by design
        if (blockIdx.x >= 64) { const long long t0_ = clock64(); while (clock64() - t0_ < 60000) __builtin_amdgcn_s_sleep(8); }
#endif
        const int row = wid * 32 + (lane & 31);
        if (lane < 32) {
            const f32x2v a = P[row * 4 + 0], b = P[row * 4 + 1], c = P[row * 4 + 2], d = P[row * 4 + 3];
            const float mt = (a.x + b.x + c.x + d.x) * 0.25f;
            const float da = a.x - mt, db = b.x - mt, dc = c.x - mt, dd = d.x - mt;
            const float m2 = (a.y + b.y) + (c.y + d.y) + 64.0f * ((da * da + db * db) + (dc * dc + dd * dd));
            unsigned long long* slot = (unsigned long long*)xbuf + ((size_t)(u.pm * BM + row) * 4 + u.pn);
            __hip_atomic_store(slot, ((unsigned long long)__float_as_uint(m2) << 32) | __float_as_uint(mt), __ATOMIC_RELAXED, __HIP_MEMORY_SCOPE_AGENT);
        }
        asm volatile("s_waitcnt vmcnt(0)" ::: "memory");
        if (lane == 0) __hip_atomic_fetch_add(cnt + 64 * u.pm, 1u, __ATOMIC_RELAXED, __HIP_MEMORY_SCOPE_AGENT);
        if (wid == 0) {
            bool dead = false; const unsigned long long t0 = __builtin_amdgcn_s_memrealtime(); const unsigned want = 8u * (unsigned)ntn;
            for (;;) {
#if defined(BROKEN_EXCHANGE_NO_WAIT)
                break;
#endif
                if ((unsigned)__builtin_amdgcn_readfirstlane(__hip_atomic_load(cnt + 64 * u.pm, __ATOMIC_RELAXED, __HIP_MEMORY_SCOPE_AGENT)) >= want) break;
                if (__builtin_amdgcn_s_memrealtime() - t0 > 2000000ull) {
                    if (lane == 0) { unsigned expect = 0u; __hip_atomic_compare_exchange_strong(tmo + 1, &expect, code | (unsigned)(u.pm & 0xff), __ATOMIC_RELAXED, __ATOMIC_RELAXED, __HIP_MEMORY_SCOPE_AGENT);
                                     __hip_atomic_store(tmo, 1u, __ATOMIC_RELAXED, __HIP_MEMORY_SCOPE_AGENT); }
                    dead = true; break; }
                __builtin_amdgcn_s_sleep(2);
            }
            __builtin_amdgcn_fence(__ATOMIC_ACQUIRE, "agent");
            if (lane == 0) flag[0] = dead ? 1u : 0u;
        }
        asm volatile("s_waitcnt vmcnt(0) lgkmcnt(0)" ::: "memory"); __builtin_amdgcn_s_barrier(); asm volatile("" ::: "memory");
        const bool bad = flag[0] != 0u;
        if (lane < 32) {
            const unsigned long long* slot = (const unsigned long long*)xbuf + (size_t)(u.pm * BM + row) * 4; float mt[4], m2[4]; float ms = 0.f;
#pragma unroll
            for (int t = 0; t < 4; ++t) { if (t < ntn) { const unsigned long long w = __hip_atomic_load(slot + t, __ATOMIC_RELAXED, __HIP_MEMORY_SCOPE_AGENT); mt[t] = __uint_as_float((unsigned)w); m2[t] = __uint_as_float((unsigned)(w >> 32)); } else { mt[t] = 0.f; m2[t] = 0.f; } ms += mt[t]; }
            const float mean = ms / (float)ntn; float q = 0.f;
#pragma unroll
            for (int t = 0; t < 4; ++t) if (t < ntn) { const float dm = mt[t] - mean; q += m2[t] + 256.0f * dm * dm; }
            S[row] = (f32x2v){mean, 1.0f / sqrtf(q / (256.0f * (float)ntn) + eps)};
        }
        asm volatile("s_waitcnt lgkmcnt(0)" ::: "memory"); __builtin_amdgcn_s_barrier(); asm volatile("" ::: "memory");
        return bad;
    }
};
struct EpiLnRes {
    static constexpr bool PERM = false, AFTER_DRAIN = true;
    const float* base; float* out; int ldc; const float* bias; PanelStats st; unsigned poison;
    __device__ __forceinline__ void fused(f32x4 (&acc)[2][2][4][2], const Unit& u, int wr, int wc, int fr, int fq, PG8_LAS unsigned char* lds, int wid, int lane) const {
        typedef float f32x2v __attribute__((ext_vector_type(2)));
        const PG8_LAS f32x2v* S = (const PG8_LAS f32x2v*)(lds + 8192);
        const int col0 = u.pn * BM + wc * 32 + 4 * fq;
#pragma unroll
        for (int bj = 0; bj < 2; ++bj)
#pragma unroll
            for (int n = 0; n < 2; ++n) { const f32x4 bv = bias ? *(const f32x4*)(bias + col0 + bj * HALF + n * 16) : (f32x4){0.f, 0.f, 0.f, 0.f};
#pragma unroll
                for (int ai = 0; ai < 2; ++ai)
#pragma unroll
                    for (int m = 0; m < 4; ++m) acc[ai][bj][m][n] += bv; }
        f32x4 pre[4][2][2];
#pragma unroll
        for (int m = 0; m < 4; ++m) { const size_t off = (size_t)(u.pm * BM + wr * 64 + m * 16 + fr) * ldc + col0;
#pragma unroll
            for (int bj = 0; bj < 2; ++bj)
#pragma unroll
                for (int n = 0; n < 2; ++n) pre[m][bj][n] = *(const f32x4*)(base + off + bj * HALF + n * 16); }
        const bool bad = st.run(acc, u, wr, wc, fr, fq, lds, wid, lane) || poison != 0u;
        const float qnan = __builtin_nanf("");
#pragma unroll
        for (int ai = 0; ai < 2; ++ai)
#pragma unroll
            for (int m = 0; m < 4; ++m) { const int r = ai * HALF + wr * 64 + m * 16 + fr; const f32x2v sr = S[r]; const size_t off = (size_t)(u.pm * BM + r) * ldc + col0;
#pragma unroll
                for (int bj = 0; bj < 2; ++bj)
#pragma unroll
                    for (int n = 0; n < 2; ++n) { const f32x4 bs = ai == 0 ? pre[m][bj][n] : *(const f32x4*)(base + off + bj * HALF + n * 16); f32x4 o = bs + (acc[ai][bj][m][n] - sr.x) * sr.y;
                        if (bad) o = (f32x4){qnan, qnan, qnan, qnan}; *(f32x4*)(out + off + bj * HALF + n * 16) = o; }
                if (m & 1) asm volatile("" ::: "memory"); }
    }
};
struct EpiLnResLn {
    static constexpr bool PERM = false, AFTER_DRAIN = true;
    const float* base; float* out; bf16_t* xn; int ldc; const float* bias; PanelStats st1, st2; unsigned poison;
    __device__ __forceinline__ void fused(f32x4 (&acc)[2][2][4][2], const Unit& u, int wr, int wc, int fr, int fq, PG8_LAS unsigned char* lds, int wid, int lane) const {
        typedef float f32x2v __attribute__((ext_vector_type(2))); typedef unsigned u32x2v __attribute__((ext_vector_type(2)));
        const PG8_LAS f32x2v* S = (const PG8_LAS f32x2v*)(lds + 8192);
        const int col0 = u.pn * BM + wc * 32 + 4 * fq;
#pragma unroll
        for (int bj = 0; bj < 2; ++bj)
#pragma unroll
            for (int n = 0; n < 2; ++n) { const f32x4 bv = bias ? *(const f32x4*)(bias + col0 + bj * HALF + n * 16) : (f32x4){0.f, 0.f, 0.f, 0.f};
#pragma unroll
                for (int ai = 0; ai < 2; ++ai)
#pragma unroll
                    for (int m = 0; m < 4; ++m) acc[ai][bj][m][n] += bv; }
        bool bad = st1.run(acc, u, wr, wc, fr, fq, lds, wid, lane) || poison != 0u;
        const float qnan = __builtin_nanf("");
#pragma unroll
        for (int ai = 0; ai < 2; ++ai)
#pragma unroll
            for (int m = 0; m < 4; ++m) { const int r = ai * HALF + wr * 64 + m * 16 + fr; const f32x2v sr = S[r]; const size_t off = (size_t)(u.pm * BM + r) * ldc + col0;
#pragma unroll
                for (int bj = 0; bj < 2; ++bj)
#pragma unroll
                    for (int n = 0; n < 2; ++n) { const f32x4 bs = *(const f32x4*)(base + off + bj * HALF + n * 16); acc[ai][bj][m][n] = bs + (acc[ai][bj][m][n] - sr.x) * sr.y; }
                asm volatile("" : "+v"(acc[ai][0][m][0]), "+v"(acc[ai][0][m][1]), "+v"(acc[ai][1][m][0]), "+v"(acc[ai][1][m][1]));
                if (m & 1) asm volatile("" ::: "memory"); }
        const bool bad1 = bad;
        bad = st2.run(acc, u, wr, wc, fr, fq, lds, wid, lane) || bad;
#pragma unroll
        for (int ai = 0; ai < 2; ++ai)
#pragma unroll
            for (int m = 0; m < 4; ++m) { const int r = ai * HALF + wr * 64 + m * 16 + fr; const f32x2v sr = S[r]; const size_t off = (size_t)(u.pm * BM + r) * ldc + col0;
#pragma unroll
                for (int bj = 0; bj < 2; ++bj)
#pragma unroll
                    for (int n = 0; n < 2; ++n) { const f32x4 x1 = acc[ai][bj][m][n]; *(f32x4*)(out + off + bj * HALF + n * 16) = bad1 ? (f32x4){qnan, qnan, qnan, qnan} : x1;
                        const f32x4 o = (x1 - sr.x) * sr.y; u32x2v w; w.x = cvt_pk_bf16(o[0], o[1]); w.y = cvt_pk_bf16(o[2], o[3]);
                        if (bad) { w.x = 0x7fc07fc0u; w.y = 0x7fc07fc0u; } *(u32x2v*)(xn + off + bj * HALF + n * 16) = w; }
                asm volatile("" ::: "memory"); }
    }
};

template <class Epi, class Sched, bool ALIGN_EPI = false, bool SP2 = false>
__device__ __forceinline__ void gemm_phase(PG8_LAS unsigned char* lds, const Gemm g, const Sched& S, const Epi& E) {
    int tid_ = threadIdx.x; asm volatile("" : "+v"(tid_)); const int tid = tid_, wid = __builtin_amdgcn_readfirstlane(tid >> 6), lane = tid & 63, wr = wid >> 2, wc = wid & 3, fr = lane & 15, fq = lane >> 4;
    const int K = g.K, nt = K / BK;
    unsigned voffA[2], voffB[2];
#pragma unroll
    for (int i = 0; i < 2; ++i) { int R, C; stage_rc(tid * 16 + i * 8192, R, C); const int Rb = Epi::PERM ? ((R & ~31) + perm32(R & 31)) : R;
        voffA[i] = (unsigned)(R * K + C) * 2u; voffB[i] = (unsigned)(Rb * K + C) * 2u; }
    const size_t kstep = (size_t)(BK * 2);
    const size_t hstep = (size_t)HALF * K * 2;
    const size_t tstep = 2 * hstep;
    const unsigned ldsw = (unsigned)wid * 1024u;
    const int aoff = lds_byte(wr * 64 + fr, fq * 8), boff = lds_byte(wc * 32 + fr, fq * 8);
#define PG8_SA(b, h) (((b) * 2 + (h)) * HTB)
#define PG8_SB(b, h) ((4 + (b) * 2 + (h)) * HTB)
#define PG8_STAGE(bufoff, gbase, voff) do { _Pragma("unroll") for (int _i = 0; _i < 2; ++_i) \
        __builtin_amdgcn_global_load_lds((const unsigned*)((const char*)(gbase) + (voff)[_i]), (PG8_LAS unsigned*)(lds + (bufoff) + ldsw + _i * 8192), 16, 0, 0); } while (0)
#define PG8_LDA(dst, b, h) do { _Pragma("unroll") for (int m = 0; m < 4; ++m) _Pragma("unroll") for (int k = 0; k < 2; ++k) dst[m][k] = *(const PG8_LAS bf16x8*)(lds + PG8_SA(b, h) + aoff + m * 2048 + k * 1024); } while (0)
#define PG8_LDB(dst, b, h) do { _Pragma("unroll") for (int n = 0; n < 2; ++n) _Pragma("unroll") for (int k = 0; k < 2; ++k) dst[n][k] = *(const PG8_LAS bf16x8*)(lds + PG8_SB(b, h) + boff + n * 2048 + k * 1024); } while (0)
#define PG8_MMA(ai, bj, At, Bt) do { __builtin_amdgcn_s_setprio(1); _Pragma("unroll") for (int m = 0; m < 4; ++m) _Pragma("unroll") for (int n = 0; n < 2; ++n) _Pragma("unroll") for (int k = 0; k < 2; ++k) \
        acc[ai][bj][m][n] = __builtin_amdgcn_mfma_f32_16x16x32_bf16(Bt[n][k], At[m][k], acc[ai][bj][m][n], 0, 0, 0); __builtin_amdgcn_s_setprio(0); } while (0)
#define PG8_WAIT_V(n) asm volatile("s_waitcnt vmcnt(" #n ")" ::: "memory")
#define PG8_WAIT_L(n) asm volatile("s_waitcnt lgkmcnt(" #n ")" ::: "memory")
#define PG8_BAR __builtin_amdgcn_s_barrier()
#define PG8_SCHED __builtin_amdgcn_sched_barrier(0)
    Unit cur, nxt; int ui = 0;
    if (!S.next(0, cur)) return;
    f32x4 acc[2][2][4][2];
#pragma unroll
    for (int a = 0; a < 2; ++a)
#pragma unroll
        for (int b = 0; b < 2; ++b)
#pragma unroll
            for (int m = 0; m < 4; ++m)
#pragma unroll
                for (int n = 0; n < 2; ++n) acc[a][b][m][n] = (f32x4){0.f, 0.f, 0.f, 0.f};
    bf16x8 At[4][2], B0[2][2], B1[2][2];
    const char* cA = (const char*)g.A + (size_t)cur.pm * tstep; const char* cB = (const char*)g.Bt + (size_t)cur.pn * tstep;
    S.a_ready(cur);
    if constexpr (SP2) {
        PG8_STAGE(PG8_SB(0, 0), cB, voffB); PG8_STAGE(PG8_SB(0, 1), cB + hstep, voffB); PG8_STAGE(PG8_SA(0, 0), cA, voffA); PG8_STAGE(PG8_SA(0, 1), cA + hstep, voffA);
        if (wr == 1) PG8_BAR;
        PG8_WAIT_V(2); PG8_BAR;
        PG8_STAGE(PG8_SB(1, 0), cB + kstep, voffB); PG8_STAGE(PG8_SA(1, 0), cA + kstep, voffA); PG8_STAGE(PG8_SB(1, 1), cB + hstep + kstep, voffB);
        PG8_WAIT_V(6); PG8_BAR;
    } else {
        PG8_STAGE(PG8_SB(0, 0), cB, voffB); PG8_STAGE(PG8_SA(0, 0), cA, voffA); PG8_STAGE(PG8_SB(0, 1), cB + hstep, voffB); PG8_STAGE(PG8_SA(0, 1), cA + hstep, voffA);
        if (wr == 1) PG8_BAR;
        PG8_WAIT_V(4); PG8_BAR;
        PG8_STAGE(PG8_SB(1, 0), cB + kstep, voffB); PG8_STAGE(PG8_SA(1, 0), cA + kstep, voffA); PG8_STAGE(PG8_SB(1, 1), cB + hstep + kstep, voffB);
        PG8_WAIT_V(6); PG8_BAR;
    }
    for (;;) {
        const bool has_next = S.next(ui + 1, nxt);
        const char* nA = has_next ? (const char*)g.A + (size_t)nxt.pm * tstep : cA; const char* nB = has_next ? (const char*)g.Bt + (size_t)nxt.pn * tstep : cB;
        for (int t = 0; t < nt; t += 2) {
            const bool last = (t == nt - 2);
            const char* a1 = cA + (size_t)(t + 1) * kstep;
            const char* a2 = last ? nA : cA + (size_t)(t + 2) * kstep; const char* b2 = last ? nB : cB + (size_t)(t + 2) * kstep;
            const char* a3 = a2 + kstep; const char* b3 = b2 + kstep;
            if (last && has_next) S.a_ready(nxt);
            if constexpr (SP2) {
            PG8_LDB(B0, 0, 0); PG8_LDB(B1, 0, 1); PG8_SCHED; PG8_LDA(At, 0, 0); PG8_STAGE(PG8_SA(1, 1), a1 + hstep, voffA);
            PG8_WAIT_V(8); PG8_WAIT_L(0); PG8_BAR; PG8_MMA(0, 0, At, B0); PG8_MMA(0, 1, At, B1); PG8_BAR; PG8_SCHED;
            PG8_LDA(At, 0, 1); PG8_STAGE(PG8_SB(0, 0), b2, voffB); PG8_STAGE(PG8_SB(0, 1), b2 + hstep, voffB); PG8_STAGE(PG8_SA(0, 0), a2, voffA);
            PG8_WAIT_V(8); PG8_WAIT_L(0); PG8_BAR; PG8_MMA(1, 0, At, B0); PG8_MMA(1, 1, At, B1); PG8_BAR; PG8_SCHED;
            PG8_LDB(B0, 1, 0); PG8_LDB(B1, 1, 1); PG8_SCHED; PG8_LDA(At, 1, 0); PG8_STAGE(PG8_SA(0, 1), a2 + hstep, voffA);
            PG8_WAIT_V(8); PG8_WAIT_L(0); PG8_BAR; PG8_MMA(0, 0, At, B0); PG8_MMA(0, 1, At, B1); PG8_BAR; PG8_SCHED;
            PG8_LDA(At, 1, 1); PG8_STAGE(PG8_SB(1, 0), b3, voffB); PG8_STAGE(PG8_SB(1, 1), b3 + hstep, voffB); PG8_STAGE(PG8_SA(1, 0), a3, voffA);
            PG8_WAIT_V(8); PG8_WAIT_L(0); PG8_BAR; PG8_MMA(1, 0, At, B0); PG8_MMA(1, 1, At, B1); PG8_BAR; PG8_SCHED;
            } else {
            PG8_LDB(B0, 0, 0); PG8_SCHED; PG8_LDA(At, 0, 0); PG8_STAGE(PG8_SA(1, 1), a1 + hstep, voffA);
            PG8_WAIT_L(8); PG8_BAR; PG8_WAIT_L(0); PG8_MMA(0, 0, At, B0); PG8_BAR; PG8_SCHED;
            PG8_LDB(B1, 0, 1); PG8_STAGE(PG8_SB(0, 0), b2, voffB);
            PG8_BAR; PG8_WAIT_L(0); PG8_MMA(0, 1, At, B1); PG8_BAR;
            PG8_LDA(At, 0, 1); PG8_STAGE(PG8_SA(0, 0), a2, voffA);
            PG8_BAR; PG8_WAIT_L(0); PG8_MMA(1, 0, At, B0); PG8_BAR; PG8_SCHED;
            PG8_STAGE(PG8_SB(0, 1), b2 + hstep, voffB);
            PG8_WAIT_V(6); PG8_BAR; PG8_MMA(1, 1, At, B1); PG8_BAR;
            PG8_LDB(B0, 1, 0); PG8_SCHED; PG8_LDA(At, 1, 0); PG8_STAGE(PG8_SA(0, 1), a2 + hstep, voffA);
            PG8_WAIT_L(8); PG8_BAR; PG8_WAIT_L(0); PG8_MMA(0, 0, At, B0); PG8_BAR; PG8_SCHED;
            PG8_LDB(B1, 1, 1); PG8_STAGE(PG8_SB(1, 0), b3, voffB);
            PG8_BAR; PG8_WAIT_L(0); PG8_MMA(0, 1, At, B1); PG8_BAR;
            PG8_LDA(At, 1, 1); PG8_STAGE(PG8_SA(1, 0), a3, voffA);
            PG8_BAR; PG8_WAIT_L(0); PG8_MMA(1, 0, At, B0); PG8_BAR; PG8_SCHED;
            PG8_STAGE(PG8_SB(1, 1), b3 + hstep, voffB);
            PG8_WAIT_V(6); PG8_BAR; PG8_MMA(1, 1, At, B1); PG8_BAR;
            }
        }
        if constexpr (ALIGN_EPI) { if (wr == 0) PG8_BAR; }
        if constexpr (!Epi::AFTER_DRAIN) { E(acc, cur, wr, wc, fr, fq); S.done(cur); }
        if (!has_next) break;
#pragma unroll
        for (int a = 0; a < 2; ++a)
#pragma unroll
            for (int b = 0; b < 2; ++b)
#pragma unroll
                for (int m = 0; m < 4; ++m)
#pragma unroll
                    for (int n = 0; n < 2; ++n) acc[a][b][m][n] = (f32x4){0.f, 0.f, 0.f, 0.f};
        cur = nxt; cA = nA; cB = nB; ++ui;
        if constexpr (ALIGN_EPI) { if (wr == 1) PG8_BAR; }
    }
    PG8_WAIT_V(0);
    if constexpr (!ALIGN_EPI) { if (wr == 0) PG8_BAR; }
    PG8_BAR;
    if constexpr (Epi::AFTER_DRAIN) { E.fused(acc, cur, wr, wc, fr, fq, lds, wid, lane); S.done(cur); }
#undef PG8_SA
#undef PG8_SB
#undef PG8_STAGE
#undef PG8_LDA
#undef PG8_LDB
#undef PG8_MMA
#undef PG8_WAIT_V
#undef PG8_WAIT_L
#undef PG8_BAR
#undef PG8_SCHED
}
}
#define XB_TMO      128
#define XB_XCNT(j)  (256  + 64 * (j))
#define XB_XSUB(j)  (1280 + 64 * (j))
#define XB_XGEN(j)  (2304 + 64 * (j))
#define XB_TOP      3328
#define XB_TOPGEN   3392
#define XCD_BAR_WORDS 3456
#define XB_SPIN_CAP (1u << 18)

__device__ __forceinline__ unsigned xb_ld(unsigned* p)              { return __hip_atomic_load(p, __ATOMIC_RELAXED, __HIP_MEMORY_SCOPE_AGENT); }
__device__ __forceinline__ unsigned xb_add(unsigned* p, unsigned v) { return __hip_atomic_fetch_add(p, v, __ATOMIC_RELAXED, __HIP_MEMORY_SCOPE_AGENT); }
__device__ __forceinline__ unsigned xb_xcc_id() { return (unsigned)__builtin_amdgcn_s_getreg((3 << 11) | 20) & 0xFu; }
#define XB_SPIN(cond, bar) do { unsigned _sp = 0; while (cond) { __builtin_amdgcn_s_sleep(1); \
    if ((++_sp & 255u) == 0u) { if (xb_ld(&(bar)[XB_TMO])) break; if (_sp > XB_SPIN_CAP) { atomicAdd(&(bar)[XB_TMO], 1u); break; } } } } while (0)

struct XcdBarrier {
    unsigned* bar; unsigned x;
    volatile LAS unsigned* st;
};

__device__ __forceinline__ XcdBarrier xcd_barrier_post(unsigned* bar, volatile LAS unsigned* st) {
    XcdBarrier b; b.bar = bar; b.x = xb_xcc_id(); b.st = st;
    if (threadIdx.x == 0) (void)xb_add(&bar[XB_XCNT(b.x)], 1u);
    return b;
}
__device__ __forceinline__ void xcd_barrier_complete(unsigned* bar, unsigned x, unsigned& nloc, unsigned& nx) {
    const unsigned G = gridDim.x * gridDim.y * gridDim.z;
    unsigned sum, cnt, mine, sp = 0u;
    for (;;) {
        sum = 0u; cnt = 0u; mine = 0u;
#pragma unroll
        for (unsigned j = 0; j < 16; ++j) { const unsigned c = xb_ld(&bar[XB_XCNT(j)]); sum += c; cnt += (c > 0u) ? 1u : 0u; mine = (j == x) ? c : mine; }
        if (sum == G) break;
        __builtin_amdgcn_s_sleep(1);
        if ((++sp & 255u) == 0u) { if (xb_ld(&bar[XB_TMO])) break; if (sp > XB_SPIN_CAP) { atomicAdd(&bar[XB_TMO], 1u); break; } }
    }
    nloc = mine > 0u ? mine : 1u; nx = cnt > 0u ? cnt : 1u;
}

__device__ __forceinline__ void xcd_barrier(const XcdBarrier& b) {
    asm volatile("s_waitcnt vmcnt(0)" ::: "memory");
    __syncthreads();
    if (threadIdx.x == 0) {
        unsigned* bar = b.bar;
        __builtin_amdgcn_s_waitcnt(0);
        unsigned nloc = b.st[0], nx = b.st[1];
        if (nloc == 0u) { xcd_barrier_complete(bar, b.x, nloc, nx); b.st[0] = nloc; b.st[1] = nx; }
        const unsigned old = xb_add(&bar[XB_XSUB(b.x)], 1u);
        const unsigned gen = old / nloc;
        if (old + 1u == (gen + 1u) * nloc) {
            __builtin_amdgcn_fence(__ATOMIC_RELEASE, "agent");
            asm volatile("s_waitcnt vmcnt(0)" ::: "memory");
            const unsigned og = xb_add(&bar[XB_TOP], 1u);
            const unsigned tg = og / nx;
            if (og + 1u == (tg + 1u) * nx) xb_add(&bar[XB_TOPGEN], 1u);
            else XB_SPIN(xb_ld(&bar[XB_TOPGEN]) == tg, bar);
            __builtin_amdgcn_fence(__ATOMIC_ACQUIRE, "agent");
            xb_add(&bar[XB_XGEN(b.x)], 1u);
            asm volatile("s_waitcnt vmcnt(0)" ::: "memory");
        } else {
            XB_SPIN(xb_ld(&bar[XB_XGEN(b.x)]) == gen, bar);
            __builtin_amdgcn_fence(__ATOMIC_ACQUIRE, "agent");
            asm volatile("s_waitcnt vmcnt(0)" ::: "memory");
        }
    }
    __syncthreads();
}

__device__ __forceinline__ void xcd_barrier_local(const XcdBarrier& b) {
    asm volatile("s_waitcnt vmcnt(0)" ::: "memory");
    __syncthreads();
    if (threadIdx.x == 0) {
        unsigned* bar = b.bar;
        __builtin_amdgcn_s_waitcnt(0);
        const unsigned nloc = b.st[0];
        const unsigned old = xb_add(&bar[XB_XSUB(b.x)], 1u);
        const unsigned gen = old / nloc;
        if (old + 1u == (gen + 1u) * nloc) xb_add(&bar[XB_XGEN(b.x)], 1u);
        else XB_SPIN(xb_ld(&bar[XB_XGEN(b.x)]) == gen, bar);
        __builtin_amdgcn_fence(__ATOMIC_ACQUIRE, "agent");
        asm volatile("s_waitcnt vmcnt(0)" ::: "memory");
    }
    __syncthreads();
}

#define XB_QSUB(q) (24576 + 64 * (q))
#define XB_QGEN(q) (28672 + 64 * (q))
__device__ __forceinline__ void quad_barrier(const XcdBarrier& b, unsigned q) {
    asm volatile("s_waitcnt vmcnt(0)" ::: "memory");
    __syncthreads();
    if (threadIdx.x == 0) {
        unsigned* bar = b.bar;
        __builtin_amdgcn_s_waitcnt(0);
        const unsigned old = xb_add(&bar[XB_QSUB(q)], 1u);
        const unsigned gen = old / 4u;
        if (old + 1u == (gen + 1u) * 4u) xb_add(&bar[XB_QGEN(q)], 1u);
        else XB_SPIN(xb_ld(&bar[XB_QGEN(q)]) == gen, bar);
        __builtin_amdgcn_fence(__ATOMIC_ACQUIRE, "agent");
        asm volatile("s_waitcnt vmcnt(0)" ::: "memory");
    }
    __syncthreads();
}

#define XB_OSUB(o) (36864 + 64 * (o))
#define XB_OGEN(o) (40960 + 64 * (o))
__device__ __forceinline__ void octet_barrier(const XcdBarrier& b, unsigned o) {
    asm volatile("s_waitcnt vmcnt(0)" ::: "memory");
    __syncthreads();
    if (threadIdx.x == 0) {
        unsigned* bar = b.bar;
        __builtin_amdgcn_s_waitcnt(0);
        const unsigned old = xb_add(&bar[XB_OSUB(o)], 1u);
        const unsigned gen = old / 8u;
        if (old + 1u == (gen + 1u) * 8u) xb_add(&bar[XB_OGEN(o)], 1u);
        else XB_SPIN(xb_ld(&bar[XB_OGEN(o)]) == gen, bar);
        __builtin_amdgcn_fence(__ATOMIC_ACQUIRE, "agent");
        asm volatile("s_waitcnt vmcnt(0)" ::: "memory");
    }
    __syncthreads();
}

__device__ __forceinline__ unsigned octet_arrive(const XcdBarrier& b, unsigned o) {
    asm volatile("s_waitcnt vmcnt(0)" ::: "memory");
    __syncthreads();
    unsigned gen = 0u;
    if (threadIdx.x == 0) {
        unsigned* bar = b.bar;
        __builtin_amdgcn_s_waitcnt(0);
        const unsigned old = xb_add(&bar[XB_OSUB(o)], 1u);
        gen = old / 8u;
        if (old + 1u == (gen + 1u) * 8u) xb_add(&bar[XB_OGEN(o)], 1u);
    }
    return gen;
}
__device__ __forceinline__ void octet_wait(const XcdBarrier& b, unsigned o, unsigned gen) {
    if (threadIdx.x == 0) {
        unsigned* bar = b.bar;
        XB_SPIN(xb_ld(&bar[XB_OGEN(o)]) == gen, bar);
        __builtin_amdgcn_fence(__ATOMIC_ACQUIRE, "agent");
        asm volatile("s_waitcnt vmcnt(0)" ::: "memory");
    }
    __syncthreads();
}

#ifndef REP_GU
#define REP_GU 1
#endif
#ifndef REP_DN
#define REP_DN 1
#endif
#ifndef REP_IN
#define REP_IN 1
#endif
#ifndef REP_PRO
#define REP_PRO 1
#endif
#ifndef REP_SB
#define REP_SB 1
#endif
#ifndef REP_CONV
#define REP_CONV 1
#endif
#ifndef REP_CMP
#define REP_CMP 1
#endif
#ifndef REP_GMLP
#define REP_GMLP 1
#endif
#ifndef REP_NSA
#define REP_NSA 1
#endif
#ifndef REP_LN
#define REP_LN 1
#endif
#ifndef REP_SYNC
#define REP_SYNC 1
#endif

#ifdef XSB
#define DIS_SB(x)
#else
#define DIS_SB(x) x
#endif
#ifdef XCONV
#define DIS_CONV(x)
#else
#define DIS_CONV(x) x
#endif
#ifdef XCMP
#define DIS_CMP(x)
#else
#define DIS_CMP(x) x
#endif
#ifdef XGMLP
#define DIS_GMLP(x)
#else
#define DIS_GMLP(x) x
#endif
#ifdef XNSA
#define DIS_NSA(x)
#else
#define DIS_NSA(x) x
#endif
#ifdef XGEMM
#define DIS_GEMM(x)
#else
#define DIS_GEMM(x) x
#endif

#define LAS __attribute__((address_space(3)))
typedef unsigned short bf16_t;
typedef short bf16x8 __attribute__((ext_vector_type(8)));
typedef short s16x4 __attribute__((ext_vector_type(4)));
typedef short v4i16_t __attribute__((ext_vector_type(4)));
typedef float f32x4 __attribute__((ext_vector_type(4)));
typedef float f32x16 __attribute__((ext_vector_type(16)));
typedef unsigned u32x4 __attribute__((ext_vector_type(4)));
typedef unsigned u32x2 __attribute__((ext_vector_type(2)));

constexpr int NB = 16, SEQ = 2048, DM = 1024, MTOK = NB * SEQ;
constexpr int HW = 2560;
constexpr int FF = 2816;
constexpr float ALPHA = 1.41421356237309515f;
constexpr float LN_EPS = 1e-5f;
constexpr float LOG2E = 1.4426950408889634f;
constexpr float C2 = 0.125f * LOG2E;

constexpr size_t MiB = 1u << 20;
constexpr size_t WS_IN0 = 0 * MiB, WS_OUT0 = 6 * MiB, WS_IN1 = 8 * MiB, WS_OUT1 = 14 * MiB;
constexpr size_t WS_GU0 = 16 * MiB, WS_GU1 = 28 * MiB, WS_DN0 = 40 * MiB, WS_DN1 = 46 * MiB;
constexpr size_t WS_W1TK = 52 * MiB, WS_W1TV = 53 * MiB, WS_TRIL = 54 * MiB, WS_KCMP = 55 * MiB, WS_VCMP = 56 * MiB;
constexpr size_t WS_PT = 56 * MiB + 768 * 1024;
constexpr size_t WS_XCH = 57 * MiB, WS_CTL = 61 * MiB, CTL_BYTES = 256 * 1024;
constexpr int CW_TMO = 4096, CW_SEAM = 8192;
constexpr size_t WS_XB = 64 * MiB, WS_H = 128 * MiB, WS_MIX = 304 * MiB, WS_MB = 368 * MiB, WS_END = 432 * MiB;

constexpr int LDS_BYTES = 147456;

struct Params { const float* in[26]; float* out; unsigned char* ws; };
__device__ __forceinline__ int opaque_tid() { int t = threadIdx.x; asm volatile("" : "+v"(t)); return t; }

__device__ __forceinline__ unsigned f2bf(float f) { unsigned u = __builtin_bit_cast(unsigned, f); return (u + 0x7fffu + ((u >> 16) & 1u)) >> 16; }
__device__ __forceinline__ unsigned pk2(float lo, float hi) { return pg8::cvt_pk_bf16(lo, hi); }
__device__ __forceinline__ float bf2f(unsigned b) { return __builtin_bit_cast(float, b << 16); }
__device__ __forceinline__ float bflo(unsigned w) { return __builtin_bit_cast(float, w << 16); }
__device__ __forceinline__ float bfhi(unsigned w) { return __builtin_bit_cast(float, w & 0xffff0000u); }
__device__ __forceinline__ float wave_sum(float v) {
#pragma unroll
    for (int o = 1; o < 64; o <<= 1) v += __shfl_xor(v, o);
    return v;
}
__device__ __forceinline__ float xor32(float v) {
    const unsigned u = __builtin_bit_cast(unsigned, v);
    auto rr = __builtin_amdgcn_permlane32_swap(u, u, false, false);
    return __builtin_bit_cast(float, (threadIdx.x & 32u) ? rr[0] : rr[1]);
}
__device__ __forceinline__ float sigmoidf_(float x) { return __builtin_amdgcn_rcpf(1.f + __expf(-x)); }
__device__ __forceinline__ float siluf_(float x) { return x * __builtin_amdgcn_rcpf(1.f + __expf(-x)); }
__device__ __forceinline__ float gelu_tanh(float x) {
    const float u = 0.7978845608028654f * (x + 0.044715f * x * x * x);
    return x * __builtin_amdgcn_rcpf(1.f + __expf(-2.f * u));
}
#define LDSW() asm volatile("s_waitcnt lgkmcnt(0)" ::: "memory")
#define MFMA32(a, b, c) __builtin_amdgcn_mfma_f32_32x32x16_bf16((a), (b), (c), 0, 0, 0)
__device__ __forceinline__ int crow(int r, int hi) { return (r & 3) + 8 * (r >> 2) + 4 * hi; }

struct EpiStore {
    static constexpr bool PERM = true, AFTER_DRAIN = false;
    bf16_t* O; int ldc;
    __device__ __forceinline__ void operator()(const pg8::f32x4 (&acc)[2][2][4][2], const pg8::Unit& u, int wr, int wc, int fr, int fq) const {
        const int row0 = u.pm * 256 + wr * 64 + fr, col0 = u.pn * 256 + wc * 32 + 8 * fq;
#pragma unroll
        for (int ai = 0; ai < 2; ++ai)
#pragma unroll
            for (int m = 0; m < 4; ++m) { bf16_t* rowp = O + (size_t)(row0 + ai * 128 + m * 16) * ldc + col0;
#pragma unroll
                for (int bj = 0; bj < 2; ++bj) { const pg8::f32x4 v0 = acc[ai][bj][m][0], v1 = acc[ai][bj][m][1];
                    u32x4 w; w.x = pk2(v0[0], v0[1]); w.y = pk2(v0[2], v0[3]); w.z = pk2(v1[0], v1[1]); w.w = pk2(v1[2], v1[3]);
                    *(u32x4*)(rowp + bj * 128) = w; } }
    }
};
struct EpiResid {
    static constexpr bool PERM = true, AFTER_DRAIN = false;
    bf16_t* O; const bf16_t* X;
    __device__ __forceinline__ void operator()(const pg8::f32x4 (&acc)[2][2][4][2], const pg8::Unit& u, int wr, int wc, int fr, int fq) const {
        const int row0 = u.pm * 256 + wr * 64 + fr, col0 = u.pn * 256 + wc * 32 + 8 * fq;
#pragma unroll
        for (int ai = 0; ai < 2; ++ai)
#pragma unroll
            for (int m = 0; m < 4; ++m) { const size_t off = (size_t)(row0 + ai * 128 + m * 16) * DM + col0;
#pragma unroll
                for (int bj = 0; bj < 2; ++bj) { const pg8::f32x4 v0 = acc[ai][bj][m][0], v1 = acc[ai][bj][m][1];
                    const u32x4 xr = *(const u32x4*)(X + off + bj * 128);
                    u32x4 w; w.x = pk2(v0[0] + ALPHA * bflo(xr.x), v0[1] + ALPHA * bfhi(xr.x)); w.y = pk2(v0[2] + ALPHA * bflo(xr.y), v0[3] + ALPHA * bfhi(xr.y));
                    w.z = pk2(v1[0] + ALPHA * bflo(xr.z), v1[1] + ALPHA * bfhi(xr.z)); w.w = pk2(v1[2] + ALPHA * bflo(xr.w), v1[3] + ALPHA * bfhi(xr.w));
                    *(u32x4*)(O + off + bj * 128) = w; } }
    }
};
struct EpiSwiglu {
    static constexpr bool PERM = true, AFTER_DRAIN = false;
    bf16_t* O; int ldc;
    __device__ __forceinline__ void operator()(const pg8::f32x4 (&acc)[2][2][4][2], const pg8::Unit& u, int wr, int wc, int fr, int fq) const {
        const int row0 = u.pm * 256 + wr * 64 + fr, col0 = u.pn * 128 + wc * 16 + 4 * fq;
#pragma unroll
        for (int ai = 0; ai < 2; ++ai)
#pragma unroll
            for (int m = 0; m < 4; ++m) { bf16_t* rowp = O + (size_t)(row0 + ai * 128 + m * 16) * ldc + col0;
#pragma unroll
                for (int bj = 0; bj < 2; ++bj) { const pg8::f32x4 gv = acc[ai][bj][m][0], uv = acc[ai][bj][m][1];
                    u32x2 w; w.x = pk2(siluf_(gv[0]) * uv[0], siluf_(gv[1]) * uv[1]); w.y = pk2(siluf_(gv[2]) * uv[2], siluf_(gv[3]) * uv[3]);
                    *(u32x2*)(rowp + bj * 64) = w; } }
    }
};


struct EpiLnOut {
    static constexpr bool PERM = false, AFTER_DRAIN = true;
    const float* base; float* out; bf16_t* xb; const float* gam; const float* bet; pg8::PanelStats st;
    __device__ __forceinline__ void fused(pg8::f32x4 (&acc)[2][2][4][2], const pg8::Unit& u, int wr, int wc, int fr, int fq, PG8_LAS unsigned char* lds, int wid, int lane) const {
        typedef float f32x2v __attribute__((ext_vector_type(2)));
        const PG8_LAS f32x2v* S = (const PG8_LAS f32x2v*)(lds + 8192);
        const int col0 = u.pn * 256 + wc * 32 + 4 * fq;
#pragma unroll
        for (int ai = 0; ai < 2; ++ai)
#pragma unroll
            for (int m = 0; m < 4; ++m) { const size_t off = (size_t)(u.pm * 256 + ai * 128 + wr * 64 + m * 16 + fr) * DM + col0;
#pragma unroll
                for (int bj = 0; bj < 2; ++bj)
#pragma unroll
                    for (int n = 0; n < 2; ++n) { const pg8::f32x4 bs = *(const pg8::f32x4*)(base + off + bj * 128 + n * 16); acc[ai][bj][m][n] += bs * ALPHA; }
                asm volatile("" : "+v"(acc[ai][0][m][0]), "+v"(acc[ai][0][m][1]), "+v"(acc[ai][1][m][0]), "+v"(acc[ai][1][m][1]));
                if (m & 1) asm volatile("" ::: "memory"); }
        const bool bad = st.run(acc, u, wr, wc, fr, fq, lds, wid, lane);
        const float qnan = __builtin_nanf("");
        pg8::f32x4 gv[2][2], bv[2][2];
#pragma unroll
        for (int bj = 0; bj < 2; ++bj)
#pragma unroll
            for (int n = 0; n < 2; ++n) { gv[bj][n] = *(const pg8::f32x4*)(gam + col0 + bj * 128 + n * 16); bv[bj][n] = *(const pg8::f32x4*)(bet + col0 + bj * 128 + n * 16); }
#pragma unroll
        for (int ai = 0; ai < 2; ++ai)
#pragma unroll
            for (int m = 0; m < 4; ++m) { const int r = ai * 128 + wr * 64 + m * 16 + fr; const f32x2v sr = S[r]; const size_t off = (size_t)(u.pm * 256 + r) * DM + col0;
#pragma unroll
                for (int bj = 0; bj < 2; ++bj)
#pragma unroll
                    for (int n = 0; n < 2; ++n) {
                        pg8::f32x4 o = (acc[ai][bj][m][n] - sr.x) * sr.y * gv[bj][n] + bv[bj][n];
                        if (bad) o = (pg8::f32x4){qnan, qnan, qnan, qnan};
                        *(pg8::f32x4*)(out + off + bj * 128 + n * 16) = o; u32x2 w; w.x = pk2(o[0], o[1]); w.y = pk2(o[2], o[3]); *(u32x2*)(xb + off + bj * 128 + n * 16) = w; }
                asm volatile("" ::: "memory"); }
    }
};
struct RoundOrder {
    pg8::StaticOrder so; int round;
    __device__ __forceinline__ bool next(int i, pg8::Unit& u) const { if (i != 0) return false; return so.next(round, u); }
    __device__ __forceinline__ void a_ready(const pg8::Unit&) const {}
    __device__ __forceinline__ void done(const pg8::Unit&) const {}
};
__device__ __forceinline__ void run_gemm_ln(LAS unsigned char* lds, unsigned char* ws, const bf16_t* A, const bf16_t* Bt, int K, int inst,
                                            const float* base, float* out, bf16_t* xb, const float* gam, const float* bet) {
    pg8::Gemm g{A, Bt, MTOK, 1024, K};
    unsigned* ctl = (unsigned*)(ws + WS_CTL);
    const int nrounds = (MTOK / 256) * 4 / (int)gridDim.x;
    for (int r = 0; r < nrounds; ++r) {
        RoundOrder S; S.so.init(MTOK, 1024, (int)gridDim.x, (int)blockIdx.x); S.round = r;
        pg8::PanelStats st{(unsigned*)(ws + WS_XCH + (size_t)inst * MiB), ctl + CW_SEAM + inst * 8192, ctl + CW_TMO, 4, LN_EPS, 0x700u + (unsigned)inst};
#ifdef TEST_EXEPI
        pg8::EpiLnRes E{base, out, DM, nullptr, st, 0u};
        pg8::gemm_phase<pg8::EpiLnRes, RoundOrder, false, true>(lds, g, S, E);
#else
        EpiLnOut E{base, out, xb, gam, bet, st};
        pg8::gemm_phase<EpiLnOut, RoundOrder, false, true>(lds, g, S, E);
#endif
        __syncthreads();
    }
}

template <class Epi>
__device__ __forceinline__ void run_gemm(LAS unsigned char* lds, const bf16_t* A, const bf16_t* Bt, int N, int K, const Epi& E) {
    pg8::Gemm g{A, Bt, MTOK, N, K}; pg8::StaticOrder S; S.init(MTOK, N, (int)gridDim.x, (int)blockIdx.x);
    DIS_GEMM((pg8::gemm_phase<Epi, pg8::StaticOrder, true, true>(lds, g, S, E)));
}

__device__ __forceinline__ int map_row(int mode, int n) {
    if (mode == 0) return n;
    if (mode == 1) return (n >> 2) * 8 + (n & 3);
    if (mode == 2) return (n >> 2) * 8 + 4 + (n & 3);
    if (n < 1280) return n;
    if (n < 1304) return 2304 + (n - 1280);
    return n - 24;
}
__device__ __forceinline__ void p0_transpose_item(const float* W, int K, int N, bf16_t* WT, int mode, LAS float* scr, int item, int lane) {
    const int nblk = (N + 31) / 32, kb = item / nblk, nb = item % nblk, k0 = 64 * kb, n0 = 32 * nb;
    const int nn = n0 + (lane & 31);
    float wv[32];
#pragma unroll
    for (int i = 0; i < 32; ++i) { const int kk = 2 * i + (lane >> 5); wv[i] = (nn < N) ? W[(size_t)(k0 + kk) * N + nn] : 0.f; }
#pragma unroll
    for (int i = 0; i < 32; ++i) { const int kk = 2 * i + (lane >> 5); scr[kk * 33 + (lane & 31)] = wv[i]; }
    LDSW();
    const int c = lane & 7;
#pragma unroll
    for (int j = 0; j < 4; ++j) { const int nl = (lane >> 3) + 8 * j, n = n0 + nl; const LAS float* s = scr + (8 * c) * 33 + nl;
        u32x4 o; o.x = pk2(s[0 * 33], s[1 * 33]); o.y = pk2(s[2 * 33], s[3 * 33]); o.z = pk2(s[4 * 33], s[5 * 33]); o.w = pk2(s[6 * 33], s[7 * 33]);
        if (n < N) *(u32x4*)(WT + (size_t)map_row(mode, n) * K + k0 + 8 * c) = o; }
    LDSW();
}
__device__ __forceinline__ void p0_prologue(const Params& p, LAS unsigned char* lds) {
    const int tid = opaque_tid(), lane = tid & 63, wave = tid >> 6;
    LAS float* scr = (LAS float*)(lds + wave * 16384);
    const int gw = blockIdx.x * 8 + wave, NGW = gridDim.x * 8;
    unsigned char* ws = p.ws;
    constexpr int I_IN0 = 16 * 80, I_OUT = 16 * 32, I_IN1 = 16 * 73, I_G = 16 * 88, I_DN = 44 * 32, I_W1 = 32 * 2;
    constexpr int NITEMS = I_IN0 + 2 * I_OUT + I_IN1 + 4 * I_G + 2 * I_DN + 2 * I_W1;
    for (int it = gw; it < NITEMS; it += NGW) {
        int r = it;
        if (r < I_IN0) { p0_transpose_item(p.in[1], 1024, 2560, (bf16_t*)(ws + WS_IN0), 0, scr, r, lane); continue; } r -= I_IN0;
        if (r < I_OUT) { p0_transpose_item(p.in[6], 1024, 1024, (bf16_t*)(ws + WS_OUT0), 0, scr, r, lane); continue; } r -= I_OUT;
        if (r < I_OUT) { p0_transpose_item(p.in[18], 1024, 1024, (bf16_t*)(ws + WS_OUT1), 0, scr, r, lane); continue; } r -= I_OUT;
        if (r < I_IN1) { p0_transpose_item(p.in[7], 1024, 2328, (bf16_t*)(ws + WS_IN1), 3, scr, r, lane); continue; } r -= I_IN1;
        if (r < I_G) { p0_transpose_item(p.in[19], 1024, FF, (bf16_t*)(ws + WS_GU0), 1, scr, r, lane); continue; } r -= I_G;
        if (r < I_G) { p0_transpose_item(p.in[20], 1024, FF, (bf16_t*)(ws + WS_GU0), 2, scr, r, lane); continue; } r -= I_G;
        if (r < I_G) { p0_transpose_item(p.in[19] + (size_t)1024 * FF, 1024, FF, (bf16_t*)(ws + WS_GU1), 1, scr, r, lane); continue; } r -= I_G;
        if (r < I_G) { p0_transpose_item(p.in[20] + (size_t)1024 * FF, 1024, FF, (bf16_t*)(ws + WS_GU1), 2, scr, r, lane); continue; } r -= I_G;
        if (r < I_DN) { p0_transpose_item(p.in[21], FF, 1024, (bf16_t*)(ws + WS_DN0), 0, scr, r, lane); continue; } r -= I_DN;
        if (r < I_DN) { p0_transpose_item(p.in[21] + (size_t)FF * 1024, FF, 1024, (bf16_t*)(ws + WS_DN1), 0, scr, r, lane); continue; } r -= I_DN;
        if (r < I_W1) { p0_transpose_item(p.in[9], 2048, 64, (bf16_t*)(ws + WS_W1TK), 0, scr, r, lane); continue; } r -= I_W1;
        p0_transpose_item(p.in[12], 2048, 64, (bf16_t*)(ws + WS_W1TV), 0, scr, r, lane);
    }
    if (blockIdx.x >= gridDim.x - 16) {
        const int bq_ = (int)blockIdx.x - ((int)gridDim.x - 16), kv = bq_ >> 3, kp = bq_ & 7; const float* pos = p.in[kv ? 11 : 8]; const float* w1 = p.in[kv ? 12 : 9];
        LAS float* ptL = (LAS float*)(lds + 135168);
        const int e = tid & 63, sub = tid >> 6, k0 = kp * 256 + sub * 32;
        float pv_[32], wv_[32];
#pragma unroll
        for (int i = 0; i < 32; ++i) { pv_[i] = pos[k0 + i]; wv_[i] = w1[(size_t)(k0 + i) * 64 + e]; }
        float a0 = 0.f, a1 = 0.f, a2 = 0.f, a3 = 0.f;
#pragma unroll
        for (int i = 0; i < 32; i += 4) { a0 += pv_[i] * wv_[i]; a1 += pv_[i + 1] * wv_[i + 1]; a2 += pv_[i + 2] * wv_[i + 2]; a3 += pv_[i + 3] * wv_[i + 3]; }
        ptL[sub * 64 + e] = (a0 + a1) + (a2 + a3);
        __syncthreads();
        if (tid < 64) { float pt = 0.f;
#pragma unroll
            for (int ww = 0; ww < 8; ++ww) pt += ptL[ww * 64 + tid];
            ((float*)(ws + WS_PT))[(kv * 8 + kp) * 64 + tid] = pt; }
        __syncthreads();
    }
    const int gt = blockIdx.x * 512 + tid, NGT = gridDim.x * 512;
    { u32x4* z = (u32x4*)((bf16_t*)(ws + WS_IN1) + (size_t)2328 * 1024); const int n16 = 232 * 1024 * 2 / 16;
      for (int i = gt; i < n16; i += NGT) z[i] = (u32x4){0u, 0u, 0u, 0u}; }
    { const float* wsrc = p.in[16]; bf16_t* tr = (bf16_t*)(ws + WS_TRIL);
      for (int i = gt; i < 4 * 128 * 128; i += NGT) { const int t = (i >> 7) & 127, s = i & 127; tr[i] = (bf16_t)((s <= t) ? f2bf(wsrc[i]) : 0u); } }
    { const float* x = p.in[0]; bf16_t* xb = (bf16_t*)(ws + WS_XB);
      for (int m = gw; m < MTOK; m += 4 * NGW) {
          f32x4 v[4][4];
#pragma unroll
          for (int r = 0; r < 4; ++r) { const int mm = m + r * NGW; if (mm < MTOK) { const f32x4* xr = (const f32x4*)(x + (size_t)mm * DM) + lane;
#pragma unroll
              for (int j = 0; j < 4; ++j) v[r][j] = xr[64 * j]; } }
#pragma unroll
          for (int r = 0; r < 4; ++r) { const int mm = m + r * NGW; if (mm < MTOK) { u32x2* o8 = (u32x2*)(xb + (size_t)mm * DM) + lane;
#pragma unroll
              for (int j = 0; j < 4; ++j) { u32x2 w; w.x = pk2(v[r][j].x, v[r][j].y); w.y = pk2(v[r][j].z, v[r][j].w); o8[64 * j] = w; } } } } }
}

template <bool F32IN, bool F32OUT>
__device__ __forceinline__ void ln_phase(const float* xin, const bf16_t* xbin, const bf16_t* mb, const float* gam, const float* bet, float* xout, bf16_t* xb) {
    const int tid = opaque_tid(), lane = tid & 63, wave = tid >> 6;
    const int G_ = gridDim.x, bx_ = blockIdx.x; const bool xown = (G_ == 256);
    const int vc_ = xown ? (bx_ % 8) * 32 + bx_ / 8 : bx_;
    const int r_ = bx_ / 8, p_ = r_ & 7, qw_ = (r_ >> 3) * 8 + wave, panel0 = (bx_ % 8) * 16 + p_;
    f32x4 gv[4], bv[4];
#pragma unroll
    for (int j = 0; j < 4; ++j) { gv[j] = ((const f32x4*)gam)[64 * j + lane]; bv[j] = ((const f32x4*)bet)[64 * j + lane]; }
    const int nrows = xown ? 16 : (MTOK + G_ * 8 - 1) / (G_ * 8);
    for (int it_ = 0; it_ < nrows; ++it_) {
        const int m = xown ? (panel0 + 8 * (it_ >> 3)) * 256 + qw_ + 32 * (it_ & 7) : bx_ * 8 + wave + it_ * G_ * 8;
        if (m >= MTOK) break;
        const u32x2* mr = (const u32x2*)(mb + (size_t)m * DM) + lane;
        f32x4 v[4]; float s = 0.f;
#pragma unroll
        for (int j = 0; j < 4; ++j) { f32x4 x;
            if (F32IN) x = ((const f32x4*)(xin + (size_t)m * DM) + lane)[64 * j];
            else { const u32x2 xw = ((const u32x2*)(xbin + (size_t)m * DM) + lane)[64 * j]; x.x = bflo(xw.x); x.y = bfhi(xw.x); x.z = bflo(xw.y); x.w = bfhi(xw.y); }
            const u32x2 w = mr[64 * j];
            v[j].x = ALPHA * x.x + bflo(w.x); v[j].y = ALPHA * x.y + bfhi(w.x); v[j].z = ALPHA * x.z + bflo(w.y); v[j].w = ALPHA * x.w + bfhi(w.y);
            s += (v[j].x + v[j].y) + (v[j].z + v[j].w); }
        const float mean = wave_sum(s) * (1.f / DM); float s2 = 0.f;
#pragma unroll
        for (int j = 0; j < 4; ++j) { v[j] = v[j] - mean; s2 += (v[j].x * v[j].x + v[j].y * v[j].y) + (v[j].z * v[j].z + v[j].w * v[j].w); }
        const float rstd = rsqrtf(wave_sum(s2) * (1.f / DM) + LN_EPS);
#pragma unroll
        for (int j = 0; j < 4; ++j) { const f32x4 o = v[j] * rstd * gv[j] + bv[j];
            if (F32OUT) ((f32x4*)(xout + (size_t)m * DM) + lane)[64 * j] = o;
            else { u32x2 w; w.x = pk2(o.x, o.y); w.y = pk2(o.z, o.w); ((u32x2*)(xb + (size_t)m * DM) + lane)[64 * j] = w; } }
    }
}

constexpr int KS = 144;
constexpr int TILEB = 64 * KS;
constexpr int L_K = 0, L_V = 2 * TILEB, L_WSF = 4 * TILEB  , L_DONE = L_WSF + 1024, L_IMP = L_DONE + 256  , L_SEL = L_IMP + 4 * 64 * 33 * 4  , L_OACC = 73728;

__device__ __forceinline__ s16x4 vtr(const LAS char* p) { return __builtin_bit_cast(s16x4, __builtin_amdgcn_ds_read_tr16_b64_v4i16((LAS v4i16_t*)p)); }

__device__ __forceinline__ f32x16 qk_sub(const LAS char* kt, int sub, const bf16x8 (&qr)[4], int r32, int hi) {
    f32x16 s;
#pragma unroll
    for (int i = 0; i < 16; ++i) s[i] = 0.f;
    const LAS char* kp = kt + (32 * sub + r32) * KS + hi * 16;
#pragma unroll
    for (int d0 = 0; d0 < 4; ++d0) { const bf16x8 a = *(const LAS bf16x8*)(kp + d0 * 32); s = MFMA32(a, qr[d0], s); }
    return s;
}
__device__ __forceinline__ void pv_sub(f32x16 (&o)[2], const f32x16& p, const LAS char* vt, int sub, int lane) {
    const int hi = lane >> 5;
    const LAS char* vp = vt + (32 * sub + 4 * hi + ((lane & 15) >> 2)) * KS + (16 * ((lane >> 4) & 1) + 4 * (lane & 3)) * 2;
#pragma unroll
    for (int s = 0; s < 2; ++s) {
        u32x4 pw; pw.x = pk2(p[8 * s + 0], p[8 * s + 1]); pw.y = pk2(p[8 * s + 2], p[8 * s + 3]); pw.z = pk2(p[8 * s + 4], p[8 * s + 5]); pw.w = pk2(p[8 * s + 6], p[8 * s + 7]);
        const bf16x8 pa = __builtin_bit_cast(bf16x8, pw);
#pragma unroll
        for (int db = 0; db < 2; ++db) {
            const s16x4 lo = vtr(vp + (16 * s) * KS + db * 64), hi4 = vtr(vp + (16 * s + 8) * KS + db * 64);
            const bf16x8 vb = (bf16x8){lo[0], lo[1], lo[2], lo[3], hi4[0], hi4[1], hi4[2], hi4[3]};
            o[db] = MFMA32(pa, vb, o[db]);
        }
    }
}
__device__ __forceinline__ void bcast_rows(float (&f)[16], LAS float* wsf_w, float val, int r32, int hi) {
    LDSW();
    if (hi == 0) wsf_w[r32] = val;
    LDSW();
#pragma unroll
    for (int r = 0; r < 16; ++r) f[r] = wsf_w[crow(r, hi)];
    LDSW();
}

__device__ __forceinline__ void sb_unit(const Params& p, LAS unsigned char* lds8, int b, int hp, int qb) {
    LAS char* lds = (LAS char*)lds8;
    const int tid = opaque_tid(), lane = tid & 63, w = __builtin_amdgcn_readfirstlane(tid >> 6), r32 = lane & 31, hi = lane >> 5;
    const int hd = w >> 2, hh = 2 * hp + hd, wq = w & 3;
    const bf16_t* H0 = (const bf16_t*)(p.ws + WS_H);
    bf16_t* MIX = (bf16_t*)(p.ws + WS_MIX);
    const size_t rowbase = (size_t)b * SEQ;
    const int t = 128 * qb + 32 * wq + r32, twmax = 128 * qb + 32 * wq + 31;
    constexpr int SB_K = 0, SB_V = 4 * TILEB, SB_DONE = 8 * TILEB;
    bf16x8 qr[4];
    { const bf16_t* qp = H0 + (rowbase + t) * HW + hh * 64;
#pragma unroll
      for (int d0 = 0; d0 < 4; ++d0) qr[d0] = *(const bf16x8*)(qp + 16 * d0 + 8 * hi); }
    f32x16 o[2];
#pragma unroll
    for (int i = 0; i < 16; ++i) { o[0][i] = 0.f; o[1][i] = 0.f; }
    float R = 0.f; bool wdone = false;
    const int lrow = tid >> 3, lch = tid & 7;
    const bf16_t* kg = H0 + (rowbase + lrow) * HW + 512 + (2 * hp) * 64 + lch * 8; const bf16_t* vg = kg + 512;
    LAS unsigned* doneL = (LAS unsigned*)(lds + SB_DONE);
    int j = 2 * qb + 1;
    u32x4 k0 = *(const u32x4*)(kg + (size_t)(64 * j) * HW), k1 = *(const u32x4*)(kg + (size_t)(64 * j) * HW + 64);
    u32x4 v0 = *(const u32x4*)(vg + (size_t)(64 * j) * HW), v1 = *(const u32x4*)(vg + (size_t)(64 * j) * HW + 64);
    for (int it = 0;; ++it) {
        LAS char* kw = lds + SB_K + (it & 1) * 2 * TILEB + lrow * KS + lch * 16; LAS char* vw = lds + SB_V + (it & 1) * 2 * TILEB + lrow * KS + lch * 16;
        *(LAS u32x4*)kw = k0; *(LAS u32x4*)(kw + TILEB) = k1; *(LAS u32x4*)vw = v0; *(LAS u32x4*)(vw + TILEB) = v1;
        if (lane == 0) doneL[(it & 1) * 8 + w] = wdone ? 1u : 0u;
        __syncthreads();
        { const u32x4 d0 = *(const LAS u32x4*)(doneL + (it & 1) * 8), d1 = *(const LAS u32x4*)(doneL + (it & 1) * 8 + 4);
          const unsigned all = d0.x & d0.y & d0.z & d0.w & d1.x & d1.y & d1.z & d1.w;
          if (all) break; }
        if (j > 0) { k0 = *(const u32x4*)(kg + (size_t)(64 * (j - 1)) * HW); k1 = *(const u32x4*)(kg + (size_t)(64 * (j - 1)) * HW + 64);
                     v0 = *(const u32x4*)(vg + (size_t)(64 * (j - 1)) * HW); v1 = *(const u32x4*)(vg + (size_t)(64 * (j - 1)) * HW + 64); }
        const LAS char* kt = lds + SB_K + ((it & 1) * 2 + hd) * TILEB; const LAS char* vt = lds + SB_V + ((it & 1) * 2 + hd) * TILEB;
#pragma unroll
        for (int sb_ = 0; sb_ < 2; ++sb_) {
            const int sub = 1 - sb_;
            const int kvb = 64 * j + 32 * sub;
            if (kvb >= twmax || wdone) continue;
            const f32x16 s = qk_sub(kt, sub, qr, r32, hi);
            float lr[16], lb[16];
#pragma unroll
            for (int r = 0; r < 16; ++r) {
                const int kv = kvb + crow(r, hi); const float z = s[r] * 0.125f;
                const float sp = fmaxf(z, 0.f) + __logf(1.f + __expf(-fabsf(z)));
                const bool past = kv < t;
                lr[r] = past ? -sp : 0.f; lb[r] = z - sp;
            }
            float T[4], To[4], aft[16];
#pragma unroll
            for (int gq = 0; gq < 4; ++gq) {
                aft[4 * gq + 3] = 0.f; aft[4 * gq + 2] = lr[4 * gq + 3]; aft[4 * gq + 1] = aft[4 * gq + 2] + lr[4 * gq + 2]; aft[4 * gq + 0] = aft[4 * gq + 1] + lr[4 * gq + 1];
                T[gq] = aft[4 * gq + 0] + lr[4 * gq + 0];
            }
#pragma unroll
            for (int gq = 0; gq < 4; ++gq) To[gq] = xor32(T[gq]);
            float A = 0.f;
            f32x16 pw;
#pragma unroll
            for (int gq = 3; gq >= 0; --gq) {
                const float ga = A + (hi == 0 ? To[gq] : 0.f);
#pragma unroll
                for (int i = 0; i < 4; ++i) { const int r = 4 * gq + i; const int kv = kvb + crow(r, hi);
                    const float e = __expf(lb[r] + R + ga + aft[r]); pw[r] = (kv < t) ? e : 0.f; }
                A += T[gq] + To[gq];
            }
            R += A;
            pv_sub(o, pw, vt, sub, lane);
            wdone = __all(R < -45.f);
        }
        wdone = wdone || __all(R < -45.f);
        if (j == 0) break;
        --j;
    }
    __syncthreads();
    bf16_t* op = MIX + (rowbase + 128 * qb + 32 * wq) * DM + hh * 64 + r32;
#pragma unroll
    for (int r = 0; r < 16; ++r) { const int q = crow(r, hi);
        op[(size_t)q * DM] = (bf16_t)f2bf(o[0][r]); op[(size_t)q * DM + 32] = (bf16_t)f2bf(o[1][r]); }
}

__device__ __forceinline__ void conv_unit(const Params& p, LAS unsigned char* lds8, int b, int tile) {
    const int tid = opaque_tid(), lane = tid & 63, w = tid >> 6;
    const bf16_t* H0 = (const bf16_t*)(p.ws + WS_H);
    bf16_t* MIX = (bf16_t*)(p.ws + WS_MIX);
    LAS bf16_t* hL = (LAS bf16_t*)lds8;
    LAS float* yL = (LAS float*)(lds8 + 63488);
    const int t0 = 32 * tile;
    const float* cw = p.in[2]; const float bias = p.in[3][tid];
    float wd[31];
#pragma unroll
    for (int k = 0; k < 31; ++k) wd[k] = cw[k * 512 + tid];
    const f32x4 g0 = ((const f32x4*)p.in[4])[lane * 2], g1 = ((const f32x4*)p.in[4])[lane * 2 + 1];
    const f32x4 b0 = ((const f32x4*)p.in[5])[lane * 2], b1 = ((const f32x4*)p.in[5])[lane * 2 + 1];
    {
        u32x4 av[8], gv8[8];
#pragma unroll
        for (int i = 0; i < 8; ++i) { const int tt = w + 8 * i, tok = t0 - 30 + tt; av[i] = (u32x4){0u, 0u, 0u, 0u}; gv8[i] = (u32x4){0u, 0u, 0u, 0u};
            if (tt < 62 && tok >= 0) { const bf16_t* rp = H0 + ((size_t)b * SEQ + tok) * HW + 1536 + lane * 8; av[i] = *(const u32x4*)rp; gv8[i] = *(const u32x4*)(rp + 512); } }
#pragma unroll
        for (int i = 0; i < 8; ++i) { const int tt = w + 8 * i; const u32x4 a = av[i], g = gv8[i]; u32x4 o;
            o.x = pk2(bflo(a.x) * sigmoidf_(bflo(g.x)), bfhi(a.x) * sigmoidf_(bfhi(g.x)));
            o.y = pk2(bflo(a.y) * sigmoidf_(bflo(g.y)), bfhi(a.y) * sigmoidf_(bfhi(g.y)));
            o.z = pk2(bflo(a.z) * sigmoidf_(bflo(g.z)), bfhi(a.z) * sigmoidf_(bfhi(g.z)));
            o.w = pk2(bflo(a.w) * sigmoidf_(bflo(g.w)), bfhi(a.w) * sigmoidf_(bfhi(g.w)));
            if (tt < 62) *(LAS u32x4*)(hL + tt * 512 + lane * 8) = o; }
    }
    __syncthreads();
    {
        const int c = tid;
        float hv[62];
#pragma unroll
        for (int i = 0; i < 62; ++i) hv[i] = bf2f((unsigned)hL[i * 512 + c]);
#pragma unroll
        for (int tq = 0; tq < 32; ++tq) { float y = bias;
#pragma unroll
            for (int k = 0; k < 31; ++k) y += hv[tq + k] * wd[k];
            yL[tq * 512 + c] = y; }
    }
    __syncthreads();
    {
#pragma unroll
        for (int i = 0; i < 4; ++i) { const int tq = 4 * w + i;
            f32x4 v0 = *(const LAS f32x4*)(yL + tq * 512 + lane * 8), v1 = *(const LAS f32x4*)(yL + tq * 512 + lane * 8 + 4);
            const float mean = wave_sum((v0.x + v0.y) + (v0.z + v0.w) + (v1.x + v1.y) + (v1.z + v1.w)) * (1.f / 512.f);
            v0 = v0 - mean; v1 = v1 - mean;
            const float var = wave_sum((v0.x * v0.x + v0.y * v0.y) + (v0.z * v0.z + v0.w * v0.w) + (v1.x * v1.x + v1.y * v1.y) + (v1.z * v1.z + v1.w * v1.w)) * (1.f / 512.f);
            const float rstd = rsqrtf(var + LN_EPS);
            v0 = v0 * rstd * g0 + b0; v1 = v1 * rstd * g1 + b1;
            u32x4 o; o.x = pk2(siluf_(v0.x), siluf_(v0.y)); o.y = pk2(siluf_(v0.z), siluf_(v0.w)); o.z = pk2(siluf_(v1.x), siluf_(v1.y)); o.w = pk2(siluf_(v1.z), siluf_(v1.w));
            *(u32x4*)(MIX + ((size_t)b * SEQ + t0 + tq) * DM + 512 + lane * 8) = o; }
    }
    __syncthreads();
}

__device__ __forceinline__ void compress_unit(const Params& p, LAS unsigned char* lds8, int b, int g, int kv, int nt) {
    LAS char* lds = (LAS char*)lds8;
    const int tid = opaque_tid(), lane = tid & 63, w = __builtin_amdgcn_readfirstlane(tid >> 6), r32 = lane & 31, hi = lane >> 5;
    const bf16_t* H1 = (const bf16_t*)(p.ws + WS_H);
    const float* w2 = p.in[kv ? 13 : 10];
    const bf16_t* w1t = (const bf16_t*)(p.ws + (kv ? WS_W1TV : WS_W1TK));
    bf16_t* outp = (bf16_t*)(p.ws + (kv ? WS_VCMP : WS_KCMP)) + (size_t)((b * 2 + g) * 128 + 32 * nt) * 64;
    constexpr int L_SLAB = 0, L_PART = 76032, L_PT = 76032 + 65536;
    LAS float* partL = (LAS float*)(lds + L_PART); const float* ptg = (const float*)(p.ws + WS_PT) + kv * 512;
    const int col = 512 + kv * 128 + g * 64;
#pragma unroll
    for (int it9 = 0; it9 < 9; ++it9) { const int idx = tid + 512 * it9; if (idx >= 528 * 8) break; const int i = idx >> 3, ch = idx & 7, tok = 512 * nt + i;
        u32x4 v = (u32x4){0u, 0u, 0u, 0u};
        if (tok < SEQ) v = *(const u32x4*)(H1 + ((size_t)b * SEQ + tok) * HW + col + ch * 8);
        *(LAS u32x4*)(lds + L_SLAB + ((i & 15) * 33 + (i >> 4)) * KS + ch * 16) = v; }
    __syncthreads();
    f32x16 acc[2];
#pragma unroll
    for (int i = 0; i < 16; ++i) { acc[0][i] = 0.f; acc[1][i] = 0.f; }
#pragma unroll
    for (int li = 0; li < 4; ++li) { const int l = 4 * w + li, c = l & 15, mo = l >> 4;
        const LAS char* ap = lds + L_SLAB + (c * 33 + r32 + mo) * KS + hi * 16;
        const bf16_t* bp = w1t + (size_t)r32 * 2048 + l * 64 + 8 * hi;
#pragma unroll
        for (int d0 = 0; d0 < 4; ++d0) { const bf16x8 a = *(const LAS bf16x8*)(ap + d0 * 32);
            const bf16x8 b0 = *(const bf16x8*)(bp + 16 * d0), b1 = *(const bf16x8*)(bp + (size_t)32 * 2048 + 16 * d0);
            acc[0] = MFMA32(a, b0, acc[0]); acc[1] = MFMA32(a, b1, acc[1]); } }
#pragma unroll
    for (int r = 0; r < 16; ++r) { const int n = crow(r, hi); partL[(w * 32 + n) * 64 + r32] = acc[0][r]; partL[(w * 32 + n) * 64 + 32 + r32] = acc[1][r]; }
    __syncthreads();
    LAS float* hidL = (LAS float*)(lds + L_SLAB);
    LAS float* w2L = (LAS float*)(lds + L_SLAB + 8448);
    { const f32x4 wa = ((const f32x4*)w2)[tid], wb = ((const f32x4*)w2)[tid + 512]; *(LAS f32x4*)(w2L + tid * 4) = wa; *(LAS f32x4*)(w2L + (tid + 512) * 4) = wb; }
#pragma unroll
    for (int i = 0; i < 4; ++i) { const int idx = tid + 512 * i, n = idx >> 6, e = idx & 63; float s = 0.f;
#pragma unroll
        for (int ww = 0; ww < 8; ++ww) s += partL[(ww * 32 + n) * 64 + e];
        const float pt = ((ptg[e] + ptg[64 + e]) + (ptg[128 + e] + ptg[192 + e])) + ((ptg[256 + e] + ptg[320 + e]) + (ptg[384 + e] + ptg[448 + e]));
        hidL[n * 65 + e] = gelu_tanh(s + pt); }
    __syncthreads();
    { const int n = tid >> 4, e2 = (tid & 15) * 4; float o0 = 0.f, o1 = 0.f, o2 = 0.f, o3 = 0.f;
#pragma unroll 8
      for (int e = 0; e < 64; ++e) { const float hval = hidL[n * 65 + e]; const f32x4 wv = *(const LAS f32x4*)(w2L + e * 64 + e2);
          o0 += hval * wv.x; o1 += hval * wv.y; o2 += hval * wv.z; o3 += hval * wv.w; }
      u32x2 ov; ov.x = pk2(o0, o1); ov.y = pk2(o2, o3);
      if (32 * nt + n >= 127) { ov.x = 0u; ov.y = 0u; }
      *(u32x2*)(outp + (size_t)n * 64 + e2) = ov; }
    __syncthreads();
}

__device__ __forceinline__ void gmlp_unit(const Params& p, LAS unsigned char* lds8, int b, int ch) {
    LAS char* lds = (LAS char*)lds8;
    const int tid = opaque_tid(), lane = tid & 63, w = __builtin_amdgcn_readfirstlane(tid >> 6), r32 = lane & 31, hi = lane >> 5;
    const bf16_t* H1 = (const bf16_t*)(p.ws + WS_H);
    bf16_t* MIX = (bf16_t*)(p.ws + WS_MIX);
    const bf16_t* TR = (const bf16_t*)(p.ws + WS_TRIL);
    constexpr int VS = 1040;
    const size_t row0 = (size_t)b * SEQ + 128 * ch;
    {
        const f32x4 g0 = ((const f32x4*)p.in[14])[lane * 2], g1 = ((const f32x4*)p.in[14])[lane * 2 + 1];
        const f32x4 b0 = ((const f32x4*)p.in[15])[lane * 2], b1 = ((const f32x4*)p.in[15])[lane * 2 + 1];
        for (int tq0 = w; tq0 < 128; tq0 += 64) {
            u32x4 raw4[8];
#pragma unroll
            for (int i = 0; i < 8; ++i) raw4[i] = *(const u32x4*)(H1 + (row0 + tq0 + 8 * i) * HW + 1792 + lane * 8);
#pragma unroll
            for (int i = 0; i < 8; ++i) { const int tq = tq0 + 8 * i; const u32x4 raw = raw4[i];
            f32x4 v0, v1;
            v0.x = gelu_tanh(bflo(raw.x)); v0.y = gelu_tanh(bfhi(raw.x)); v0.z = gelu_tanh(bflo(raw.y)); v0.w = gelu_tanh(bfhi(raw.y));
            v1.x = gelu_tanh(bflo(raw.z)); v1.y = gelu_tanh(bfhi(raw.z)); v1.z = gelu_tanh(bflo(raw.w)); v1.w = gelu_tanh(bfhi(raw.w));
            const float mean = wave_sum((v0.x + v0.y) + (v0.z + v0.w) + (v1.x + v1.y) + (v1.z + v1.w)) * (1.f / 512.f);
            v0 = v0 - mean; v1 = v1 - mean;
            const float var = wave_sum((v0.x * v0.x + v0.y * v0.y) + (v0.z * v0.z + v0.w * v0.w) + (v1.x * v1.x + v1.y * v1.y) + (v1.z * v1.z + v1.w * v1.w)) * (1.f / 512.f);
            const float rstd = rsqrtf(var + LN_EPS);
            v0 = v0 * rstd * g0 + b0; v1 = v1 * rstd * g1 + b1;
            u32x4 o; o.x = pk2(v0.x, v0.y); o.y = pk2(v0.z, v0.w); o.z = pk2(v1.x, v1.y); o.w = pk2(v1.z, v1.w);
            *(LAS u32x4*)(lds + tq * VS + lane * 16) = o; }
        }
    }
    __syncthreads();
    const int gi = w >> 1, th = w & 1;
    f32x16 acc[2][4];
#pragma unroll
    for (int a = 0; a < 2; ++a)
#pragma unroll
        for (int d = 0; d < 4; ++d)
#pragma unroll
            for (int i = 0; i < 16; ++i) acc[a][d][i] = 0.f;
    const bf16_t* ap = TR + (size_t)(gi * 128 + 64 * th + r32) * 128 + 8 * hi;
    const LAS char* vp = lds + (8 * hi + ((lane & 15) >> 2)) * VS + (128 * gi + 16 * ((lane >> 4) & 1) + 4 * (lane & 3)) * 2;
    const int nks = 4 * th + 4;
    for (int ks = 0; ks < nks; ++ks) {
        const bf16x8 a0 = *(const bf16x8*)(ap + 16 * ks), a1 = *(const bf16x8*)(ap + 32 * 128 + 16 * ks);
#pragma unroll
        for (int db = 0; db < 4; ++db) {
            const s16x4 lo = vtr(vp + (16 * ks) * VS + db * 64), hi4 = vtr(vp + (16 * ks + 4) * VS + db * 64);
            const bf16x8 vb = (bf16x8){lo[0], lo[1], lo[2], lo[3], hi4[0], hi4[1], hi4[2], hi4[3]};
            acc[0][db] = MFMA32(a0, vb, acc[0][db]); acc[1][db] = MFMA32(a1, vb, acc[1][db]);
        }
    }
    __syncthreads();
    {
        const float* bs = p.in[17] + gi * 128;
        LAS float* st = (LAS float*)(lds + w * 16896);
        const int rrow = lane >> 4, c8 = (lane & 15) * 8;
#pragma unroll
        for (int tb = 0; tb < 2; ++tb) {
#pragma unroll
            for (int r = 0; r < 16; ++r) { const int q = crow(r, hi); const float bias = bs[64 * th + 32 * tb + q];
#pragma unroll
                for (int db = 0; db < 4; ++db) st[q * 132 + 32 * db + r32] = acc[tb][db][r] + bias; }
            LDSW();
#pragma unroll
            for (int i = 0; i < 8; ++i) { const int row = 4 * i + rrow, tq = 64 * th + 32 * tb + row;
                const f32x4 m0 = *(const LAS f32x4*)(st + row * 132 + c8), m1 = *(const LAS f32x4*)(st + row * 132 + c8 + 4);
                const u32x4 uu = *(const u32x4*)(H1 + (row0 + tq) * HW + 1280 + 128 * gi + c8);
                u32x4 o; o.x = pk2(gelu_tanh(bflo(uu.x)) * m0.x, gelu_tanh(bfhi(uu.x)) * m0.y); o.y = pk2(gelu_tanh(bflo(uu.y)) * m0.z, gelu_tanh(bfhi(uu.y)) * m0.w);
                o.z = pk2(gelu_tanh(bflo(uu.z)) * m1.x, gelu_tanh(bfhi(uu.z)) * m1.y); o.w = pk2(gelu_tanh(bflo(uu.w)) * m1.z, gelu_tanh(bfhi(uu.w)) * m1.w);
                *(u32x4*)(MIX + (row0 + tq) * DM + 512 + 128 * gi + c8) = o; }
            LDSW();
        }
    }
    __syncthreads();
}

template <int MODE>
__device__ __forceinline__ void nsa_tile(float& m, float& l, f32x16 (&o)[2], const LAS char* kt, const LAS char* vt, LAS float* wsf_w, const bf16x8 (&qr)[4],
                                         int j, unsigned selm, int t, int twmin, int twmax, int lane) {
    const int r32 = lane & 31, hi = lane >> 5;
    const bool selected = (MODE == 1) ? (((selm >> j) & 1u) != 0u) : true;
    if (64 * j + 63 <= twmin && (MODE == 1 || 64 * j >= twmax - 511)) {
        if (MODE == 1 && !__any(selected)) return;
        bf16x8 kf[8];
        { const LAS char* kp = kt + r32 * KS + hi * 16;
#pragma unroll
          for (int i = 0; i < 8; ++i) kf[i] = *(const LAS bf16x8*)(kp + (i >> 2) * (32 * KS) + (i & 3) * 32); }
        __builtin_amdgcn_sched_barrier(0);
        f32x16 s0, s1;
#pragma unroll
        for (int i = 0; i < 16; ++i) { s0[i] = 0.f; s1[i] = 0.f; }
#pragma unroll
        for (int d0 = 0; d0 < 4; ++d0) { s0 = MFMA32(kf[d0], qr[d0], s0); s1 = MFMA32(kf[4 + d0], qr[d0], s1); }
        s16x4 vf[16];
        { const LAS char* vp = vt + (4 * hi + ((lane & 15) >> 2)) * KS + (16 * ((lane >> 4) & 1) + 4 * (lane & 3)) * 2;
#pragma unroll
          for (int i = 0; i < 16; ++i) { const int sub = i >> 3, ss = (i >> 2) & 1, db = (i >> 1) & 1, jj = i & 1;
              vf[i] = vtr(vp + (32 * sub + 16 * ss + 8 * jj) * KS + db * 64); } }
        __builtin_amdgcn_sched_barrier(0);
        float mx = fmaxf(fmaxf(s0[0], s0[1]), fmaxf(s1[0], s1[1]));
#pragma unroll
        for (int r = 2; r < 16; r += 2) mx = fmaxf(mx, fmaxf(fmaxf(s0[r], s0[r + 1]), fmaxf(s1[r], s1[r + 1])));
        mx *= C2; mx = fmaxf(mx, xor32(mx));
        const float cand = selected ? mx : -1e30f;
        if (__any(cand > m + 8.f)) {
            const float mn = fmaxf(m, cand), f = __builtin_amdgcn_exp2f(m - mn);
            l *= f; m = mn;
            float fr[16]; bcast_rows(fr, wsf_w, f, r32, hi);
#pragma unroll
            for (int r = 0; r < 16; ++r) { o[0][r] *= fr[r]; o[1][r] *= fr[r]; }
        }
        const float nme = selected ? -m : -1e30f;
        f32x16 p0, p1; float ls0 = 0.f, ls1 = 0.f, ls2 = 0.f, ls3 = 0.f;
#pragma unroll
        for (int r = 0; r < 16; r += 2) { p0[r] = __builtin_amdgcn_exp2f(__builtin_fmaf(s0[r], C2, nme)); ls0 += p0[r]; p0[r + 1] = __builtin_amdgcn_exp2f(__builtin_fmaf(s0[r + 1], C2, nme)); ls1 += p0[r + 1];
            p1[r] = __builtin_amdgcn_exp2f(__builtin_fmaf(s1[r], C2, nme)); ls2 += p1[r]; p1[r + 1] = __builtin_amdgcn_exp2f(__builtin_fmaf(s1[r + 1], C2, nme)); ls3 += p1[r + 1]; }
        l += (ls0 + ls1) + (ls2 + ls3);
#pragma unroll
        for (int i = 0; i < 4; ++i) { const int sub = i >> 1, ss = i & 1; const f32x16& pp = sub ? p1 : p0;
            u32x4 pw; pw.x = pk2(pp[8 * ss + 0], pp[8 * ss + 1]); pw.y = pk2(pp[8 * ss + 2], pp[8 * ss + 3]); pw.z = pk2(pp[8 * ss + 4], pp[8 * ss + 5]); pw.w = pk2(pp[8 * ss + 6], pp[8 * ss + 7]);
            const bf16x8 pa = __builtin_bit_cast(bf16x8, pw);
#pragma unroll
            for (int db = 0; db < 2; ++db) { const s16x4 lo = vf[i * 4 + db * 2], h4 = vf[i * 4 + db * 2 + 1];
                const bf16x8 vb = (bf16x8){lo[0], lo[1], lo[2], lo[3], h4[0], h4[1], h4[2], h4[3]};
                o[db] = MFMA32(pa, vb, o[db]); } }
        return;
    }
#pragma unroll 1
    for (int sub = 0; sub < 2; ++sub) {
        const int kvb = 64 * j + 32 * sub;
        if (kvb > twmax) continue;
        if (MODE == 2 && kvb + 31 + 512 <= twmin) continue;
        if (MODE == 1 && !__any(selected)) continue;
        const f32x16 s = qk_sub(kt, sub, qr, r32, hi);
        const bool need_mask = (kvb + 31 > twmin) || (MODE == 2 && kvb < twmax - 511);
        f32x16 pw; float ls = 0.f;
        if (!need_mask) {
            float mx = fmaxf(fmaxf(s[0], s[1]), fmaxf(s[2], s[3]));
#pragma unroll
            for (int r = 4; r < 16; r += 4) mx = fmaxf(mx, fmaxf(fmaxf(s[r], s[r + 1]), fmaxf(s[r + 2], s[r + 3])));
            mx *= C2; mx = fmaxf(mx, xor32(mx));
            const float cand = selected ? mx : -1e30f;
            if (__any(cand > m + 8.f)) {
                const float mn = fmaxf(m, cand), f = __builtin_amdgcn_exp2f(m - mn);
                l *= f; m = mn;
                float fr[16]; bcast_rows(fr, wsf_w, f, r32, hi);
#pragma unroll
                for (int r = 0; r < 16; ++r) { o[0][r] *= fr[r]; o[1][r] *= fr[r]; }
            }
            const float nme = selected ? -m : -1e30f;
#pragma unroll
            for (int r = 0; r < 16; ++r) { pw[r] = __builtin_amdgcn_exp2f(__builtin_fmaf(s[r], C2, nme)); ls += pw[r]; }
        } else {
            float s2[16]; float mx = -1e30f;
#pragma unroll
            for (int r = 0; r < 16; ++r) { const int kv = kvb + crow(r, hi);
                const bool valid = (kv <= t) && ((MODE == 1) ? selected : (t - kv < 512));
                s2[r] = valid ? s[r] * C2 : -1e30f; mx = fmaxf(mx, s2[r]); }
            mx = fmaxf(mx, xor32(mx));
            if (__any(mx > m + 8.f)) {
                const float mn = fmaxf(m, mx), f = __builtin_amdgcn_exp2f(m - mn);
                l *= f; m = mn;
                float fr[16]; bcast_rows(fr, wsf_w, f, r32, hi);
#pragma unroll
                for (int r = 0; r < 16; ++r) { o[0][r] *= fr[r]; o[1][r] *= fr[r]; }
            }
#pragma unroll
            for (int r = 0; r < 16; ++r) { const float e = __builtin_amdgcn_exp2f(s2[r] - m); pw[r] = (s2[r] > -1e29f) ? e : 0.f; ls += pw[r]; }
        }
        l += ls;
        pv_sub(o, pw, vt, sub, lane);
    }
}
template <int MODE, bool FINAL>
__device__ __forceinline__ void nsa_branch(LAS float* accw, bf16_t* gout, LAS char* lds, const bf16_t* kg, const bf16_t* vg, unsigned todo, const bf16x8 (&qr)[4],
                                           float gate, unsigned selm, int t, int twmin, int twmax, int tid, int lane, int w) {
    const int r32 = lane & 31, hi = lane >> 5, lrow = tid >> 3, lch = tid & 7;
    LAS float* wsf_w = (LAS float*)(lds + L_WSF) + w * 32;
    float m = -1e30f, l = 0.f;
    f32x16 o[2];
#pragma unroll
    for (int i = 0; i < 16; ++i) { o[0][i] = 0.f; o[1][i] = 0.f; }
    const bf16_t* kgl = kg + (size_t)lrow * HW + lch * 8; const bf16_t* vgl = vg + (size_t)lrow * HW + lch * 8;
    LAS char* kw0 = lds + L_K + lrow * KS + lch * 16; LAS char* vw0 = lds + L_V + lrow * KS + lch * 16;
#define NSA_POP(jv) do { jv = (MODE == 1) ? __builtin_ctz(todo) : 31 - __builtin_clz(todo); todo &= ~(1u << jv); } while (0)
#define NSA_LOAD(KR, VR, jv) do { const bf16_t* kp_ = kgl + (size_t)(64 * (jv)) * HW; const bf16_t* vp_ = vgl + (size_t)(64 * (jv)) * HW; \
        asm volatile("global_load_dwordx4 %0, %2, off\n\tglobal_load_dwordx4 %1, %3, off" : "=&v"(KR), "=&v"(VR) : "v"(kp_), "v"(vp_) : "memory"); } while (0)
#define NSA_WAIT(KR, VR) asm volatile("s_waitcnt vmcnt(2)" : "+v"(KR), "+v"(VR) : : "memory")
    u32x4 kA, vA, kB, vB;
    int j0, j1, jl; bool h1;
    NSA_POP(j0); NSA_LOAD(kA, vA, j0); jl = j0;
    h1 = todo != 0u; if (h1) { NSA_POP(j1); jl = j1; } else j1 = jl;
    NSA_LOAD(kB, vB, j1);
    for (;;) {
        NSA_WAIT(kA, vA);
        *(LAS u32x4*)kw0 = kA; *(LAS u32x4*)vw0 = vA;
        __syncthreads();
        int j2; const bool h2 = h1 && todo != 0u; if (h2) { NSA_POP(j2); jl = j2; } else j2 = jl;
        NSA_LOAD(kA, vA, j2);
        nsa_tile<MODE>(m, l, o, lds + L_K, lds + L_V, wsf_w, qr, j0, selm, t, twmin, twmax, lane);
        if (!h1) break;
        NSA_WAIT(kB, vB);
        *(LAS u32x4*)(kw0 + TILEB) = kB; *(LAS u32x4*)(vw0 + TILEB) = vB;
        __syncthreads();
        int j3; const bool h3 = h2 && todo != 0u; if (h3) { NSA_POP(j3); jl = j3; } else j3 = jl;
        NSA_LOAD(kB, vB, j3);
        nsa_tile<MODE>(m, l, o, lds + L_K + TILEB, lds + L_V + TILEB, wsf_w, qr, j1, selm, t, twmin, twmax, lane);
        if (!h2) break;
        j0 = j2; j1 = j3; h1 = h3;
    }
    asm volatile("s_waitcnt vmcnt(0)" : "+v"(kA), "+v"(vA), "+v"(kB), "+v"(vB) : : "memory");
#undef NSA_POP
#undef NSA_LOAD
#undef NSA_WAIT
    __syncthreads();
    l += xor32(l);
    const float fac = (l > 0.f) ? gate / l : 0.f;
    float fr[16]; bcast_rows(fr, wsf_w, fac, r32, hi);
    if (!FINAL) {
#pragma unroll
        for (int r = 0; r < 16; ++r) { const int q = crow(r, hi); accw[q * 64 + r32] += o[0][r] * fr[r]; accw[q * 64 + 32 + r32] += o[1][r] * fr[r]; }
    } else {
#pragma unroll
        for (int r = 0; r < 16; ++r) { const int q = crow(r, hi); bf16_t* gq_ = gout + (size_t)(q & 7) * DM + (q >> 3) * 64;
            gq_[0] = (bf16_t)f2bf(accw[q * 64 + r32] + o[0][r] * fr[r]); gq_[32] = (bf16_t)f2bf(accw[q * 64 + 32 + r32] + o[1][r] * fr[r]); }
    }
    LDSW();
}

__device__ __forceinline__ void nsa_unit(const Params& p, LAS unsigned char* lds8, int b, int g, int qb) {
    LAS char* lds = (LAS char*)lds8;
    const int tid = opaque_tid(), lane = tid & 63, w = __builtin_amdgcn_readfirstlane(tid >> 6), r32 = lane & 31, hi = lane >> 5;
    const int rh = r32 >> 3, tl = 8 * w + (r32 & 7);
    const bf16_t* H1 = (const bf16_t*)(p.ws + WS_H);
    bf16_t* MIX = (bf16_t*)(p.ws + WS_MIX);
    const size_t rowbase = (size_t)b * SEQ;
    const int t0 = 64 * qb, t = t0 + tl, twmin = t0 + 8 * w, twmax = twmin + 7;
    LAS float* wsf_w = (LAS float*)(lds + L_WSF) + w * 32;
    LAS float* impL = (LAS float*)(lds + L_IMP);
    LAS unsigned* selL = (LAS unsigned*)(lds + L_SEL);
    bf16x8 qr[4];
    float g0, g1, g2;
    { const bf16_t* qp = H1 + (rowbase + t) * HW + (g * 4 + rh) * 64;
#pragma unroll
      for (int d0 = 0; d0 < 4; ++d0) qr[d0] = *(const bf16x8*)(qp + 16 * d0 + 8 * hi);
      const bf16_t* gp = H1 + (rowbase + t) * HW + 2304 + (g * 4 + rh) * 3;
      g0 = sigmoidf_(bf2f((unsigned)gp[0])); g1 = sigmoidf_(bf2f((unsigned)gp[1])); g2 = sigmoidf_(bf2f((unsigned)gp[2])); }
    LAS float* accw = (LAS float*)(lds + L_OACC) + w * 2048;
    bf16_t* gout = MIX + (rowbase + t0 + 8 * w) * DM + (g * 4) * 64 + r32;
    {
        const bf16_t* kc = (const bf16_t*)(p.ws + WS_KCMP) + (size_t)(b * 2 + g) * 128 * 64;
        const bf16_t* vc = (const bf16_t*)(p.ws + WS_VCMP) + (size_t)(b * 2 + g) * 128 * 64;
#pragma unroll
        for (int i = 0; i < 2; ++i) { const int idx = tid + 512 * i, row = idx >> 3, ch = idx & 7;
            *(LAS u32x4*)(lds + L_K + row * KS + ch * 16) = *(const u32x4*)(kc + row * 64 + ch * 8);
            *(LAS u32x4*)(lds + L_V + row * KS + ch * 16) = *(const u32x4*)(vc + row * 64 + ch * 8); }
        __syncthreads();
        const int nmax = (t - 31) >> 4;
        const int nmaxw = (twmax - 31) >> 4;
        float m = -1e30f, l = 0.f;
#pragma unroll 1
        for (int sb = 0; sb < 4; ++sb) {
            if (32 * sb > nmaxw) break;
            const f32x16 s = qk_sub(lds + L_K, sb, qr, r32, hi);
            float s2[16]; float mx = m;
#pragma unroll
            for (int r = 0; r < 16; ++r) { const int n = 32 * sb + crow(r, hi); s2[r] = (n <= nmax) ? s[r] * C2 : -1e30f; mx = fmaxf(mx, s2[r]); }
            l *= __builtin_amdgcn_exp2f(m - mx); m = mx;
#pragma unroll
            for (int r = 0; r < 16; ++r) { const float e = __builtin_amdgcn_exp2f(s2[r] - m); l += (s2[r] > -1e29f) ? e : 0.f; }
        }
        { const float mt = fmaxf(m, xor32(m)); l *= __builtin_amdgcn_exp2f(m - mt); m = mt; l += xor32(l); }
        const float inv = (l > 0.f) ? 1.f / l : 0.f;
        f32x16 o[2];
#pragma unroll
        for (int i = 0; i < 16; ++i) { o[0][i] = 0.f; o[1][i] = 0.f; }
        LAS float* ip = impL + ((rh * 64) + tl) * 33 + hi; float lprev = 0.f;
#pragma unroll 1
        for (int sb = 0; sb < 4; ++sb) {
            if (32 * sb > nmaxw) {
#pragma unroll
                for (int gq = 0; gq < 4; ++gq) ip[2 * (4 * sb + gq)] = (hi == 0 && gq == 0) ? lprev : 0.f;
                lprev = 0.f; continue; }
            const f32x16 s = qk_sub(lds + L_K, sb, qr, r32, hi);
            f32x16 pw;
#pragma unroll
            for (int r = 0; r < 16; ++r) { const int n = 32 * sb + crow(r, hi); const float e = __builtin_amdgcn_exp2f(s[r] * C2 - m) * inv; pw[r] = (n <= nmax) ? e : 0.f; }
#pragma unroll
            for (int gq = 0; gq < 4; ++gq) {
                const float Gv = (pw[4 * gq] + pw[4 * gq + 1]) + (pw[4 * gq + 2] + pw[4 * gq + 3]);
                const float lcur = xor32(pw[4 * gq + 3]);
                ip[2 * (4 * sb + gq)] = Gv + (hi ? lcur : lprev); lprev = lcur; }
            pv_sub(o, pw, lds + L_V, sb, lane);
        }
        float fr[16]; bcast_rows(fr, wsf_w, g0, r32, hi);
#pragma unroll
        for (int r = 0; r < 16; ++r) { const int q = crow(r, hi); accw[q * 64 + r32] = o[0][r] * fr[r]; accw[q * 64 + 32 + r32] = o[1][r] * fr[r]; }
    }
    __syncthreads();
#ifndef XTOPK
    { const int tok = tid >> 3, j0 = (tid & 7) * 4;
#pragma unroll
      for (int jj = 0; jj < 4; ++jj) { LAS float* q0 = impL + tok * 33 + j0 + jj; q0[0] = ((q0[0] + q0[64 * 33]) + q0[2 * 64 * 33]) + q0[3 * 64 * 33]; } }
    __syncthreads();
    if (w == 0) {
        float sc[32];
#pragma unroll
        for (int jj = 0; jj < 32; ++jj) { const float v = impL[lane * 33 + jj];
            const bool forced = (jj == 0) || (jj == qb) || (jj == qb - 1);
            sc[jj] = (jj <= qb) ? v + (forced ? 1000.f : 0.f) : -1e30f; }
        unsigned mask = 0u;
        if (qb < 8) mask = (2u << qb) - 1u;
        else {
#pragma unroll 1
            for (int k = 0; k < 8; ++k) { float best = -3e38f; int bj = 0;
#pragma unroll
                for (int jj = 0; jj < 32; ++jj) { const float v = ((mask >> jj) & 1u) ? -3e38f : sc[jj]; if (v > best) { best = v; bj = jj; } }
                mask |= 1u << bj; }
        }
        selL[lane] = mask;
        unsigned un = mask;
#pragma unroll
        for (int o = 1; o < 64; o <<= 1) un |= (unsigned)__shfl_xor((int)un, o);
        if (lane == 0) selL[64] = un;
    }
#endif
    __syncthreads();
    const unsigned selm = selL[tl], uni = selL[64];
#ifndef XSEL
    { const unsigned vmask = (qb >= 31) ? 0xffffffffu : ((2u << qb) - 1u);
      nsa_branch<1, false>(accw, gout, lds, H1 + rowbase * HW + 768 + g * 64, H1 + rowbase * HW + 896 + g * 64, (uni & vmask) | 1u, qr, g1, selm, t, twmin, twmax, tid, lane, w);
#ifdef PROBE_SEL
      nsa_branch<1, false>(accw, gout, lds, H1 + rowbase * HW + 768 + g * 64, H1 + rowbase * HW + 896 + g * 64, (uni & vmask) | 1u, qr, 0.f, selm, t, twmin, twmax, tid, lane, w);
#endif
    }
#endif
#ifndef XWIN
    { const int lo = qb > 8 ? qb - 8 : 0; const unsigned vmask = (qb >= 31) ? 0xffffffffu : ((2u << qb) - 1u); const unsigned todo = vmask & ~((1u << lo) - 1u);
#ifdef PROBE_WIN
      nsa_branch<2, false>(accw, gout, lds, H1 + rowbase * HW + 1024 + g * 64, H1 + rowbase * HW + 1152 + g * 64, todo, qr, 0.f, 0u, t, twmin, twmax, tid, lane, w);
#endif
      nsa_branch<2, true>(accw, gout, lds, H1 + rowbase * HW + 1024 + g * 64, H1 + rowbase * HW + 1152 + g * 64, todo, qr, g2, 0u, t, twmin, twmax, tid, lane, w); }
#endif
}

__global__ void __launch_bounds__(512, 2) fwd_megakernel(Params p) {
    extern __shared__ __attribute__((aligned(16))) unsigned char lds_raw[];
    LAS unsigned char* lds = (LAS unsigned char*)lds_raw;
    cg::grid_group grid = cg::this_grid();
    unsigned char* ws = p.ws;
    bf16_t* XB = (bf16_t*)(ws + WS_XB); bf16_t* HB = (bf16_t*)(ws + WS_H); bf16_t* MIX = (bf16_t*)(ws + WS_MIX); bf16_t* MB = (bf16_t*)(ws + WS_MB);
    const int G = gridDim.x, bx = blockIdx.x;
    const int vcu = (G % 8 == 0) ? (bx % 8) * (G / 8) + bx / 8 : bx;
    LAS unsigned* misc = (LAS unsigned*)(lds + LDS_BYTES - 64);
    if (threadIdx.x < 16) misc[threadIdx.x] = 0u;
    __syncthreads();
    XcdBarrier bar = xcd_barrier_post((unsigned*)(ws + WS_CTL), (volatile LAS unsigned*)misc);
    if (G == 0x7fffffff) grid.sync();
#define GSYNC() do { for (int rep_ = 0; rep_ < REP_SYNC; ++rep_) xcd_barrier(bar); } while (0)
#define LSYNC() do { if (loc_ok) xcd_barrier_local(bar); else xcd_barrier(bar); } while (0)
#define QSYNC() do { if (loc_ok) quad_barrier(bar, (unsigned)((bx & 7) * 8 + ((bx >> 3) & 7))); else xcd_barrier(bar); } while (0)
    unsigned* xcctab = (unsigned*)(ws + WS_CTL) + 16384; unsigned* xccflag = (unsigned*)(ws + WS_CTL) + 20480;
    if (threadIdx.x == 0) __hip_atomic_store(&xcctab[bx], bar.x + 1u, __ATOMIC_RELAXED, __HIP_MEMORY_SCOPE_AGENT);

    for (int rep = 0; rep < REP_PRO; ++rep) p0_prologue(p, lds);
    GSYNC();
    int bad_ = (G != 256) ? 1 : 0;
    if (G == 256 && threadIdx.x < 256) { const unsigned a_ = xb_ld(&xcctab[threadIdx.x]), r_ = xb_ld(&xcctab[threadIdx.x & 7]); bad_ = (a_ != r_ || a_ == 0u) ? 1 : 0; }
    const bool loc_ok = (__syncthreads_or(bad_) == 0);
    for (int rep = 0; rep < REP_IN; ++rep) run_gemm(lds, XB, (const bf16_t*)(ws + WS_IN0), 2560, 1024, EpiStore{HB, HW});
    LSYNC();
    for (int rep = 0; rep < REP_SB; ++rep)
    for (int u = vcu; u < 1024; u += G) { const int i = u >> 8, c = u & 255, bhp = c >> 2, s = c & 3;
        const int qb = (i == 0) ? s : (i == 1) ? 7 - s : (i == 2) ? 8 + s : 15 - s;
        sb_unit(p, lds, bhp >> 2, bhp & 3, qb); }
    for (int rep = 0; rep < REP_CONV; ++rep)
    if (G == 256) { for (int i = 0; i < 4; ++i) { const int lu = (vcu & 31) + 32 * i; conv_unit(p, lds, 2 * (vcu >> 5) + (lu >> 6), lu & 63); } }
    else for (int u = bx; u < 1024; u += G) conv_unit(p, lds, u >> 6, u & 63);
    LSYNC();
    run_gemm(lds, MIX, (const bf16_t*)(ws + WS_OUT0), 1024, 1024, EpiStore{MB, DM});
    QSYNC();
    for (int rep = 0; rep < REP_LN; ++rep) ln_phase<true, false>(p.in[0], XB, MB, p.in[22], p.in[23], p.out, XB);
    QSYNC();
    for (int rep = 0; rep < REP_GU; ++rep) run_gemm(lds, XB, (const bf16_t*)(ws + WS_GU0), 2 * FF, 1024, EpiSwiglu{HB, FF});
    QSYNC();
    for (int rep = 0; rep < REP_DN; ++rep) run_gemm(lds, HB, (const bf16_t*)(ws + WS_DN0), 1024, FF, EpiStore{MB, DM});
    QSYNC();
    ln_phase<false, false>(p.in[0], XB, MB, p.in[24], p.in[25], p.out, XB);
    QSYNC();
    run_gemm(lds, XB, (const bf16_t*)(ws + WS_IN1), 2560, 1024, EpiStore{HB, HW});
    LSYNC();
    for (int u = vcu; u < 256; u += G) compress_unit(p, lds, u >> 4, (u >> 3) & 1, (u >> 2) & 1, u & 3);
    if (loc_ok && G == 256) {
        const unsigned og_ = octet_arrive(bar, (unsigned)(vcu >> 3));
        for (int u = vcu; u < 256; u += G) gmlp_unit(p, lds, u >> 4, u & 15);
        octet_wait(bar, (unsigned)(vcu >> 3), og_);
    } else { xcd_barrier(bar); for (int u = vcu; u < 256; u += G) gmlp_unit(p, lds, u >> 4, u & 15); }
    for (int u = vcu; u < 1024; u += G) { const int i = u >> 8, c = u & 255, bg = c >> 3, s = c & 7;
        const unsigned pk = (s == 0) ? 0x1F160A01u : (s == 1) ? 0x1D1A0B00u : (s == 2) ? 0x19131102u : (s == 3) ? 0x1B180803u
                          : (s == 4) ? 0x1E0F0D04u : (s == 5) ? 0x15120E06u : (s == 6) ? 0x17140907u : 0x1C100C05u;
        const int qb = (int)((pk >> (8 * i)) & 0xffu);
        nsa_unit(p, lds, bg >> 1, bg & 1, qb); }
    LSYNC();
    run_gemm(lds, MIX, (const bf16_t*)(ws + WS_OUT1), 1024, 1024, EpiStore{MB, DM});
    QSYNC();
    ln_phase<false, false>(p.in[0], XB, MB, p.in[22] + DM, p.in[23] + DM, p.out, XB);
    QSYNC();
    run_gemm(lds, XB, (const bf16_t*)(ws + WS_GU1), 2 * FF, 1024, EpiSwiglu{HB, FF});
    QSYNC();
    run_gemm(lds, HB, (const bf16_t*)(ws + WS_DN1), 1024, FF, EpiStore{MB, DM});
    QSYNC();
    ln_phase<false, true>(p.in[0], XB, MB, p.in[24] + DM, p.in[25] + DM, p.out, XB);
}

extern "C" void kernel_launch(void* const* d_in, const int* in_sizes, int n_in, void* d_out, int out_size, void* d_ws, size_t ws_size, hipStream_t stream) {
    static int grid = 0;
    if (grid == 0) {
        if (n_in != 26 || out_size != MTOK * DM || ws_size < WS_END) { fprintf(stderr, "kernel_launch: unexpected problem shape (n_in %d, out %d, ws %zu)\n", n_in, out_size, ws_size); grid = -1; return; }
        int dev = 0, cus = 0, per_cu = 0;
        hipGetDevice(&dev); hipDeviceGetAttribute(&cus, hipDeviceAttributeMultiprocessorCount, dev);
        hipFuncSetAttribute((const void*)fwd_megakernel, hipFuncAttributeMaxDynamicSharedMemorySize, LDS_BYTES);
        hipOccupancyMaxActiveBlocksPerMultiprocessor(&per_cu, (const void*)fwd_megakernel, 512, LDS_BYTES);
        (void)hipGetLastError();
        if (per_cu < 1) { fprintf(stderr, "kernel_launch: occupancy query says %d blocks per CU\n", per_cu); per_cu = 1; }
        grid = cus;
    }
    if (grid < 0) return;
    if (hipMemsetAsync((char*)d_ws + WS_CTL, 0, CTL_BYTES, stream) != hipSuccess) { fprintf(stderr, "kernel_launch: memset failed\n"); return; }
    Params prm{};
    for (int i = 0; i < 26; ++i) prm.in[i] = (const float*)d_in[i];
    prm.out = (float*)d_out; prm.ws = (unsigned char*)d_ws;
    void* args[] = {&prm};
    hipError_t e = hipLaunchCooperativeKernel((const void*)fwd_megakernel, dim3(grid), dim3(512), args, LDS_BYTES, stream);
    if (e != hipSuccess) fprintf(stderr, "cooperative launch failed: %s (grid %d)\n", hipGetErrorString(e), grid);
}
```
